# Optimizing an MI355X kernel written in HIP

```python
import math
import jax, jax.numpy as jnp
from jax import lax
import numpy as np

D_MODEL = 1024
BATCH = 8
SEQ = 2048
DEPTH = 2

N_MIXERS = 2
N_POOL_LAYERS = (DEPTH + 1) // 2
N_ATTN_LAYERS = DEPTH // 2
EPS = 1e-6
POOL_WINDOWS = (2, 4, 8, 16)
POOL_GROUP_DIM = D_MODEL // len(POOL_WINDOWS)
DILATED_GROUPS = ((128, 1), (512, 4), (2048, 16))
N_ATT_GROUPS = len(DILATED_GROUPS)
ATT_HEADS = 16
HEAD_DIM = D_MODEL // ATT_HEADS
ATT_BLOCK = 128
N_BUCKETS = 32
REL_MAX_DIST = 2048
NEG_INF = -1e30
N_EXPERTS = 32
TOP_K = 4
D_EXPERT = D_MODEL
SWIGLU_LIMIT = 7.0
SWIGLU_ALPHA = 1.702
MOE_BLOCK = 128

kernel_name = "hybrid_pool_dilated_attn_moe"


def rmsnorm(x, g):
    xf = x.astype(jnp.float32)
    y = xf * lax.rsqrt(jnp.mean(xf * xf, axis=-1, keepdims=True) + EPS)
    return (y * g.astype(jnp.float32)).astype(x.dtype)


def pool_mixer(h, w_groups, scale):
    B, S, D = h.shape
    hf = h.astype(jnp.float32)
    c = jnp.cumsum(hf, axis=1)
    pos = jnp.arange(S)
    outs = []
    for gi, w in enumerate(POOL_WINDOWS):
        sl = slice(gi * POOL_GROUP_DIM, (gi + 1) * POOL_GROUP_DIM)
        cg = c[..., sl]
        c_lag = jnp.pad(cg, ((0, 0), (w, 0), (0, 0)))[:, :S]
        cnt = jnp.minimum(pos + 1, w).astype(jnp.float32)[None, :, None]
        outs.append((cg - c_lag) / cnt - hf[..., sl])
    p = jnp.stack(outs, axis=2).astype(h.dtype)
    y = jnp.einsum('bsgc,gcd->bsgd', p, w_groups).reshape(B, S, D)
    return y * scale


def t5_bucket(n):
    n = jnp.maximum(n, 0)
    max_exact = N_BUCKETS // 2
    nf = jnp.maximum(n, 1).astype(jnp.float32)
    large = max_exact + (jnp.log(nf / max_exact) / math.log(REL_MAX_DIST / max_exact)
                         * (N_BUCKETS - max_exact)).astype(jnp.int32)
    large = jnp.minimum(large, N_BUCKETS - 1)
    return jnp.where(n < max_exact, n, large)


def rms_head(t, g):
    tf = t.astype(jnp.float32)
    y = tf * lax.rsqrt(jnp.mean(tf * tf, axis=-1, keepdims=True) + EPS)
    return (y * g.astype(jnp.float32)).astype(t.dtype)


def dilated_group_attn(q, k, v, window, dil, bias_tab):
    B, S, H, Dh = q.shape
    L = S // dil
    nb = -(-L // ATT_BLOCK)
    Lp = nb * ATT_BLOCK
    steps = window // dil
    Z = B * dil

    def sub(t):
        t = jnp.swapaxes(t.reshape(B, L, dil, H, Dh), 1, 2).reshape(Z, L, H, Dh)
        return jnp.pad(t, ((0, 0), (0, Lp - L), (0, 0), (0, 0)))

    def band(t):
        tp = jnp.pad(t, ((0, 0), (ATT_BLOCK, 0), (0, 0), (0, 0))).reshape(Z, nb + 1, ATT_BLOCK, H, Dh)
        return jnp.concatenate([tp[:, :-1], tp[:, 1:]], axis=2)

    qb = sub(q).reshape(Z, nb, ATT_BLOCK, H, Dh)
    kb = band(sub(k))
    vb = band(sub(v))
    s = jnp.einsum('znqhc,znkhc->znhqk', qb, kb,
                   preferred_element_type=jnp.float32) * (Dh ** -0.5)
    qi = jnp.arange(ATT_BLOCK)[:, None]
    kj = jnp.arange(2 * ATT_BLOCK)[None, :]
    delta = qi + ATT_BLOCK - kj
    bias = bias_tab[t5_bucket(delta * dil)].transpose(2, 0, 1)
    key_pos = jnp.arange(nb)[:, None] * ATT_BLOCK - ATT_BLOCK + kj
    valid = ((delta >= 0) & (delta <= steps))[None] & (key_pos >= 0)[:, None, :]
    s = jnp.where(valid[None, :, None], s + bias.astype(jnp.float32)[None, None], NEG_INF)
    m = jnp.max(s, axis=-1, keepdims=True)
    p = jnp.exp(s - m)
    den = jnp.sum(p, axis=-1, keepdims=True)
    o = jnp.einsum('znhqk,znkhc->znqhc', p / den, vb.astype(jnp.float32))
    lse = (m[..., 0] + jnp.log(den[..., 0])).transpose(0, 1, 3, 2)

    def unsub(t):
        rest = t.shape[3:]
        t = t.reshape((Z, Lp) + rest)[:, :L].reshape((B, dil, L) + rest)
        return jnp.swapaxes(t, 1, 2).reshape((B, S) + rest)

    return unsub(o), unsub(lse)


def dilated_attention(h, w_qkv, q_gain, k_gain, w_o, rel_bias):
    B, S, D = h.shape
    qkv = (h @ w_qkv).reshape(B, S, 3, N_ATT_GROUPS, ATT_HEADS, HEAD_DIM)
    q = rms_head(qkv[:, :, 0], q_gain)
    k = rms_head(qkv[:, :, 1], k_gain)
    v = qkv[:, :, 2]
    outs, lses = [], []
    for g, (win, dil) in enumerate(DILATED_GROUPS):
        o_g, l_g = dilated_group_attn(q[:, :, g], k[:, :, g], v[:, :, g], win, dil,
                                      rel_bias[:, g * ATT_HEADS:(g + 1) * ATT_HEADS])
        outs.append(o_g)
        lses.append(l_g)
    alpha = jax.nn.softmax(jnp.stack(lses, axis=0), axis=0)
    o = jnp.einsum('gbsh,gbshc->bshc', alpha, jnp.stack(outs, axis=0))
    return o.reshape(B, S, ATT_HEADS * HEAD_DIM).astype(h.dtype) @ w_o


def moe(h, w_r, b_r, w_gu, b_gu, w_dn, b_dn):
    B, S, D = h.shape
    N = B * S
    t = h.reshape(N, D)
    logits = (t @ w_r + b_r).astype(jnp.float32)
    top_v, top_i = lax.top_k(logits, TOP_K)
    gates = jax.nn.softmax(top_v, axis=-1)
    NK = N * TOP_K
    e_flat = top_i.reshape(NK)
    order = jnp.argsort(e_flat)
    e_sorted = e_flat[order]
    tok_sorted = order // TOP_K
    g_sorted = gates.reshape(NK)[order]
    counts = jnp.zeros((N_EXPERTS,), jnp.int32).at[e_flat].add(1)
    padded = ((counts + MOE_BLOCK - 1) // MOE_BLOCK) * MOE_BLOCK
    start = jnp.cumsum(counts) - counts
    pend = jnp.cumsum(padded)
    pstart = pend - padded
    dest = pstart[e_sorted] + (jnp.arange(NK) - start[e_sorted])
    P = ((NK + N_EXPERTS * (MOE_BLOCK - 1) + MOE_BLOCK - 1) // MOE_BLOCK) * MOE_BLOCK
    NB = P // MOE_BLOCK
    x_pad = jnp.zeros((P, D), t.dtype).at[dest].set(t[tok_sorted])
    block_start = jnp.arange(NB) * MOE_BLOCK
    block_e = jnp.minimum(jnp.sum(block_start[:, None] >= pend[None, :], axis=1),
                          N_EXPERTS - 1).astype(jnp.int32)

    def expert_block(args):
        xb, e = args
        gu = xb @ w_gu[e] + b_gu[e]
        gate = jnp.minimum(gu[:, :D_EXPERT], SWIGLU_LIMIT)
        up = jnp.clip(gu[:, D_EXPERT:], -SWIGLU_LIMIT, SWIGLU_LIMIT)
        glu = gate * jax.nn.sigmoid(SWIGLU_ALPHA * gate)
        return ((up + 1) * glu) @ w_dn[e] + b_dn[e]

    y_pad = lax.map(expert_block, (x_pad.reshape(NB, MOE_BLOCK, D), block_e)).reshape(P, D)
    y = y_pad[dest] * g_sorted[:, None].astype(t.dtype)
    out = jax.ops.segment_sum(y, tok_sorted, num_segments=N)
    return out.reshape(B, S, D)


def setup_inputs(seed: int = 0) -> dict:
    key = jax.random.key(seed)
    ks = jax.random.split(key, 16)
    f32 = jnp.float32
    D, E, F = D_MODEL, N_EXPERTS, D_EXPERT
    QKV = 3 * N_ATT_GROUPS * ATT_HEADS * HEAD_DIM
    nrm = lambda k, s: jax.random.normal(k, s, f32)
    return {
        "x": nrm(ks[0], (BATCH, SEQ, D)),
        "norm_mix_g": 1.0 + 0.02 * nrm(ks[1], (DEPTH, D)),
        "norm_ffn_g": 1.0 + 0.02 * nrm(ks[2], (DEPTH, D)),
        "pool_w": nrm(ks[3], (N_POOL_LAYERS, len(POOL_WINDOWS), POOL_GROUP_DIM, POOL_GROUP_DIM)) * POOL_GROUP_DIM ** -0.5,
        "pool_scale": 1.0 + 0.02 * nrm(ks[4], (N_POOL_LAYERS, D)),
        "attn_w_qkv": nrm(ks[5], (N_ATTN_LAYERS, D, QKV)) * D ** -0.5,
        "attn_q_gain": 1.0 + 0.02 * nrm(ks[6], (N_ATTN_LAYERS, HEAD_DIM)),
        "attn_k_gain": 1.0 + 0.02 * nrm(ks[7], (N_ATTN_LAYERS, HEAD_DIM)),
        "attn_w_o": nrm(ks[8], (N_ATTN_LAYERS, ATT_HEADS * HEAD_DIM, D)) * (ATT_HEADS * HEAD_DIM) ** -0.5,
        "rel_bias": 0.2 * nrm(ks[9], (N_BUCKETS, N_ATT_GROUPS * ATT_HEADS)),
        "moe_w_router": nrm(ks[10], (DEPTH, D, E)) * D ** -0.5,
        "moe_b_router": 0.01 * nrm(ks[11], (DEPTH, E)),
        "moe_w_gate_up": nrm(ks[12], (DEPTH, E, D, 2 * F)) * D ** -0.5,
        "moe_b_gate_up": 0.01 * nrm(ks[13], (DEPTH, E, 2 * F)),
        "moe_w_down": nrm(ks[14], (DEPTH, E, F, D)) * F ** -0.5,
        "moe_b_down": 0.01 * nrm(ks[15], (DEPTH, E, D)),
    }


def reference(x, norm_mix_g, norm_ffn_g, pool_w, pool_scale, attn_w_qkv, attn_q_gain,
              attn_k_gain, attn_w_o, rel_bias, moe_w_router, moe_b_router, moe_w_gate_up,
              moe_b_gate_up, moe_w_down, moe_b_down):
    for i in range(DEPTH):
        h = rmsnorm(x, norm_mix_g[i])
        j = i // N_MIXERS
        if i % N_MIXERS == 0:
            x = x + pool_mixer(h, pool_w[j], pool_scale[j])
        else:
            x = x + dilated_attention(h, attn_w_qkv[j], attn_q_gain[j], attn_k_gain[j],
                                      attn_w_o[j], rel_bias)
        h = rmsnorm(x, norm_ffn_g[i])
        x = x + moe(h, moe_w_router[i], moe_b_router[i], moe_w_gate_up[i],
                    moe_b_gate_up[i], moe_w_down[i], moe_b_down[i])
    return x
```

```cpp
#include <hip/hip_runtime.h>
#include <hip/hip_cooperative_groups.h>
#include <cstdio>
#include <cstdint>
namespace cg = cooperative_groups;

#ifndef MK_MULTI
#define MK_MULTI 1
#endif

#define LAS __attribute__((address_space(3)))
#define GAS __attribute__((address_space(1)))
typedef unsigned short bf16;
typedef short bf16x8 __attribute__((ext_vector_type(8)));
typedef short s16x4 __attribute__((ext_vector_type(4)));
typedef float f32x2 __attribute__((ext_vector_type(2)));
typedef float f32x4 __attribute__((ext_vector_type(4)));
typedef float f32x16 __attribute__((ext_vector_type(16)));
typedef unsigned u32x4 __attribute__((ext_vector_type(4)));
typedef unsigned u32x2 __attribute__((ext_vector_type(2)));
typedef GAS unsigned gu32;

constexpr int NTOK = 16384, DM = 1024, SEQ = 2048, NEXP = 32, TOPK = 4, FF = 1024, NQKV = 9216;
constexpr int CAP = 16384;
constexpr int MAXT = 288;
constexpr int PMAX = MAXT * 256;
constexpr float EPS = 1e-6f;
constexpr int NWAVES = 8, NTHREADS = 512;

constexpr size_t MiB = 1u << 20;
constexpr size_t WS_CTL = 0, CTL_BYTES = 1 * MiB;
constexpr size_t WS_WRT = 1 * MiB;
constexpr size_t WS_WPOOL = WS_WRT + 512 * 1024;
constexpr size_t WS_WO = 2 * MiB;
constexpr size_t WS_WQKV = 4 * MiB;
constexpr size_t WS_WGU = 22 * MiB;
constexpr size_t WS_WDN = WS_WGU + 256 * MiB;
constexpr size_t WS_ROWSLOT = WS_WDN + 128 * MiB;
constexpr size_t WS_ROWGATE = WS_ROWSLOT + 2 * MiB;
constexpr size_t WS_LSE = WS_ROWGATE + 2 * MiB;
constexpr size_t WS_H2 = WS_LSE + 3 * MiB;
constexpr size_t WS_BIG = WS_H2 + 32 * MiB;
constexpr size_t WS_XPAD = WS_BIG, WS_ACT = WS_BIG + 144 * MiB, WS_QKV = WS_BIG;
constexpr size_t WS_Y = WS_BIG + 288 * MiB;
constexpr size_t WS_OG = WS_Y, WS_OB = WS_Y + 96 * MiB;
constexpr size_t WS_END = WS_Y + 128 * MiB;
static_assert((size_t)PMAX * 1024 * 2 == 144 * MiB, "xpad size");
static_assert(WS_END <= 874 * MiB, "workspace map must fit the guaranteed d_ws size");
constexpr int CW_CNT = 64;
constexpr int CW_BAR = 4096;

constexpr int RING_BYTES = 131072;
constexpr int MISC_OFF = RING_BYTES;
constexpr int L_BARST = MISC_OFF + 0;
constexpr int L_CNT = MISC_OFF + 64;
constexpr int L_PROW0 = MISC_OFF + 192;
constexpr int L_NT = MISC_OFF + 320;
constexpr int L_TILEE = MISC_OFF + 336;
constexpr int L_TILEROW = MISC_OFF + 1488;
constexpr int L_HIST = MISC_OFF + 2640;
constexpr int L_BASE = MISC_OFF + 2768;
constexpr int L_SLOTE = MISC_OFF + 2896;
constexpr int L_SLOTP = MISC_OFF + 3920;
constexpr int L_SLOTG = MISC_OFF + 4944;
constexpr int L_RSTD = MISC_OFF + 5968;
constexpr int L_BIAS = MISC_OFF + 6288;
constexpr int L_BUCKET = MISC_OFF + 7344;
constexpr int LDS_BYTES = 147456;
static_assert(L_BUCKET + 3 * 132 * 4 <= LDS_BYTES, "LDS map");

#define RLX_AGENT __ATOMIC_RELAXED, __HIP_MEMORY_SCOPE_AGENT
#define LDS_WAIT() asm volatile("s_waitcnt lgkmcnt(0)" ::: "memory")
#define VM_WAIT() asm volatile("s_waitcnt vmcnt(0)" ::: "memory")
__device__ __forceinline__ unsigned f2bf(float f) { unsigned u = __builtin_bit_cast(unsigned, f); return (u + 0x7fffu + ((u >> 16) & 1u)) >> 16; }
__device__ __forceinline__ unsigned pk2(float lo, float hi) { return f2bf(lo) | (f2bf(hi) << 16); }
__device__ __forceinline__ float bf2f(unsigned short b) { return __builtin_bit_cast(float, ((unsigned)b) << 16); }
__device__ __forceinline__ float bflo(unsigned w) { return __builtin_bit_cast(float, w << 16); }
__device__ __forceinline__ float bfhi(unsigned w) { return __builtin_bit_cast(float, w & 0xffff0000u); }
__device__ __forceinline__ unsigned cvt_pk_bf16(float lo, float hi) { unsigned r; asm volatile("v_cvt_pk_bf16_f32 %0, %1, %2" : "=v"(r) : "v"(lo), "v"(hi)); return r; }
__device__ __forceinline__ float wave_sum(float v) {
#pragma unroll
    for (int o = 1; o < 64; o <<= 1) v += __shfl_xor(v, o);
    return v;
}

#define XB_TMO      128
#define XB_XCNT(j)  (256  + 64 * (j))
#define XB_XSUB(j)  (1280 + 64 * (j))
#define XB_XGEN(j)  (2304 + 64 * (j))
#define XB_TOP      3328
#define XB_TOPGEN   3392
#define XCD_BAR_WORDS 3456
#define XB_SPIN_CAP (1u << 20)
__device__ __forceinline__ unsigned xb_ld(unsigned* p)              { return __hip_atomic_load(p, __ATOMIC_RELAXED, __HIP_MEMORY_SCOPE_AGENT); }
__device__ __forceinline__ unsigned xb_add(unsigned* p, unsigned v) { return __hip_atomic_fetch_add(p, v, __ATOMIC_RELAXED, __HIP_MEMORY_SCOPE_AGENT); }
__device__ __forceinline__ unsigned xb_xcc_id() { return (unsigned)__builtin_amdgcn_s_getreg((3 << 11) | 20) & 0xFu; }
#define XB_SPIN(cond, bar) do { unsigned _sp = 0; while (cond) { __builtin_amdgcn_s_sleep(1); \
    if ((++_sp & 255u) == 0u) { if (xb_ld(&(bar)[XB_TMO])) break; if (_sp > XB_SPIN_CAP) { atomicAdd(&(bar)[XB_TMO], 1u); break; } } } } while (0)
struct XcdBarrier { unsigned* bar; unsigned x; volatile LAS unsigned* st; };
__device__ __forceinline__ XcdBarrier xcd_barrier_post(unsigned* bar, volatile LAS unsigned* st) {
    XcdBarrier b; b.bar = bar; b.x = xb_xcc_id(); b.st = st;
    if (threadIdx.x == 0) (void)xb_add(&bar[XB_XCNT(b.x)], 1u);
    return b;
}
__device__ __forceinline__ void xcd_barrier_complete(unsigned* bar, unsigned x, unsigned& nloc, unsigned& nx) {
    const unsigned G = gridDim.x * gridDim.y * gridDim.z;
    unsigned sum, cnt, mine, sp = 0u;
    for (;;) {
        sum = 0u; cnt = 0u; mine = 0u;
#pragma unroll
        for (unsigned j = 0; j < 16; ++j) { const unsigned c = xb_ld(&bar[XB_XCNT(j)]); sum += c; cnt += (c > 0u) ? 1u : 0u; mine = (j == x) ? c : mine; }
        if (sum == G) break;
        __builtin_amdgcn_s_sleep(1);
        if ((++sp & 255u) == 0u) { if (xb_ld(&bar[XB_TMO])) break; if (sp > XB_SPIN_CAP) { atomicAdd(&bar[XB_TMO], 1u); break; } }
    }
    nloc = mine > 0u ? mine : 1u; nx = cnt > 0u ? cnt : 1u;
}
__device__ __forceinline__ void xcd_barrier(const XcdBarrier& b) {
    asm volatile("s_waitcnt vmcnt(0)" ::: "memory");
    __syncthreads();
    if (threadIdx.x == 0) {
        unsigned* bar = b.bar;
        __builtin_amdgcn_s_waitcnt(0);
        unsigned nloc = b.st[0], nx = b.st[1];
        if (nloc == 0u) { xcd_barrier_complete(bar, b.x, nloc, nx); b.st[0] = nloc; b.st[1] = nx; }
        const unsigned old = xb_add(&bar[XB_XSUB(b.x)], 1u);
        const unsigned gen = old / nloc;
        if (old + 1u == (gen + 1u) * nloc) {
            __builtin_amdgcn_fence(__ATOMIC_RELEASE, "agent");
            asm volatile("s_waitcnt vmcnt(0)" ::: "memory");
            const unsigned og = xb_add(&bar[XB_TOP], 1u);
            const unsigned tg = og / nx;
            if (og + 1u == (tg + 1u) * nx) xb_add(&bar[XB_TOPGEN], 1u);
            else XB_SPIN(xb_ld(&bar[XB_TOPGEN]) == tg, bar);
            __builtin_amdgcn_fence(__ATOMIC_ACQUIRE, "agent");
            xb_add(&bar[XB_XGEN(b.x)], 1u);
            asm volatile("s_waitcnt vmcnt(0)" ::: "memory");
        } else {
            XB_SPIN(xb_ld(&bar[XB_XGEN(b.x)]) == gen, bar);
            __builtin_amdgcn_fence(__ATOMIC_ACQUIRE, "agent");
            asm volatile("s_waitcnt vmcnt(0)" ::: "memory");
        }
    }
    __syncthreads();
}

namespace pg8 {
constexpr int BM = 256, BK = 64, HALF = 128, HTB = HALF * BK * 2, STAGE_BYTES = 8 * HTB, NXCD = 8, WGM = 8, KD = 1024;
__host__ __device__ __forceinline__ int lds_byte(int r, int c) { const int st = (r >> 4) * 2 + (c >> 5), rr = r & 15, cc = c & 31, ob = rr * 64 + cc * 2; return st * 1024 + (ob ^ (((ob >> 9) & 1) << 5)); }
__host__ __device__ __forceinline__ void stage_rc(int b, int& R, int& C) { const int st = b / 1024, sb = b % 1024, swz = sb ^ (((sb >> 9) & 1) << 5); R = (st >> 1) * 16 + swz / 64; C = (st & 1) * 32 + (swz % 64) / 2; }
__host__ __device__ __forceinline__ int perm32(int rho) { const int n = rho >> 4, i = rho & 15; return 8 * (i >> 2) + 4 * n + (i & 3); }

struct Unit { const char* a; const char* b; int i0, i1, i2, i3; };

__device__ __forceinline__ bool tile_order(int i, int G, int c, int nM, int nN, int& pm, int& pn) {
    const int nwg = nM * nN; const long L = (long)i * G + c; if (L >= nwg) return false;
    int wgid = (int)L; { const int q = nwg / NXCD, r = nwg % NXCD, xcd = wgid % NXCD, off = wgid / NXCD; wgid = (xcd < r ? xcd * (q + 1) : r * (q + 1) + (xcd - r) * q) + off; }
    const int nig = WGM * nN, gid = wgid / nig, fm = gid * WGM, gsz = (nM - fm) < WGM ? (nM - fm) : WGM;
    pm = fm + ((wgid % nig) % gsz); pn = (wgid % nig) / gsz; return true;
}

template <class Epi, class Sched, bool ALIGN_EPI, bool SP2>
__device__ __forceinline__ void gemm_phase(LAS unsigned char* lds, const size_t hstepB, const Sched& S, const Epi& E) {
    const int tid = threadIdx.x, wid = __builtin_amdgcn_readfirstlane(tid >> 6), lane = tid & 63, wr = wid >> 2, wc = wid & 3, fr = lane & 15, fq = lane >> 4;
    constexpr int K = KD, nt = K / BK;
    unsigned voffA[2], voffB[2];
#pragma unroll
    for (int i = 0; i < 2; ++i) { int R, C; stage_rc(tid * 16 + i * 8192, R, C); const int Rb = Epi::brow(R);
        voffA[i] = (unsigned)(R * K + C) * 2u; voffB[i] = (unsigned)(Rb * K + C) * 2u; }
    const size_t kstep = (size_t)(BK * 2);
    const size_t hstepA = (size_t)HALF * K * 2;
    const unsigned ldsw = (unsigned)wid * 1024u;
    const int aoff = lds_byte(wr * 64 + fr, fq * 8), boff = lds_byte(wc * 32 + fr, fq * 8);
#define PG8_SA(b, h) (((b) * 2 + (h)) * HTB)
#define PG8_SB(b, h) ((4 + (b) * 2 + (h)) * HTB)
#define PG8_STAGE(bufoff, gbase, voff) do { _Pragma("unroll") for (int _i = 0; _i < 2; ++_i) \
        __builtin_amdgcn_global_load_lds((const unsigned*)((const char*)(gbase) + (voff)[_i]), (LAS unsigned*)(lds + (bufoff) + ldsw + _i * 8192), 16, 0, 0); } while (0)
#define PG8_LDA(dst, b, h) do { _Pragma("unroll") for (int m = 0; m < 4; ++m) _Pragma("unroll") for (int k = 0; k < 2; ++k) dst[m][k] = *(const LAS bf16x8*)(lds + PG8_SA(b, h) + aoff + m * 2048 + k * 1024); } while (0)
#define PG8_LDB(dst, b, h) do { _Pragma("unroll") for (int n = 0; n < 2; ++n) _Pragma("unroll") for (int k = 0; k < 2; ++k) dst[n][k] = *(const LAS bf16x8*)(lds + PG8_SB(b, h) + boff + n * 2048 + k * 1024); } while (0)
#define PG8_MMA(ai, bj, At, Bt) do { __builtin_amdgcn_s_setprio(1); _Pragma("unroll") for (int m = 0; m < 4; ++m) _Pragma("unroll") for (int n = 0; n < 2; ++n) _Pragma("unroll") for (int k = 0; k < 2; ++k) \
        acc[ai][bj][m][n] = __builtin_amdgcn_mfma_f32_16x16x32_bf16(Bt[n][k], At[m][k], acc[ai][bj][m][n], 0, 0, 0); __builtin_amdgcn_s_setprio(0); } while (0)
#define PG8_WAIT_V(n) asm volatile("s_waitcnt vmcnt(" #n ")" ::: "memory")
#define PG8_WAIT_L(n) asm volatile("s_waitcnt lgkmcnt(" #n ")" ::: "memory")
#define PG8_BAR __builtin_amdgcn_s_barrier()
#define PG8_SCHED __builtin_amdgcn_sched_barrier(0)
    Unit cur, nxt; int ui = 0;
    if (!S.next(0, cur)) return;
    f32x4 acc[2][2][4][2];
#pragma unroll
    for (int a = 0; a < 2; ++a)
#pragma unroll
        for (int b = 0; b < 2; ++b)
#pragma unroll
            for (int m = 0; m < 4; ++m)
#pragma unroll
                for (int n = 0; n < 2; ++n) acc[a][b][m][n] = (f32x4){0.f, 0.f, 0.f, 0.f};
    bf16x8 At[4][2], B0[2][2], B1[2][2];
    const char* cA = cur.a; const char* cB = cur.b;
    if constexpr (SP2) {
        PG8_STAGE(PG8_SB(0, 0), cB, voffB); PG8_STAGE(PG8_SB(0, 1), cB + hstepB, voffB); PG8_STAGE(PG8_SA(0, 0), cA, voffA); PG8_STAGE(PG8_SA(0, 1), cA + hstepA, voffA);
        if (wr == 1) PG8_BAR;
        PG8_WAIT_V(2); PG8_BAR;
        PG8_STAGE(PG8_SB(1, 0), cB + kstep, voffB); PG8_STAGE(PG8_SA(1, 0), cA + kstep, voffA); PG8_STAGE(PG8_SB(1, 1), cB + hstepB + kstep, voffB);
        PG8_WAIT_V(6); PG8_BAR;
    } else {
        PG8_STAGE(PG8_SB(0, 0), cB, voffB); PG8_STAGE(PG8_SA(0, 0), cA, voffA); PG8_STAGE(PG8_SB(0, 1), cB + hstepB, voffB); PG8_STAGE(PG8_SA(0, 1), cA + hstepA, voffA);
        if (wr == 1) PG8_BAR;
        PG8_WAIT_V(4); PG8_BAR;
        PG8_STAGE(PG8_SB(1, 0), cB + kstep, voffB); PG8_STAGE(PG8_SA(1, 0), cA + kstep, voffA); PG8_STAGE(PG8_SB(1, 1), cB + hstepB + kstep, voffB);
        PG8_WAIT_V(6); PG8_BAR;
    }
    for (;;) {
        const bool has_next = S.next(ui + 1, nxt);
        const char* nA = has_next ? nxt.a : cA; const char* nB = has_next ? nxt.b : cB;
        for (int t = 0; t < nt; t += 2) {
            const bool last = (t == nt - 2);
            const char* a1 = cA + (size_t)(t + 1) * kstep;
            const char* a2 = last ? nA : cA + (size_t)(t + 2) * kstep; const char* b2 = last ? nB : cB + (size_t)(t + 2) * kstep;
            const char* a3 = a2 + kstep; const char* b3 = b2 + kstep;
            if constexpr (SP2) {
            PG8_LDB(B0, 0, 0); PG8_LDB(B1, 0, 1); PG8_SCHED; PG8_LDA(At, 0, 0); PG8_STAGE(PG8_SA(1, 1), a1 + hstepA, voffA);
            PG8_WAIT_V(8); PG8_WAIT_L(0); PG8_BAR; PG8_MMA(0, 0, At, B0); PG8_MMA(0, 1, At, B1); PG8_BAR; PG8_SCHED;
            PG8_LDA(At, 0, 1); PG8_STAGE(PG8_SB(0, 0), b2, voffB); PG8_STAGE(PG8_SB(0, 1), b2 + hstepB, voffB); PG8_STAGE(PG8_SA(0, 0), a2, voffA);
            PG8_WAIT_V(8); PG8_WAIT_L(0); PG8_BAR; PG8_MMA(1, 0, At, B0); PG8_MMA(1, 1, At, B1); PG8_BAR; PG8_SCHED;
            PG8_LDB(B0, 1, 0); PG8_LDB(B1, 1, 1); PG8_SCHED; PG8_LDA(At, 1, 0); PG8_STAGE(PG8_SA(0, 1), a2 + hstepA, voffA);
            PG8_WAIT_V(8); PG8_WAIT_L(0); PG8_BAR; PG8_MMA(0, 0, At, B0); PG8_MMA(0, 1, At, B1); PG8_BAR; PG8_SCHED;
            PG8_LDA(At, 1, 1); PG8_STAGE(PG8_SB(1, 0), b3, voffB); PG8_STAGE(PG8_SB(1, 1), b3 + hstepB, voffB); PG8_STAGE(PG8_SA(1, 0), a3, voffA);
            PG8_WAIT_V(8); PG8_WAIT_L(0); PG8_BAR; PG8_MMA(1, 0, At, B0); PG8_MMA(1, 1, At, B1); PG8_BAR; PG8_SCHED;
            } else {
            PG8_LDB(B0, 0, 0); PG8_SCHED; PG8_LDA(At, 0, 0); PG8_STAGE(PG8_SA(1, 1), a1 + hstepA, voffA);
            PG8_WAIT_L(8); PG8_BAR; PG8_WAIT_L(0); PG8_MMA(0, 0, At, B0); PG8_BAR; PG8_SCHED;
            PG8_LDB(B1, 0, 1); PG8_STAGE(PG8_SB(0, 0), b2, voffB);
            PG8_BAR; PG8_WAIT_L(0); PG8_MMA(0, 1, At, B1); PG8_BAR;
            PG8_LDA(At, 0, 1); PG8_STAGE(PG8_SA(0, 0), a2, voffA);
            PG8_BAR; PG8_WAIT_L(0); PG8_MMA(1, 0, At, B0); PG8_BAR; PG8_SCHED;
            PG8_STAGE(PG8_SB(0, 1), b2 + hstepB, voffB);
            PG8_WAIT_V(6); PG8_BAR; PG8_MMA(1, 1, At, B1); PG8_BAR;
            PG8_LDB(B0, 1, 0); PG8_SCHED; PG8_LDA(At, 1, 0); PG8_STAGE(PG8_SA(0, 1), a2 + hstepA, voffA);
            PG8_WAIT_L(8); PG8_BAR; PG8_WAIT_L(0); PG8_MMA(0, 0, At, B0); PG8_BAR; PG8_SCHED;
            PG8_LDB(B1, 1, 1); PG8_STAGE(PG8_SB(1, 0), b3, voffB);
            PG8_BAR; PG8_WAIT_L(0); PG8_MMA(0, 1, At, B1); PG8_BAR;
            PG8_LDA(At, 1, 1); PG8_STAGE(PG8_SA(1, 0), a3, voffA);
            PG8_BAR; PG8_WAIT_L(0); PG8_MMA(1, 0, At, B0); PG8_BAR; PG8_SCHED;
            PG8_STAGE(PG8_SB(1, 1), b3 + hstepB, voffB);
            PG8_WAIT_V(6); PG8_BAR; PG8_MMA(1, 1, At, B1); PG8_BAR;
            }
        }
        if constexpr (ALIGN_EPI) { if (wr == 0) PG8_BAR; }
        E(acc, cur, wr, wc, fr, fq);
        if (!has_next) break;
#pragma unroll
        for (int a = 0; a < 2; ++a)
#pragma unroll
            for (int b = 0; b < 2; ++b)
#pragma unroll
                for (int m = 0; m < 4; ++m)
#pragma unroll
                    for (int n = 0; n < 2; ++n) acc[a][b][m][n] = (f32x4){0.f, 0.f, 0.f, 0.f};
        cur = nxt; cA = nA; cB = nB; ++ui;
        if constexpr (ALIGN_EPI) { if (wr == 1) PG8_BAR; }
    }
    PG8_WAIT_V(0);
    if constexpr (!ALIGN_EPI) { if (wr == 0) PG8_BAR; }
    PG8_BAR;
#undef PG8_SA
#undef PG8_SB
#undef PG8_STAGE
#undef PG8_LDA
#undef PG8_LDB
#undef PG8_MMA
#undef PG8_WAIT_V
#undef PG8_WAIT_L
#undef PG8_BAR
#undef PG8_SCHED
}
}

struct Args { const float* in[16]; float* out; unsigned char* ws; int ph_lo, ph_hi; int never, pad; };
struct Frame {
    LAS unsigned char* lds;
    gu32* ctl;
    int tid, lane, wave, G;
    const float *x, *norm_mix_g, *norm_ffn_g, *pool_w, *pool_scale, *w_qkv, *q_gain, *k_gain, *w_o, *rel_bias, *w_router, *b_router, *w_gu, *b_gu, *w_dn, *b_dn;
    float* out; unsigned char* ws;
};

__device__ __forceinline__ void transpose_item(const float* W, int K, int N, bf16* WT, LAS float* scr, int item, int lane) {
    const int nblk = N / 32, kb = item / nblk, nb = item % nblk, k0 = 64 * kb, n0 = 32 * nb;
#pragma unroll 8
    for (int i = 0; i < 32; ++i) { const int kk = 2 * i + (lane >> 5); scr[kk * 33 + (lane & 31)] = W[(size_t)(k0 + kk) * N + n0 + (lane & 31)]; }
    LDS_WAIT(); asm volatile("" ::: "memory");
    const int c = lane & 7;
#pragma unroll
    for (int j = 0; j < 4; ++j) { const int n = (lane >> 3) + 8 * j; const LAS float* s = scr + (8 * c) * 33 + n;
        u32x4 o; o.x = pk2(s[0 * 33], s[1 * 33]); o.y = pk2(s[2 * 33], s[3 * 33]); o.z = pk2(s[4 * 33], s[5 * 33]); o.w = pk2(s[6 * 33], s[7 * 33]);
        *(GAS u32x4*)(WT + (size_t)(n0 + n) * K + k0 + 8 * c) = o; }
    LDS_WAIT(); asm volatile("" ::: "memory");
}
__device__ __forceinline__ void phase_convert(Frame& F) {
    LAS float* scr = (LAS float*)(F.lds + F.wave * 16384);
    const int gw = blockIdx.x * NWAVES + F.wave, NGW = F.G * NWAVES;
    constexpr int I_GU = 64 * 1024, I_DN = 64 * 512, I_QKV = 16 * 288, I_WO = 512, I_POOL = 4 * 32;
    constexpr int NITEMS = I_GU + I_DN + I_QKV + I_WO + I_POOL;
    for (int it = gw; it < NITEMS; it += NGW) {
        int r = it;
        if (r < I_GU) { const int mat = r >> 10; transpose_item(F.w_gu + (size_t)mat * 1024 * 2048, 1024, 2048, (bf16*)(F.ws + WS_WGU) + (size_t)mat * 2048 * 1024, scr, r & 1023, F.lane); continue; } r -= I_GU;
        if (r < I_DN) { const int mat = r >> 9; transpose_item(F.w_dn + (size_t)mat * 1024 * 1024, 1024, 1024, (bf16*)(F.ws + WS_WDN) + (size_t)mat * 1024 * 1024, scr, r & 511, F.lane); continue; } r -= I_DN;
        if (r < I_QKV) { transpose_item(F.w_qkv, 1024, NQKV, (bf16*)(F.ws + WS_WQKV), scr, r, F.lane); continue; } r -= I_QKV;
        if (r < I_WO) { transpose_item(F.w_o, 1024, 1024, (bf16*)(F.ws + WS_WO), scr, r, F.lane); continue; } r -= I_WO;
        { const int mat = r >> 5; transpose_item(F.pool_w + (size_t)mat * 65536, 256, 256, (bf16*)(F.ws + WS_WPOOL) + (size_t)mat * 65536, scr, r & 31, F.lane); }
    }
    float* wrt = (float*)(F.ws + WS_WRT);
    for (int i = blockIdx.x * NTHREADS + F.tid; i < 2 * 32 * 1024; i += F.G * NTHREADS) { const int l = i >> 15, e = (i >> 10) & 31, c = i & 1023; wrt[i] = F.w_router[(size_t)l * 32768 + c * 32 + e]; }
}

__device__ __forceinline__ void router_tile(Frame& F, int layer, int tok0) {
    LAS int* hist = (LAS int*)(F.lds + L_HIST); LAS int* base = (LAS int*)(F.lds + L_BASE);
    LAS int* slot_e = (LAS int*)(F.lds + L_SLOTE); LAS int* slot_p = (LAS int*)(F.lds + L_SLOTP); LAS float* slot_g = (LAS float*)(F.lds + L_SLOTG);
    const int lane = F.lane;
    if (F.tid < 32) hist[F.tid] = 0;
    __syncthreads();
    const float* wrt = (const float*)(F.ws + WS_WRT) + (size_t)layer * 32 * 1024;
    const float* g2 = F.norm_ffn_g + layer * 1024;
    bf16* H2 = (bf16*)(F.ws + WS_H2);
    f32x4 gv[4];
#pragma unroll
    for (int j = 0; j < 4; ++j) gv[j] = *(const f32x4*)(g2 + lane * 4 + 256 * j);
    const float brl = (lane < 32) ? F.b_router[layer * 32 + lane] : 0.f;
    for (int half = 0; half < 2; ++half) {
        const int rb = F.wave * 8 + half * 4;
        f32x4 h[4][4];
#pragma unroll
        for (int r = 0; r < 4; ++r) {
            const int tok = tok0 + rb + r;
            const GAS f32x4* xr = (const GAS f32x4*)(F.out + (size_t)tok * 1024) + lane;
            float ss = 0.f;
#pragma unroll
            for (int j = 0; j < 4; ++j) { h[r][j] = xr[64 * j]; ss += (h[r][j].x * h[r][j].x + h[r][j].y * h[r][j].y) + (h[r][j].z * h[r][j].z + h[r][j].w * h[r][j].w); }
            const float rstd = rsqrtf(wave_sum(ss) * (1.f / 1024.f) + EPS);
            GAS u32x2* o8 = (GAS u32x2*)(H2 + (size_t)tok * 1024) + lane;
#pragma unroll
            for (int j = 0; j < 4; ++j) { h[r][j] = h[r][j] * rstd * gv[j]; u32x2 w; w.x = pk2(h[r][j].x, h[r][j].y); w.y = pk2(h[r][j].z, h[r][j].w); o8[64 * j] = w; }
        }
        float lg[4] = {0.f, 0.f, 0.f, 0.f};
        for (int e = 0; e < 32; ++e) {
            f32x4 w[4];
#pragma unroll
            for (int j = 0; j < 4; ++j) w[j] = *(const f32x4*)(wrt + e * 1024 + lane * 4 + 256 * j);
#pragma unroll
            for (int r = 0; r < 4; ++r) {
                float p = 0.f;
#pragma unroll
                for (int j = 0; j < 4; ++j) p += (h[r][j].x * w[j].x + h[r][j].y * w[j].y) + (h[r][j].z * w[j].z + h[r][j].w * w[j].w);
                p = wave_sum(p);
                lg[r] = (lane == e) ? p : lg[r];
            }
        }
#pragma unroll
        for (int r = 0; r < 4; ++r) {
            float v = (lane < 32) ? lg[r] + brl : -INFINITY;
            float tv[4]; int ti[4];
#pragma unroll
            for (int k = 0; k < 4; ++k) {
                float bv = v; int bi = lane;
#pragma unroll
                for (int off = 32; off >= 1; off >>= 1) { const float ov = __shfl_xor(bv, off); const int oi = __shfl_xor(bi, off); if (ov > bv || (ov == bv && oi < bi)) { bv = ov; bi = oi; } }
                tv[k] = bv; ti[k] = bi; if (lane == bi) v = -INFINITY;
            }
            const float e1 = __expf(tv[1] - tv[0]), e2 = __expf(tv[2] - tv[0]), e3 = __expf(tv[3] - tv[0]);
            const float inv = 1.f / (1.f + e1 + e2 + e3);
            if (lane < 4) {
                const int e = lane == 0 ? ti[0] : lane == 1 ? ti[1] : lane == 2 ? ti[2] : ti[3];
                const float gt = (lane == 0 ? 1.f : lane == 1 ? e1 : lane == 2 ? e2 : e3) * inv;
                const int lp = atomicAdd((int*)(hist + e), 1);
                const int s = (rb + r) * 4 + lane;
                slot_e[s] = e; slot_p[s] = lp; slot_g[s] = gt;
            }
        }
    }
    __syncthreads();
    if (F.tid < 32) base[F.tid] = (int)__hip_atomic_fetch_add((unsigned*)(F.ctl + CW_CNT + layer * 32 + F.tid), (unsigned)hist[F.tid], RLX_AGENT);
    __syncthreads();
    if (F.tid < 256) {
        const int e = slot_e[F.tid]; const int pos = base[e] + slot_p[F.tid];
        ((int*)(F.ws + WS_ROWSLOT))[e * CAP + pos] = (tok0 + (F.tid >> 2)) * 4 + (F.tid & 3);
        ((float*)(F.ws + WS_ROWGATE))[e * CAP + pos] = slot_g[F.tid];
    }
    __syncthreads();
}

__device__ __forceinline__ int pswz(int r, int c) { return r * 2048 + ((((c >> 3) ^ (r & 7)) << 4) | ((c & 7) << 1)); }
template <int W>
__device__ __forceinline__ void pool_window(const float* x, int tok0, int s0, const LAS float* rstd1, float gx, float gy, LAS unsigned char* P, int tid) {
    float rx[W], ry[W];
    const GAS f32x2* xp = (const GAS f32x2*)x + tid;
#pragma unroll
    for (int j = 0; j < W; ++j) { const int s = s0 - W + j; float hx = 0.f, hy = 0.f;
        if (s >= 0) { const f32x2 v = xp[(size_t)(tok0 - W + j) * 512]; const float r = rstd1[16 - W + j]; hx = v.x * r * gx; hy = v.y * r * gy; }
        rx[j] = hx; ry[j] = hy; }
    for (int sc = 0; sc < 4; ++sc) {
        f32x2 v[16];
#pragma unroll
        for (int j = 0; j < 16; ++j) v[j] = xp[(size_t)(tok0 + sc * 16 + j) * 512];
#pragma unroll
        for (int j = 0; j < 16; ++j) {
            const int tl = sc * 16 + j; const float r = rstd1[16 + tl];
            const float hx = v[j].x * r * gx, hy = v[j].y * r * gy;
            rx[j % W] = hx; ry[j % W] = hy;
            float sx = 0.f, sy = 0.f;
#pragma unroll
            for (int q = 0; q < W; ++q) { sx += rx[q]; sy += ry[q]; }
            const int s = s0 + tl; const int cn = (s + 1 < W) ? (s + 1) : W; const float inv = 1.f / (float)cn;
            *(LAS unsigned*)(P + pswz(tl, 2 * tid)) = pk2(sx * inv - hx, sy * inv - hy);
        }
    }
}
__device__ __forceinline__ void phase_pool(Frame& F) {
    LAS unsigned char* P = F.lds;
    LAS float* rstd1 = (LAS float*)(F.lds + L_RSTD);
    const int lane = F.lane, wave = F.wave, tid = F.tid;
    const int fr = lane & 15, fq = lane >> 4;
    for (int tile = blockIdx.x; tile < NTOK / 64; tile += F.G) {
        const int tok0 = tile * 64, s0 = tok0 & (SEQ - 1);
        for (int rr = wave; rr < 80; rr += 8) {
            const int s = s0 - 16 + rr; float r = 0.f;
            if (s >= 0) {
                const GAS f32x4* xr = (const GAS f32x4*)(F.x + (size_t)(tok0 - 16 + rr) * 1024) + lane; float ss = 0.f;
#pragma unroll
                for (int j = 0; j < 4; ++j) { const f32x4 v = xr[64 * j]; ss += (v.x * v.x + v.y * v.y) + (v.z * v.z + v.w * v.w); }
                r = rsqrtf(wave_sum(ss) * (1.f / 1024.f) + EPS);
            }
            if (lane == 0) rstd1[rr] = r;
        }
        __syncthreads();
        { const float gx = F.norm_mix_g[2 * tid], gy = F.norm_mix_g[2 * tid + 1];
          const int grp = wave >> 1;
          if (grp == 0) pool_window<2>(F.x, tok0, s0, rstd1, gx, gy, P, tid);
          else if (grp == 1) pool_window<4>(F.x, tok0, s0, rstd1, gx, gy, P, tid);
          else if (grp == 2) pool_window<8>(F.x, tok0, s0, rstd1, gx, gy, P, tid);
          else pool_window<16>(F.x, tok0, s0, rstd1, gx, gy, P, tid); }
        __syncthreads();
        { const int gi = wave >> 1, nh = wave & 1;
          const bf16* Wt = (const bf16*)(F.ws + WS_WPOOL) + (size_t)gi * 65536 + (size_t)(nh * 128) * 256;
          f32x4 acc[4][8];
#pragma unroll
          for (int m = 0; m < 4; ++m)
#pragma unroll
              for (int n = 0; n < 8; ++n) acc[m][n] = (f32x4){0.f, 0.f, 0.f, 0.f};
#pragma unroll 2
          for (int ks = 0; ks < 8; ++ks) {
              bf16x8 a[4];
#pragma unroll
              for (int m = 0; m < 4; ++m) a[m] = *(const LAS bf16x8*)(P + pswz(m * 16 + fr, gi * 256 + ks * 32 + fq * 8));
#pragma unroll
              for (int n = 0; n < 8; ++n) {
                  const bf16x8 b = *(const GAS bf16x8*)(Wt + (size_t)(n * 16 + fr) * 256 + ks * 32 + fq * 8);
#pragma unroll
                  for (int m = 0; m < 4; ++m) acc[m][n] = __builtin_amdgcn_mfma_f32_16x16x32_bf16(b, a[m], acc[m][n], 0, 0, 0);
              }
          }
#pragma unroll
          for (int n = 0; n < 8; ++n) {
              const int col = gi * 256 + nh * 128 + n * 16 + fq * 4;
              const f32x4 sc = *(const f32x4*)(F.pool_scale + col);
#pragma unroll
              for (int m = 0; m < 4; ++m) {
                  const size_t off = (size_t)(tok0 + m * 16 + fr) * 1024 + col;
                  const f32x4 xv = *(const GAS f32x4*)(F.x + off);
                  *(GAS f32x4*)(F.out + off) = xv + acc[m][n] * sc;
              }
          }
        }
        VM_WAIT();
        __syncthreads();
        router_tile(F, 0, tok0);
    }
}
__device__ __forceinline__ void phase_router(Frame& F, int layer) {
    for (int tile = blockIdx.x; tile < NTOK / 64; tile += F.G) router_tile(F, layer, tile * 64);
}

__device__ __forceinline__ void moe_tables(Frame& F, int layer) {
    LAS int* cntL = (LAS int*)(F.lds + L_CNT); LAS int* prow0 = (LAS int*)(F.lds + L_PROW0); LAS int* ntp = (LAS int*)(F.lds + L_NT);
    LAS int* tileE = (LAS int*)(F.lds + L_TILEE); LAS int* tileRow = (LAS int*)(F.lds + L_TILEROW);
    __syncthreads();
    if (F.tid == 0) {
        int acc = 0, T = 0;
        for (int e = 0; e < 32; ++e) {
            int c = (int)__hip_atomic_load((unsigned*)(F.ctl + CW_CNT + layer * 32 + e), RLX_AGENT);
            if (c > CAP) c = CAP;
            cntL[e] = c; prow0[e] = acc;
            const int mt = (c + 255) >> 8;
            for (int m = 0; m < mt && T < MAXT; ++m) { tileE[T] = e; tileRow[T] = acc + m * 256; ++T; }
            acc += mt * 256;
        }
        ntp[0] = T;
    }
    __syncthreads();
}
__device__ __forceinline__ void phase_gather(Frame& F, int layer) {
    moe_tables(F, layer);
    const LAS int* cntL = (const LAS int*)(F.lds + L_CNT); const LAS int* prow0 = (const LAS int*)(F.lds + L_PROW0);
    const LAS int* tileE = (const LAS int*)(F.lds + L_TILEE);
    const int NT = *(const LAS int*)(F.lds + L_NT);
    const int gw = blockIdx.x * NWAVES + F.wave, NGW = F.G * NWAVES;
    const int* rowslot = (const int*)(F.ws + WS_ROWSLOT);
    const bf16* H2 = (const bf16*)(F.ws + WS_H2); bf16* XP = (bf16*)(F.ws + WS_XPAD);
    for (int pr = gw; pr < NT * 256; pr += NGW) {
        const int e = tileE[pr >> 8]; const int pos = pr - prow0[e];
        if (pos < cntL[e]) {
            const int tok = rowslot[e * CAP + pos] >> 2;
            const GAS u32x4* src = (const GAS u32x4*)(H2 + (size_t)tok * 1024) + F.lane;
            GAS u32x4* dst = (GAS u32x4*)(XP + (size_t)pr * 1024) + F.lane;
            const u32x4 v0 = src[0], v1 = src[64];
            dst[0] = v0; dst[64] = v1;
        }
    }
}

struct MoeOrder {
    int NT, nN, G, c; const LAS int* tileE; const LAS int* tileRow; const char* Abase; const char* Bbase; size_t bExp, bTile;
    __device__ __forceinline__ bool next(int i, pg8::Unit& u) const {
        int T, pn; if (!pg8::tile_order(i, G, c, NT, nN, T, pn)) return false;
        const int e = tileE[T], row0 = tileRow[T];
        u.a = Abase + (size_t)row0 * 2048; u.b = Bbase + (size_t)e * bExp + (size_t)pn * bTile; u.i0 = T; u.i1 = pn; u.i2 = e; u.i3 = row0; return true;
    }
};
struct EpiGU {
    static __host__ __device__ __forceinline__ int brow(int R) { return (R & ~31) + pg8::perm32(R & 31); }
    bf16* ACT; const float* bgu;
    __device__ __forceinline__ void operator()(const f32x4 (&acc)[2][2][4][2], const pg8::Unit& u, int wr, int wc, int fr, int fq) const {
        const int e = u.i2, f0 = u.i1 * 128 + wc * 32 + 8 * fq;
        const float* bg = bgu + (size_t)e * 2048 + f0;
        const f32x4 bg0 = *(const f32x4*)(bg), bg1 = *(const f32x4*)(bg + 4), bu0 = *(const f32x4*)(bg + 1024), bu1 = *(const f32x4*)(bg + 1028);
#pragma unroll
        for (int ai = 0; ai < 2; ++ai)
#pragma unroll
            for (int m = 0; m < 4; ++m) {
                bf16* rowp = ACT + (size_t)(u.i3 + ai * 128 + wr * 64 + m * 16 + fr) * 1024 + f0;
                const f32x4 g0 = acc[ai][0][m][0] + bg0, g1 = acc[ai][0][m][1] + bg1, u0 = acc[ai][1][m][0] + bu0, u1 = acc[ai][1][m][1] + bu1;
                float o[8];
#pragma unroll
                for (int j = 0; j < 8; ++j) {
                    const float g = fminf(j < 4 ? g0[j & 3] : g1[j & 3], 7.f);
                    const float up = fminf(fmaxf(j < 4 ? u0[j & 3] : u1[j & 3], -7.f), 7.f);
                    const float sg = __builtin_amdgcn_rcpf(1.f + __builtin_amdgcn_exp2f(-1.702f * 1.4426950408889634f * g));
                    o[j] = (up + 1.f) * (g * sg);
                }
                u32x4 w; w.x = cvt_pk_bf16(o[0], o[1]); w.y = cvt_pk_bf16(o[2], o[3]); w.z = cvt_pk_bf16(o[4], o[5]); w.w = cvt_pk_bf16(o[6], o[7]);
                *(GAS u32x4*)rowp = w;
            }
    }
};
struct EpiDN {
    static __host__ __device__ __forceinline__ int brow(int R) { return (R & ~31) + pg8::perm32(R & 31); }
    bf16* Y; const float* bdn; const int* rowslot; const float* rowgate; const LAS int* cntL; const LAS int* prow0;
    __device__ __forceinline__ void operator()(const f32x4 (&acc)[2][2][4][2], const pg8::Unit& u, int wr, int wc, int fr, int fq) const {
        const int e = u.i2, col0 = u.i1 * 256 + wc * 32 + 8 * fq;
        const float* bp = bdn + (size_t)e * 1024 + col0;
        f32x4 bv[2][2];
#pragma unroll
        for (int bj = 0; bj < 2; ++bj)
#pragma unroll
            for (int n = 0; n < 2; ++n) bv[bj][n] = *(const f32x4*)(bp + bj * 128 + 4 * n);
        const int pbase = u.i3 - prow0[e], cn = cntL[e];
#pragma unroll
        for (int ai = 0; ai < 2; ++ai)
#pragma unroll
            for (int m = 0; m < 4; ++m) {
                const int pos = pbase + ai * 128 + wr * 64 + m * 16 + fr;
                if (pos < cn) {
                    const int slot = rowslot[e * CAP + pos]; const float gt = rowgate[e * CAP + pos];
                    bf16* rowp = Y + (size_t)slot * 1024 + col0;
#pragma unroll
                    for (int bj = 0; bj < 2; ++bj) {
                        const f32x4 v0 = (acc[ai][bj][m][0] + bv[bj][0]) * gt, v1 = (acc[ai][bj][m][1] + bv[bj][1]) * gt;
                        u32x4 w; w.x = cvt_pk_bf16(v0[0], v0[1]); w.y = cvt_pk_bf16(v0[2], v0[3]); w.z = cvt_pk_bf16(v1[0], v1[1]); w.w = cvt_pk_bf16(v1[2], v1[3]);
                        *(GAS u32x4*)(rowp + bj * 128) = w;
                    }
                }
            }
    }
};
__device__ __forceinline__ void phase_moe_gu(Frame& F, int layer) {
    moe_tables(F, layer);
    MoeOrder S; S.NT = *(const LAS int*)(F.lds + L_NT); S.nN = 8; S.G = F.G; S.c = blockIdx.x; S.tileE = (const LAS int*)(F.lds + L_TILEE); S.tileRow = (const LAS int*)(F.lds + L_TILEROW);
    S.Abase = (const char*)(F.ws + WS_XPAD); S.Bbase = (const char*)(F.ws + WS_WGU) + (size_t)layer * 32 * 2048 * 1024 * 2; S.bExp = (size_t)2048 * 1024 * 2; S.bTile = (size_t)128 * 1024 * 2;
    EpiGU E; E.ACT = (bf16*)(F.ws + WS_ACT); E.bgu = F.b_gu + (size_t)layer * 32 * 2048;
    pg8::gemm_phase<EpiGU, MoeOrder, true, true>(F.lds, (size_t)1024 * 1024 * 2, S, E);
}
__device__ __forceinline__ void phase_moe_dn(Frame& F, int layer) {
    moe_tables(F, layer);
    MoeOrder S; S.NT = *(const LAS int*)(F.lds + L_NT); S.nN = 4; S.G = F.G; S.c = blockIdx.x; S.tileE = (const LAS int*)(F.lds + L_TILEE); S.tileRow = (const LAS int*)(F.lds + L_TILEROW);
    S.Abase = (const char*)(F.ws + WS_ACT); S.Bbase = (const char*)(F.ws + WS_WDN) + (size_t)layer * 32 * 1024 * 1024 * 2; S.bExp = (size_t)1024 * 1024 * 2; S.bTile = (size_t)256 * 1024 * 2;
    EpiDN E; E.Y = (bf16*)(F.ws + WS_Y); E.bdn = F.b_dn + (size_t)layer * 32 * 1024; E.rowslot = (const int*)(F.ws + WS_ROWSLOT); E.rowgate = (const float*)(F.ws + WS_ROWGATE);
    E.cntL = (const LAS int*)(F.lds + L_CNT); E.prow0 = (const LAS int*)(F.lds + L_PROW0);
    pg8::gemm_phase<EpiDN, MoeOrder, true, true>(F.lds, (size_t)128 * 1024 * 2, S, E);
}

__device__ __forceinline__ void phase_combine(Frame& F, int layer) {
    const int gw = blockIdx.x * NWAVES + F.wave, NGW = F.G * NWAVES, lane = F.lane;
    const bf16* Y = (const bf16*)(F.ws + WS_Y); bf16* H2 = (bf16*)(F.ws + WS_H2);
    f32x4 gv[4];
#pragma unroll
    for (int j = 0; j < 4; ++j) gv[j] = *(const f32x4*)(F.norm_mix_g + 1024 + lane * 4 + 256 * j);
    for (int tok = gw; tok < NTOK; tok += NGW) {
        GAS f32x4* xr = (GAS f32x4*)(F.out + (size_t)tok * 1024) + lane;
        f32x4 v[4];
#pragma unroll
        for (int j = 0; j < 4; ++j) v[j] = xr[64 * j];
#pragma unroll
        for (int k = 0; k < 4; ++k) {
            const GAS u32x2* yr = (const GAS u32x2*)(Y + (size_t)(tok * 4 + k) * 1024) + lane;
#pragma unroll
            for (int j = 0; j < 4; ++j) { const u32x2 w = yr[64 * j]; v[j].x += bflo(w.x); v[j].y += bfhi(w.x); v[j].z += bflo(w.y); v[j].w += bfhi(w.y); }
        }
        float ss = 0.f;
#pragma unroll
        for (int j = 0; j < 4; ++j) { xr[64 * j] = v[j]; ss += (v[j].x * v[j].x + v[j].y * v[j].y) + (v[j].z * v[j].z + v[j].w * v[j].w); }
        if (layer == 0) {
            const float rstd = rsqrtf(wave_sum(ss) * (1.f / 1024.f) + EPS);
            GAS u32x2* o8 = (GAS u32x2*)(H2 + (size_t)tok * 1024) + lane;
#pragma unroll
            for (int j = 0; j < 4; ++j) { const f32x4 h = v[j] * rstd * gv[j]; u32x2 w; w.x = pk2(h.x, h.y); w.y = pk2(h.z, h.w); o8[64 * j] = w; }
        }
    }
}

struct DenseOrder {
    int nM, nN, G, c; const char* Abase; const char* Bbase;
    __device__ __forceinline__ bool next(int i, pg8::Unit& u) const {
        int pm, pn; if (!pg8::tile_order(i, G, c, nM, nN, pm, pn)) return false;
        u.a = Abase + (size_t)pm * 256 * 2048; u.b = Bbase + (size_t)pn * 256 * 2048; u.i0 = pm; u.i1 = pn; u.i2 = 0; u.i3 = 0; return true;
    }
};
struct EpiQKV {
    static __host__ __device__ __forceinline__ int brow(int R) { return 2 * (R & ~31) + pg8::perm32(R & 31); }
    bf16* O; const float* qg; const float* kg;
    __device__ __forceinline__ void operator()(const f32x4 (&acc)[2][2][4][2], const pg8::Unit& u, int wr, int wc, int fr, int fq) const {
        const int pn = u.i1, which = pn / 12;
        const int colh = pn * 256 + wc * 64;
        f32x4 gn[2][2];
#pragma unroll
        for (int bj = 0; bj < 2; ++bj)
#pragma unroll
            for (int n = 0; n < 2; ++n) {
                const int hd = bj * 32 + 8 * fq + 4 * n;
                gn[bj][n] = which == 0 ? *(const f32x4*)(qg + hd) * 0.125f : which == 1 ? *(const f32x4*)(kg + hd) : (f32x4){1.f, 1.f, 1.f, 1.f};
            }
#pragma unroll
        for (int ai = 0; ai < 2; ++ai)
#pragma unroll
            for (int m = 0; m < 4; ++m) {
                float ss = 0.f;
#pragma unroll
                for (int bj = 0; bj < 2; ++bj)
#pragma unroll
                    for (int n = 0; n < 2; ++n) { const f32x4 v = acc[ai][bj][m][n]; ss += (v[0] * v[0] + v[1] * v[1]) + (v[2] * v[2] + v[3] * v[3]); }
                ss += __shfl_xor(ss, 16); ss += __shfl_xor(ss, 32);
                const float rs = which == 2 ? 1.f : rsqrtf(ss * (1.f / 64.f) + EPS);
                bf16* rowp = O + (size_t)(u.i0 * 256 + ai * 128 + wr * 64 + m * 16 + fr) * NQKV + colh + 8 * fq;
#pragma unroll
                for (int bj = 0; bj < 2; ++bj) {
                    const f32x4 v0 = acc[ai][bj][m][0] * rs * gn[bj][0], v1 = acc[ai][bj][m][1] * rs * gn[bj][1];
                    u32x4 w; w.x = cvt_pk_bf16(v0[0], v0[1]); w.y = cvt_pk_bf16(v0[2], v0[3]); w.z = cvt_pk_bf16(v1[0], v1[1]); w.w = cvt_pk_bf16(v1[2], v1[3]);
                    *(GAS u32x4*)(rowp + bj * 32) = w;
                }
            }
    }
};
__device__ __forceinline__ void phase_qkv(Frame& F) {
    DenseOrder S; S.nM = NTOK / 256; S.nN = NQKV / 256; S.G = F.G; S.c = blockIdx.x; S.Abase = (const char*)(F.ws + WS_H2); S.Bbase = (const char*)(F.ws + WS_WQKV);
    EpiQKV E; E.O = (bf16*)(F.ws + WS_QKV); E.qg = F.q_gain; E.kg = F.k_gain;
    pg8::gemm_phase<EpiQKV, DenseOrder, true, true>(F.lds, (size_t)32 * 1024 * 2, S, E);
}

struct EpiWo {
    static __host__ __device__ __forceinline__ int brow(int R) { return R; }
    float* X;
    __device__ __forceinline__ void operator()(const f32x4 (&acc)[2][2][4][2], const pg8::Unit& u, int wr, int wc, int fr, int fq) const {
        const int row0 = u.i0 * 256 + wr * 64 + fr, col0 = u.i1 * 256 + wc * 32 + 4 * fq;
#pragma unroll
        for (int ai = 0; ai < 2; ++ai)
#pragma unroll
            for (int m = 0; m < 4; ++m) { float* rowp = X + (size_t)(row0 + ai * 128 + m * 16) * 1024 + col0;
#pragma unroll
                for (int bj = 0; bj < 2; ++bj)
#pragma unroll
                    for (int n = 0; n < 2; ++n) { GAS f32x4* p = (GAS f32x4*)(rowp + bj * 128 + n * 16); *p = *p + acc[ai][bj][m][n]; } }
    }
};
__device__ __forceinline__ void phase_wo(Frame& F) {
    DenseOrder S; S.nM = NTOK / 256; S.nN = 4; S.G = F.G; S.c = blockIdx.x; S.Abase = (const char*)(F.ws + WS_OB); S.Bbase = (const char*)(F.ws + WS_WO);
    EpiWo E; E.X = F.out;
    pg8::gemm_phase<EpiWo, DenseOrder, false, true>(F.lds, (size_t)128 * 1024 * 2, S, E);
}

typedef short v4i16_t __attribute__((ext_vector_type(4)));
__device__ __forceinline__ s16x4 vtr(const LAS unsigned char* p) { return __builtin_bit_cast(s16x4, __builtin_amdgcn_ds_read_tr16_b64_v4i16((LAS v4i16_t*)p)); }
__device__ __forceinline__ void phase_attn(Frame& F) {
    LAS unsigned char* lds = F.lds;
    LAS float* biasL = (LAS float*)(lds + L_BIAS); LAS int* bucketL = (LAS int*)(lds + L_BUCKET);
    const int tid = F.tid, lane = F.lane, wave = F.wave;
    for (int i = tid; i < 3 * 129; i += NTHREADS) {
        const int g = i / 129, d = i % 129; const int n = d * (g == 0 ? 1 : g == 1 ? 4 : 16);
        int bk;
        if (n < 16) bk = n;
        else { const float nf = (float)n; int lg = 16 + (int)(logf(nf / 16.f) / 4.852030263919617f * 16.f); bk = lg < 31 ? lg : 31; }
        bucketL[g * 132 + d] = bk;
    }
    __syncthreads();
    const int hg = wave >> 2, w = wave & 3, t2 = tid & 255;
    const int q = lane & 31, hh = lane >> 5;
    const bf16* QKV = (const bf16*)(F.ws + WS_QKV);
    LAS unsigned char* Kb = lds + hg * 32768;
    LAS unsigned char* Vb = lds + 65536 + hg * 32768;
    for (int item = blockIdx.x; item < 3072; item += F.G) {
        const int hp = item & 7, gb = item >> 3, g = gb >> 7, blk = gb & 127;
        const int dil = g == 0 ? 1 : g == 1 ? 4 : 16;
        const int nb = 16 / dil;
        const int z = blk / nb, i = blk % nb, b = z / dil, r = z % dil;
        const int head = hp * 2 + hg;
        const size_t rowbase = (size_t)b * SEQ + r;
        {
            const int it0 = (i == 0) ? 4 : 0;
            u32x4 kv[8], vv[8];
#pragma unroll
            for (int it = 0; it < 8; ++it) {
                if (it >= it0) {
                    const int cidx = t2 + 256 * it, row = cidx >> 3, ch = cidx & 7;
                    const long j = (long)(i - 1) * 128 + row;
                    const bf16* src = QKV + (rowbase + (size_t)dil * j) * NQKV + g * 1024 + head * 64 + ch * 8;
                    kv[it] = *(const GAS u32x4*)(src + 3072); vv[it] = *(const GAS u32x4*)(src + 6144);
                }
            }
#pragma unroll
            for (int it = 0; it < 8; ++it) {
                if (it >= it0) {
                    const int cidx = t2 + 256 * it, row = cidx >> 3, ch = cidx & 7;
                    const int off = row * 128 + ((ch ^ (row & 7)) << 4);
                    *(LAS u32x4*)(Kb + off) = kv[it]; *(LAS u32x4*)(Vb + off) = vv[it];
                }
            }
            if (t2 < 129) biasL[hg * 132 + t2] = F.rel_bias[bucketL[g * 132 + t2] * 48 + g * 16 + head];
        }
        bf16x8 qf[4];
        const size_t qrow = rowbase + (size_t)dil * ((size_t)i * 128 + 32 * w + q);
        {
            const bf16* qp = QKV + qrow * NQKV + g * 1024 + head * 64 + 8 * hh;
#pragma unroll
            for (int ks = 0; ks < 4; ++ks) qf[ks] = *(const GAS bf16x8*)(qp + 16 * ks);
        }
        __syncthreads();
        const int kt_lo = (i == 0 && w < 4) ? 4 : w;
        f32x16 S[5];
#pragma unroll
        for (int t = 0; t < 5; ++t) {
#pragma unroll
            for (int rg = 0; rg < 16; ++rg) S[t][rg] = 0.f;
            const int kt = w + t;
            if (kt >= kt_lo) {
                const int row = 32 * kt + q;
#pragma unroll
                for (int ks = 0; ks < 4; ++ks) {
                    const bf16x8 kf = *(const LAS bf16x8*)(Kb + row * 128 + (((2 * ks + hh) ^ (row & 7)) << 4));
                    S[t] = __builtin_amdgcn_mfma_f32_32x32x16_bf16(kf, qf[ks], S[t], 0, 0, 0);
                }
            }
        }
        float mx = -1e30f;
#pragma unroll
        for (int t = 0; t < 5; ++t) {
            const bool tv = (w + t) >= kt_lo;
#pragma unroll
            for (int rg = 0; rg < 16; ++rg) {
                const int keyl = (rg & 3) + 8 * (rg >> 2) + 4 * hh;
                const int delta = 128 + q - 32 * t - keyl;
                const bool valid = tv && delta >= 0 && delta <= 128;
                const int dc = delta < 0 ? 0 : (delta > 128 ? 128 : delta);
                const float sv = valid ? S[t][rg] + biasL[hg * 132 + dc] : -1e30f;
                S[t][rg] = sv; mx = fmaxf(mx, sv);
            }
        }
        mx = fmaxf(mx, __shfl_xor(mx, 32));
        float lsum = 0.f;
#pragma unroll
        for (int t = 0; t < 5; ++t)
#pragma unroll
            for (int rg = 0; rg < 16; ++rg) { const float p = __expf(S[t][rg] - mx); S[t][rg] = p; lsum += p; }
        lsum += __shfl_xor(lsum, 32);
        f32x16 O[2];
#pragma unroll
        for (int dt = 0; dt < 2; ++dt)
#pragma unroll
            for (int rg = 0; rg < 16; ++rg) O[dt][rg] = 0.f;
        const int g16 = lane >> 4, i16 = lane & 15, qsel = i16 >> 2, psel = i16 & 3;
#pragma unroll
        for (int t = 0; t < 5; ++t) {
            const int kt = w + t;
            if (kt >= kt_lo) {
#pragma unroll
                for (int s2 = 0; s2 < 2; ++s2) {
                    bf16x8 pf;
                    { const unsigned w0 = cvt_pk_bf16(S[t][8 * s2 + 0], S[t][8 * s2 + 1]), w1 = cvt_pk_bf16(S[t][8 * s2 + 2], S[t][8 * s2 + 3]),
                                     w2 = cvt_pk_bf16(S[t][8 * s2 + 4], S[t][8 * s2 + 5]), w3 = cvt_pk_bf16(S[t][8 * s2 + 6], S[t][8 * s2 + 7]);
                      const u32x4 pw = (u32x4){w0, w1, w2, w3}; pf = __builtin_bit_cast(bf16x8, pw); }
#pragma unroll
                    for (int dt = 0; dt < 2; ++dt) {
                        const int krow = 32 * kt + 16 * s2 + 4 * hh + qsel;
                        const int ch = 4 * dt + 2 * (g16 & 1) + (psel >> 1);
                        const s16x4 lo = vtr(Vb + krow * 128 + ((ch ^ (krow & 7)) << 4) + (psel & 1) * 8);
                        const int krow2 = krow + 8;
                        const s16x4 hi = vtr(Vb + krow2 * 128 + ((ch ^ (krow2 & 7)) << 4) + (psel & 1) * 8);
                        const bf16x8 vf = (bf16x8){lo[0], lo[1], lo[2], lo[3], hi[0], hi[1], hi[2], hi[3]};
                        O[dt] = __builtin_amdgcn_mfma_f32_32x32x16_bf16(vf, pf, O[dt], 0, 0, 0);
                    }
                }
            }
        }
        {
            const float inv = 1.f / lsum;
            bf16* op = (bf16*)(F.ws + WS_OG) + ((size_t)g * NTOK + qrow) * 1024 + head * 64;
#pragma unroll
            for (int dt = 0; dt < 2; ++dt)
#pragma unroll
                for (int r4 = 0; r4 < 4; ++r4) {
                    u32x2 wv; wv.x = cvt_pk_bf16(O[dt][4 * r4 + 0] * inv, O[dt][4 * r4 + 1] * inv); wv.y = cvt_pk_bf16(O[dt][4 * r4 + 2] * inv, O[dt][4 * r4 + 3] * inv);
                    *(GAS u32x2*)(op + dt * 32 + 8 * r4 + 4 * hh) = wv;
                }
            if (hh == 0) ((float*)(F.ws + WS_LSE))[((size_t)g * NTOK + qrow) * 16 + head] = mx + __logf(lsum);
        }
        __syncthreads();
    }
}
__device__ __forceinline__ void phase_attn_combine(Frame& F) {
    const int gw = blockIdx.x * NWAVES + F.wave, NGW = F.G * NWAVES, lane = F.lane;
    const float* LSE = (const float*)(F.ws + WS_LSE); const bf16* OG = (const bf16*)(F.ws + WS_OG); bf16* OB = (bf16*)(F.ws + WS_OB);
    for (int tok = gw; tok < NTOK; tok += NGW) {
        const int head = lane >> 2;
        const float l0 = LSE[((size_t)0 * NTOK + tok) * 16 + head], l1 = LSE[((size_t)1 * NTOK + tok) * 16 + head], l2 = LSE[((size_t)2 * NTOK + tok) * 16 + head];
        const float m = fmaxf(l0, fmaxf(l1, l2));
        float a0 = __expf(l0 - m), a1 = __expf(l1 - m), a2 = __expf(l2 - m); const float inv = 1.f / (a0 + a1 + a2); a0 *= inv; a1 *= inv; a2 *= inv;
        const GAS u32x4* p0 = (const GAS u32x4*)(OG + ((size_t)0 * NTOK + tok) * 1024) + 2 * lane;
        const GAS u32x4* p1 = (const GAS u32x4*)(OG + ((size_t)1 * NTOK + tok) * 1024) + 2 * lane;
        const GAS u32x4* p2 = (const GAS u32x4*)(OG + ((size_t)2 * NTOK + tok) * 1024) + 2 * lane;
        GAS u32x4* po = (GAS u32x4*)(OB + (size_t)tok * 1024) + 2 * lane;
#pragma unroll
        for (int c = 0; c < 2; ++c) {
            const u32x4 v0 = p0[c], v1 = p1[c], v2 = p2[c]; u32x4 o;
#pragma unroll
            for (int k = 0; k < 4; ++k) {
                const float lo = a0 * bflo(v0[k]) + a1 * bflo(v1[k]) + a2 * bflo(v2[k]);
                const float hi = a0 * bfhi(v0[k]) + a1 * bfhi(v1[k]) + a2 * bfhi(v2[k]);
                o[k] = pk2(lo, hi);
            }
            po[c] = o;
        }
    }
}

constexpr int NPHASE = 15;
__global__ void __launch_bounds__(NTHREADS, 2) fwd_kernel(Args args) {
    extern __shared__ __attribute__((aligned(16))) unsigned char lds_raw[];
    Frame F;
    F.lds = (LAS unsigned char*)lds_raw;
    F.tid = threadIdx.x; F.lane = F.tid & 63; F.wave = __builtin_amdgcn_readfirstlane(F.tid >> 6); F.G = gridDim.x;
    F.ws = args.ws; F.out = args.out; F.ctl = (gu32*)(args.ws + WS_CTL);
    F.x = args.in[0]; F.norm_mix_g = args.in[1]; F.norm_ffn_g = args.in[2]; F.pool_w = args.in[3]; F.pool_scale = args.in[4]; F.w_qkv = args.in[5];
    F.q_gain = args.in[6]; F.k_gain = args.in[7]; F.w_o = args.in[8]; F.rel_bias = args.in[9]; F.w_router = args.in[10]; F.b_router = args.in[11];
    F.w_gu = args.in[12]; F.b_gu = args.in[13]; F.w_dn = args.in[14]; F.b_dn = args.in[15];
    if (F.tid < 16) ((LAS unsigned*)(F.lds + L_BARST))[F.tid] = 0u;
    __syncthreads();
    if (args.never) cg::this_grid().sync();
#if MK_MULTI
#define GRID_BAR() do { } while (0)
#else
    XcdBarrier bar = xcd_barrier_post((unsigned*)(F.ctl + CW_BAR), (volatile LAS unsigned*)(F.lds + L_BARST));
#define GRID_BAR() xcd_barrier(bar)
#endif
    const int lo = args.ph_lo, hi = args.ph_hi;
#define IN(k) (lo <= (k) && (k) < hi)
#define SEAM(k) do { if (IN(k) && IN((k) + 1)) GRID_BAR(); } while (0)
    if (IN(0)) phase_convert(F);          SEAM(0);
    if (IN(1)) phase_pool(F);             SEAM(1);
    if (IN(2)) phase_gather(F, 0);        SEAM(2);
    if (IN(3)) phase_moe_gu(F, 0);        SEAM(3);
    if (IN(4)) phase_moe_dn(F, 0);        SEAM(4);
    if (IN(5)) phase_combine(F, 0);       SEAM(5);
    if (IN(6)) phase_qkv(F);              SEAM(6);
    if (IN(7)) phase_attn(F);             SEAM(7);
    if (IN(8)) phase_attn_combine(F);     SEAM(8);
    if (IN(9)) phase_wo(F);               SEAM(9);
    if (IN(10)) phase_router(F, 1);       SEAM(10);
    if (IN(11)) phase_gather(F, 1);       SEAM(11);
    if (IN(12)) phase_moe_gu(F, 1);       SEAM(12);
    if (IN(13)) phase_moe_dn(F, 1);       SEAM(13);
    if (IN(14)) phase_combine(F, 1);
#undef IN
#undef SEAM
}

extern "C" void kernel_launch(void* const* d_in, const int* in_sizes, int n_in, void* d_out, int out_size, void* d_ws, size_t ws_size, hipStream_t stream) {
    static int grid = 0;
    if (grid == 0) {
        if (n_in != 16 || in_sizes[0] != NTOK * DM || out_size != NTOK * DM || ws_size < WS_END) {
            fprintf(stderr, "kernel_launch: unexpected shapes (n_in %d, in0 %d, out %d, ws %zu < %zu); nothing launched\n", n_in, n_in > 0 ? in_sizes[0] : -1, out_size, ws_size, (size_t)WS_END); grid = -1; return; }
        int dev = 0, cus = 0, per_cu = 0;
        if (hipGetDevice(&dev) != hipSuccess || hipDeviceGetAttribute(&cus, hipDeviceAttributeMultiprocessorCount, dev) != hipSuccess) { grid = -1; return; }
        if (hipFuncSetAttribute((const void*)fwd_kernel, hipFuncAttributeMaxDynamicSharedMemorySize, LDS_BYTES) != hipSuccess) { fprintf(stderr, "kernel_launch: hipFuncSetAttribute failed\n"); grid = -1; return; }
        if (hipOccupancyMaxActiveBlocksPerMultiprocessor(&per_cu, (const void*)fwd_kernel, NTHREADS, LDS_BYTES) != hipSuccess || per_cu < 1) { fprintf(stderr, "kernel_launch: occupancy query says %d blocks/CU\n", per_cu); (void)hipGetLastError(); grid = -1; return; }
        grid = cus;
    }
    if (grid < 0) return;
    if (hipMemsetAsync((char*)d_ws + WS_CTL, 0, CTL_BYTES, stream) != hipSuccess) { fprintf(stderr, "kernel_launch: memset failed\n"); return; }
    Args a{};
    for (int i = 0; i < 16; ++i) a.in[i] = (const float*)d_in[i];
    a.out = (float*)d_out; a.ws = (unsigned char*)d_ws; a.never = 0; a.pad = 0;
#if MK_MULTI
    for (int p = 0; p < NPHASE; ++p) { a.ph_lo = p; a.ph_hi = p + 1; hipLaunchKernelGGL(fwd_kernel, dim3(grid), dim3(NTHREADS), LDS_BYTES, stream, a); }
#else
    a.ph_lo = 0; a.ph_hi = NPHASE;
    void* kargs[] = {&a};
    hipError_t e = hipLaunchCooperativeKernel((const void*)fwd_kernel, dim3(grid), dim3(NTHREADS), kargs, LDS_BYTES, stream);
    if (e != hipSuccess) fprintf(stderr, "kernel_launch: cooperative launch failed: %s (grid %d)\n", hipGetErrorString(e), grid);
#endif
}
```

```cpp
#include <hip/hip_runtime.h>
#include <hip/hip_cooperative_groups.h>
#include <cstdio>
#include <cstdint>
namespace cg = cooperative_groups;

#ifndef MK_MULTI
#define MK_MULTI 0
#endif

#define LAS __attribute__((address_space(3)))
#define GAS __attribute__((address_space(1)))
typedef unsigned short bf16;
typedef short bf16x8 __attribute__((ext_vector_type(8)));
typedef short s16x4 __attribute__((ext_vector_type(4)));
typedef float f32x2 __attribute__((ext_vector_type(2)));
typedef float f32x4 __attribute__((ext_vector_type(4)));
typedef float f32x16 __attribute__((ext_vector_type(16)));
typedef unsigned u32x4 __attribute__((ext_vector_type(4)));
typedef unsigned u32x2 __attribute__((ext_vector_type(2)));
typedef GAS unsigned gu32;

constexpr int NTOK = 16384, DM = 1024, SEQ = 2048, NEXP = 32, TOPK = 4, FF = 1024, NQKV = 9216;
constexpr int CAP = 16384;
constexpr int MAXT = 288;
constexpr int PMAX = MAXT * 256;
constexpr float EPS = 1e-6f;
constexpr int NWAVES = 8, NTHREADS = 512;

constexpr size_t MiB = 1u << 20;
constexpr size_t WS_CTL = 0, CTL_BYTES = 1 * MiB;
constexpr size_t WS_WRT = 1 * MiB;
constexpr size_t WS_WPOOL = WS_WRT + 512 * 1024;
constexpr size_t WS_WO = 2 * MiB;
constexpr size_t WS_WQKV = 4 * MiB;
constexpr size_t WS_WGU = 22 * MiB;
constexpr size_t WS_WDN = WS_WGU + 256 * MiB;
constexpr size_t WS_ROWSLOT = WS_WDN + 128 * MiB;
constexpr size_t WS_ROWGATE = WS_ROWSLOT + 2 * MiB;
constexpr size_t WS_LSE = WS_ROWGATE + 2 * MiB;
constexpr size_t WS_H2 = WS_LSE + 3 * MiB;
constexpr size_t WS_BIG = WS_H2 + 32 * MiB;
constexpr size_t WS_XPAD = WS_BIG, WS_ACT = WS_BIG + 144 * MiB, WS_QKV = WS_BIG;
constexpr size_t WS_Y = WS_BIG + 288 * MiB;
constexpr size_t WS_OG = WS_Y, WS_OB = WS_Y + 96 * MiB;
constexpr size_t WS_END = WS_Y + 128 * MiB;
static_assert((size_t)PMAX * 1024 * 2 == 144 * MiB, "xpad size");
static_assert(WS_END <= 874 * MiB, "workspace map must fit the guaranteed d_ws size");
constexpr int CW_CNT = 64;
constexpr int CW_BAR = 4096;

constexpr int RING_BYTES = 131072;
constexpr int MISC_OFF = RING_BYTES;
constexpr int L_BARST = MISC_OFF + 0;
constexpr int L_CNT = MISC_OFF + 64;
constexpr int L_PROW0 = MISC_OFF + 192;
constexpr int L_NT = MISC_OFF + 320;
constexpr int L_TILEE = MISC_OFF + 336;
constexpr int L_TILEROW = MISC_OFF + 1488;
constexpr int L_HIST = MISC_OFF + 2640;
constexpr int L_BASE = MISC_OFF + 2768;
constexpr int L_SLOTE = MISC_OFF + 2896;
constexpr int L_SLOTP = MISC_OFF + 3920;
constexpr int L_SLOTG = MISC_OFF + 4944;
constexpr int L_RSTD = MISC_OFF + 5968;
constexpr int L_BIAS = MISC_OFF + 6288;
constexpr int L_BUCKET = MISC_OFF + 7344;
constexpr int LDS_BYTES = 147456;
static_assert(L_BUCKET + 3 * 132 * 4 <= LDS_BYTES, "LDS map");

#define RLX_AGENT __ATOMIC_RELAXED, __HIP_MEMORY_SCOPE_AGENT
#define LDS_WAIT() asm volatile("s_waitcnt lgkmcnt(0)" ::: "memory")
#define VM_WAIT() asm volatile("s_waitcnt vmcnt(0)" ::: "memory")
__device__ __forceinline__ unsigned f2bf(float f) { unsigned u = __builtin_bit_cast(unsigned, f); return (u + 0x7fffu + ((u >> 16) & 1u)) >> 16; }
__device__ __forceinline__ unsigned pk2(float lo, float hi) { return f2bf(lo) | (f2bf(hi) << 16); }
__device__ __forceinline__ float bf2f(unsigned short b) { return __builtin_bit_cast(float, ((unsigned)b) << 16); }
__device__ __forceinline__ float bflo(unsigned w) { return __builtin_bit_cast(float, w << 16); }
__device__ __forceinline__ float bfhi(unsigned w) { return __builtin_bit_cast(float, w & 0xffff0000u); }
__device__ __forceinline__ unsigned cvt_pk_bf16(float lo, float hi) { unsigned r; asm volatile("v_cvt_pk_bf16_f32 %0, %1, %2" : "=v"(r) : "v"(lo), "v"(hi)); return r; }
__device__ __forceinline__ float wave_sum(float v) {
#pragma unroll
    for (int o = 1; o < 64; o <<= 1) v += __shfl_xor(v, o);
    return v;
}

#define XB_TMO      128
#define XB_XCNT(j)  (256  + 64 * (j))
#define XB_XSUB(j)  (1280 + 64 * (j))
#define XB_XGEN(j)  (2304 + 64 * (j))
#define XB_TOP      3328
#define XB_TOPGEN   3392
#define XCD_BAR_WORDS 3456
#define XB_SPIN_CAP (1u << 20)
__device__ __forceinline__ unsigned xb_ld(unsigned* p)              { return __hip_atomic_load(p, __ATOMIC_RELAXED, __HIP_MEMORY_SCOPE_AGENT); }
__device__ __forceinline__ unsigned xb_add(unsigned* p, unsigned v) { return __hip_atomic_fetch_add(p, v, __ATOMIC_RELAXED, __HIP_MEMORY_SCOPE_AGENT); }
__device__ __forceinline__ unsigned xb_xcc_id() { return (unsigned)__builtin_amdgcn_s_getreg((3 << 11) | 20) & 0xFu; }
#define XB_SPIN(cond, bar) do { unsigned _sp = 0; while (cond) { __builtin_amdgcn_s_sleep(1); \
    if ((++_sp & 255u) == 0u) { if (xb_ld(&(bar)[XB_TMO])) break; if (_sp > XB_SPIN_CAP) { atomicAdd(&(bar)[XB_TMO], 1u); break; } } } } while (0)
struct XcdBarrier { unsigned* bar; unsigned x; volatile LAS unsigned* st; };
__device__ __forceinline__ XcdBarrier xcd_barrier_post(unsigned* bar, volatile LAS unsigned* st) {
    XcdBarrier b; b.bar = bar; b.x = xb_xcc_id(); b.st = st;
    if (threadIdx.x == 0) (void)xb_add(&bar[XB_XCNT(b.x)], 1u);
    return b;
}
__device__ __forceinline__ void xcd_barrier_complete(unsigned* bar, unsigned x, unsigned& nloc, unsigned& nx) {
    const unsigned G = gridDim.x * gridDim.y * gridDim.z;
    unsigned sum, cnt, mine, sp = 0u;
    for (;;) {
        sum = 0u; cnt = 0u; mine = 0u;
#pragma unroll
        for (unsigned j = 0; j < 16; ++j) { const unsigned c = xb_ld(&bar[XB_XCNT(j)]); sum += c; cnt += (c > 0u) ? 1u : 0u; mine = (j == x) ? c : mine; }
        if (sum == G) break;
        __builtin_amdgcn_s_sleep(1);
        if ((++sp & 255u) == 0u) { if (xb_ld(&bar[XB_TMO])) break; if (sp > XB_SPIN_CAP) { atomicAdd(&bar[XB_TMO], 1u); break; } }
    }
    nloc = mine > 0u ? mine : 1u; nx = cnt > 0u ? cnt : 1u;
}
__device__ __forceinline__ void xcd_barrier(const XcdBarrier& b) {
    asm volatile("s_waitcnt vmcnt(0)" ::: "memory");
    __syncthreads();
    if (threadIdx.x == 0) {
        unsigned* bar = b.bar;
        __builtin_amdgcn_s_waitcnt(0);
        unsigned nloc = b.st[0], nx = b.st[1];
        if (nloc == 0u) { xcd_barrier_complete(bar, b.x, nloc, nx); b.st[0] = nloc; b.st[1] = nx; }
        const unsigned old = xb_add(&bar[XB_XSUB(b.x)], 1u);
        const unsigned gen = old / nloc;
        if (old + 1u == (gen + 1u) * nloc) {
            __builtin_amdgcn_fence(__ATOMIC_RELEASE, "agent");
            asm volatile("s_waitcnt vmcnt(0)" ::: "memory");
            const unsigned og = xb_add(&bar[XB_TOP], 1u);
            const unsigned tg = og / nx;
            if (og + 1u == (tg + 1u) * nx) xb_add(&bar[XB_TOPGEN], 1u);
            else XB_SPIN(xb_ld(&bar[XB_TOPGEN]) == tg, bar);
            __builtin_amdgcn_fence(__ATOMIC_ACQUIRE, "agent");
            xb_add(&bar[XB_XGEN(b.x)], 1u);
            asm volatile("s_waitcnt vmcnt(0)" ::: "memory");
        } else {
            XB_SPIN(xb_ld(&bar[XB_XGEN(b.x)]) == gen, bar);
            __builtin_amdgcn_fence(__ATOMIC_ACQUIRE, "agent");
            asm volatile("s_waitcnt vmcnt(0)" ::: "memory");
        }
    }
    __syncthreads();
}

namespace pg8 {
constexpr int BM = 256, BK = 64, HALF = 128, HTB = HALF * BK * 2, STAGE_BYTES = 8 * HTB, NXCD = 8, WGM = 8, KD = 1024;
__host__ __device__ __forceinline__ int lds_byte(int r, int c) { const int st = (r >> 4) * 2 + (c >> 5), rr = r & 15, cc = c & 31, ob = rr * 64 + cc * 2; return st * 1024 + (ob ^ (((ob >> 9) & 1) << 5)); }
__host__ __device__ __forceinline__ void stage_rc(int b, int& R, int& C) { const int st = b / 1024, sb = b % 1024, swz = sb ^ (((sb >> 9) & 1) << 5); R = (st >> 1) * 16 + swz / 64; C = (st & 1) * 32 + (swz % 64) / 2; }
__host__ __device__ __forceinline__ int perm32(int rho) { const int n = rho >> 4, i = rho & 15; return 8 * (i >> 2) + 4 * n + (i & 3); }

struct Unit { const char* a; const char* b; int i0, i1, i2, i3; };

__device__ __forceinline__ bool tile_order(int i, int G, int c, int nM, int nN, int& pm, int& pn) {
    const int nwg = nM * nN; const long L = (long)i * G + c; if (L >= nwg) return false;
    int wgid = (int)L; { const int q = nwg / NXCD, r = nwg % NXCD, xcd = wgid % NXCD, off = wgid / NXCD; wgid = (xcd < r ? xcd * (q + 1) : r * (q + 1) + (xcd - r) * q) + off; }
    const int nig = WGM * nN, gid = wgid / nig, fm = gid * WGM, gsz = (nM - fm) < WGM ? (nM - fm) : WGM;
    pm = fm + ((wgid % nig) % gsz); pn = (wgid % nig) / gsz; return true;
}

template <class Epi, class Sched, bool ALIGN_EPI, bool SP2>
__device__ __forceinline__ void gemm_phase(LAS unsigned char* lds, const size_t hstepB, const Sched& S, const Epi& E) {
    const int tid = threadIdx.x, wid = __builtin_amdgcn_readfirstlane(tid >> 6), lane = tid & 63, wr = wid >> 2, wc = wid & 3, fr = lane & 15, fq = lane >> 4;
    constexpr int K = KD, nt = K / BK;
    unsigned voffA[2], voffB[2];
#pragma unroll
    for (int i = 0; i < 2; ++i) { int R, C; stage_rc(tid * 16 + i * 8192, R, C); const int Rb = Epi::brow(R);
        voffA[i] = (unsigned)(R * K + C) * 2u; voffB[i] = (unsigned)(Rb * K + C) * 2u; }
    const size_t kstep = (size_t)(BK * 2);
    const size_t hstepA = (size_t)HALF * K * 2;
    const unsigned ldsw = (unsigned)wid * 1024u;
    const int aoff = lds_byte(wr * 64 + fr, fq * 8), boff = lds_byte(wc * 32 + fr, fq * 8);
#define PG8_SA(b, h) (((b) * 2 + (h)) * HTB)
#define PG8_SB(b, h) ((4 + (b) * 2 + (h)) * HTB)
#define PG8_STAGE(bufoff, gbase, voff) do { _Pragma("unroll") for (int _i = 0; _i < 2; ++_i) \
        __builtin_amdgcn_global_load_lds((const unsigned*)((const char*)(gbase) + (voff)[_i]), (LAS unsigned*)(lds + (bufoff) + ldsw + _i * 8192), 16, 0, 0); } while (0)
#define PG8_LDA(dst, b, h) do { _Pragma("unroll") for (int m = 0; m < 4; ++m) _Pragma("unroll") for (int k = 0; k < 2; ++k) dst[m][k] = *(const LAS bf16x8*)(lds + PG8_SA(b, h) + aoff + m * 2048 + k * 1024); } while (0)
#define PG8_LDB(dst, b, h) do { _Pragma("unroll") for (int n = 0; n < 2; ++n) _Pragma("unroll") for (int k = 0; k < 2; ++k) dst[n][k] = *(const LAS bf16x8*)(lds + PG8_SB(b, h) + boff + n * 2048 + k * 1024); } while (0)
#define PG8_MMA(ai, bj, At, Bt) do { __builtin_amdgcn_s_setprio(1); _Pragma("unroll") for (int m = 0; m < 4; ++m) _Pragma("unroll") for (int n = 0; n < 2; ++n) _Pragma("unroll") for (int k = 0; k < 2; ++k) \
        acc[ai][bj][m][n] = __builtin_amdgcn_mfma_f32_16x16x32_bf16(Bt[n][k], At[m][k], acc[ai][bj][m][n], 0, 0, 0); __builtin_amdgcn_s_setprio(0); } while (0)
#define PG8_WAIT_V(n) asm volatile("s_waitcnt vmcnt(" #n ")" ::: "memory")
#define PG8_WAIT_L(n) asm volatile("s_waitcnt lgkmcnt(" #n ")" ::: "memory")
#define PG8_BAR __builtin_amdgcn_s_barrier()
#define PG8_SCHED __builtin_amdgcn_sched_barrier(0)
    Unit cur, nxt; int ui = 0;
    if (!S.next(0, cur)) return;
    f32x4 acc[2][2][4][2];
#pragma unroll
    for (int a = 0; a < 2; ++a)
#pragma unroll
        for (int b = 0; b < 2; ++b)
#pragma unroll
            for (int m = 0; m < 4; ++m)
#pragma unroll
                for (int n = 0; n < 2; ++n) acc[a][b][m][n] = (f32x4){0.f, 0.f, 0.f, 0.f};
    bf16x8 At[4][2], B0[2][2], B1[2][2];
    const char* cA = cur.a; const char* cB = cur.b;
    if constexpr (SP2) {
        PG8_STAGE(PG8_SB(0, 0), cB, voffB); PG8_STAGE(PG8_SB(0, 1), cB + hstepB, voffB); PG8_STAGE(PG8_SA(0, 0), cA, voffA); PG8_STAGE(PG8_SA(0, 1), cA + hstepA, voffA);
        if (wr == 1) PG8_BAR;
        PG8_WAIT_V(2); PG8_BAR;
        PG8_STAGE(PG8_SB(1, 0), cB + kstep, voffB); PG8_STAGE(PG8_SA(1, 0), cA + kstep, voffA); PG8_STAGE(PG8_SB(1, 1), cB + hstepB + kstep, voffB);
        PG8_WAIT_V(6); PG8_BAR;
    } else {
        PG8_STAGE(PG8_SB(0, 0), cB, voffB); PG8_STAGE(PG8_SA(0, 0), cA, voffA); PG8_STAGE(PG8_SB(0, 1), cB + hstepB, voffB); PG8_STAGE(PG8_SA(0, 1), cA + hstepA, voffA);
        if (wr == 1) PG8_BAR;
        PG8_WAIT_V(4); PG8_BAR;
        PG8_STAGE(PG8_SB(1, 0), cB + kstep, voffB); PG8_STAGE(PG8_SA(1, 0), cA + kstep, voffA); PG8_STAGE(PG8_SB(1, 1), cB + hstepB + kstep, voffB);
        PG8_WAIT_V(6); PG8_BAR;
    }
    for (;;) {
        const bool has_next = S.next(ui + 1, nxt);
        const char* nA = has_next ? nxt.a : cA; const char* nB = has_next ? nxt.b : cB;
        for (int t = 0; t < nt; t += 2) {
            const bool last = (t == nt - 2);
            const char* a1 = cA + (size_t)(t + 1) * kstep;
            const char* a2 = last ? nA : cA + (size_t)(t + 2) * kstep; const char* b2 = last ? nB : cB + (size_t)(t + 2) * kstep;
            const char* a3 = a2 + kstep; const char* b3 = b2 + kstep;
            if constexpr (SP2) {
            PG8_LDB(B0, 0, 0); PG8_LDB(B1, 0, 1); PG8_SCHED; PG8_LDA(At, 0, 0); PG8_STAGE(PG8_SA(1, 1), a1 + hstepA, voffA);
            PG8_WAIT_V(8); PG8_WAIT_L(0); PG8_BAR; PG8_MMA(0, 0, At, B0); PG8_MMA(0, 1, At, B1); PG8_BAR; PG8_SCHED;
            PG8_LDA(At, 0, 1); PG8_STAGE(PG8_SB(0, 0), b2, voffB); PG8_STAGE(PG8_SB(0, 1), b2 + hstepB, voffB); PG8_STAGE(PG8_SA(0, 0), a2, voffA);
            PG8_WAIT_V(8); PG8_WAIT_L(0); PG8_BAR; PG8_MMA(1, 0, At, B0); PG8_MMA(1, 1, At, B1); PG8_BAR; PG8_SCHED;
            PG8_LDB(B0, 1, 0); PG8_LDB(B1, 1, 1); PG8_SCHED; PG8_LDA(At, 1, 0); PG8_STAGE(PG8_SA(0, 1), a2 + hstepA, voffA);
            PG8_WAIT_V(8); PG8_WAIT_L(0); PG8_BAR; PG8_MMA(0, 0, At, B0); PG8_MMA(0, 1, At, B1); PG8_BAR; PG8_SCHED;
            PG8_LDA(At, 1, 1); PG8_STAGE(PG8_SB(1, 0), b3, voffB); PG8_STAGE(PG8_SB(1, 1), b3 + hstepB, voffB); PG8_STAGE(PG8_SA(1, 0), a3, voffA);
            PG8_WAIT_V(8); PG8_WAIT_L(0); PG8_BAR; PG8_MMA(1, 0, At, B0); PG8_MMA(1, 1, At, B1); PG8_BAR; PG8_SCHED;
            } else {
            PG8_LDB(B0, 0, 0); PG8_SCHED; PG8_LDA(At, 0, 0); PG8_STAGE(PG8_SA(1, 1), a1 + hstepA, voffA);
            PG8_WAIT_L(8); PG8_BAR; PG8_WAIT_L(0); PG8_MMA(0, 0, At, B0); PG8_BAR; PG8_SCHED;
            PG8_LDB(B1, 0, 1); PG8_STAGE(PG8_SB(0, 0), b2, voffB);
            PG8_BAR; PG8_WAIT_L(0); PG8_MMA(0, 1, At, B1); PG8_BAR;
            PG8_LDA(At, 0, 1); PG8_STAGE(PG8_SA(0, 0), a2, voffA);
            PG8_BAR; PG8_WAIT_L(0); PG8_MMA(1, 0, At, B0); PG8_BAR; PG8_SCHED;
            PG8_STAGE(PG8_SB(0, 1), b2 + hstepB, voffB);
            PG8_WAIT_V(6); PG8_BAR; PG8_MMA(1, 1, At, B1); PG8_BAR;
            PG8_LDB(B0, 1, 0); PG8_SCHED; PG8_LDA(At, 1, 0); PG8_STAGE(PG8_SA(0, 1), a2 + hstepA, voffA);
            PG8_WAIT_L(8); PG8_BAR; PG8_WAIT_L(0); PG8_MMA(0, 0, At, B0); PG8_BAR; PG8_SCHED;
            PG8_LDB(B1, 1, 1); PG8_STAGE(PG8_SB(1, 0), b3, voffB);
            PG8_BAR; PG8_WAIT_L(0); PG8_MMA(0, 1, At, B1); PG8_BAR;
            PG8_LDA(At, 1, 1); PG8_STAGE(PG8_SA(1, 0), a3, voffA);
            PG8_BAR; PG8_WAIT_L(0); PG8_MMA(1, 0, At, B0); PG8_BAR; PG8_SCHED;
            PG8_STAGE(PG8_SB(1, 1), b3 + hstepB, voffB);
            PG8_WAIT_V(6); PG8_BAR; PG8_MMA(1, 1, At, B1); PG8_BAR;
            }
        }
        if constexpr (ALIGN_EPI) { if (wr == 0) PG8_BAR; }
        E(acc, cur, wr, wc, fr, fq);
        if (!has_next) break;
#pragma unroll
        for (int a = 0; a < 2; ++a)
#pragma unroll
            for (int b = 0; b < 2; ++b)
#pragma unroll
                for (int m = 0; m < 4; ++m)
#pragma unroll
                    for (int n = 0; n < 2; ++n) acc[a][b][m][n] = (f32x4){0.f, 0.f, 0.f, 0.f};
        cur = nxt; cA = nA; cB = nB; ++ui;
        if constexpr (ALIGN_EPI) { if (wr == 1) PG8_BAR; }
    }
    PG8_WAIT_V(0);
    if constexpr (!ALIGN_EPI) { if (wr == 0) PG8_BAR; }
    PG8_BAR;
#undef PG8_SA
#undef PG8_SB
#undef PG8_STAGE
#undef PG8_LDA
#undef PG8_LDB
#undef PG8_MMA
#undef PG8_WAIT_V
#undef PG8_WAIT_L
#undef PG8_BAR
#undef PG8_SCHED
}
}

struct Args { const float* in[16]; float* out; unsigned char* ws; int ph_lo, ph_hi; int never, pad; };
struct Frame {
    LAS unsigned char* lds;
    gu32* ctl;
    int tid, lane, wave, G;
    const float *x, *norm_mix_g, *norm_ffn_g, *pool_w, *pool_scale, *w_qkv, *q_gain, *k_gain, *w_o, *rel_bias, *w_router, *b_router, *w_gu, *b_gu, *w_dn, *b_dn;
    float* out; unsigned char* ws;
};

__device__ __forceinline__ void transpose_item(const float* W, int K, int N, bf16* WT, LAS float* scr, int item, int lane) {
    const int nblk = N / 32, kb = item / nblk, nb = item % nblk, k0 = 64 * kb, n0 = 32 * nb;
#pragma unroll 8
    for (int i = 0; i < 32; ++i) { const int kk = 2 * i + (lane >> 5); scr[kk * 33 + (lane & 31)] = W[(size_t)(k0 + kk) * N + n0 + (lane & 31)]; }
    LDS_WAIT(); asm volatile("" ::: "memory");
    const int c = lane & 7;
#pragma unroll
    for (int j = 0; j < 4; ++j) { const int n = (lane >> 3) + 8 * j; const LAS float* s = scr + (8 * c) * 33 + n;
        u32x4 o; o.x = pk2(s[0 * 33], s[1 * 33]); o.y = pk2(s[2 * 33], s[3 * 33]); o.z = pk2(s[4 * 33], s[5 * 33]); o.w = pk2(s[6 * 33], s[7 * 33]);
        *(GAS u32x4*)(WT + (size_t)(n0 + n) * K + k0 + 8 * c) = o; }
    LDS_WAIT(); asm volatile("" ::: "memory");
}
__device__ __forceinline__ void phase_convert(Frame& F) {
    LAS float* scr = (LAS float*)(F.lds + F.wave * 16384);
    const int gw = blockIdx.x * NWAVES + F.wave, NGW = F.G * NWAVES;
    constexpr int I_GU = 64 * 1024, I_DN = 64 * 512, I_QKV = 16 * 288, I_WO = 512, I_POOL = 4 * 32;
    constexpr int NITEMS = I_GU + I_DN + I_QKV + I_WO + I_POOL;
    for (int it = gw; it < NITEMS; it += NGW) {
        int r = it;
        if (r < I_GU) { const int mat = r >> 10; transpose_item(F.w_gu + (size_t)mat * 1024 * 2048, 1024, 2048, (bf16*)(F.ws + WS_WGU) + (size_t)mat * 2048 * 1024, scr, r & 1023, F.lane); continue; } r -= I_GU;
        if (r < I_DN) { const int mat = r >> 9; transpose_item(F.w_dn + (size_t)mat * 1024 * 1024, 1024, 1024, (bf16*)(F.ws + WS_WDN) + (size_t)mat * 1024 * 1024, scr, r & 511, F.lane); continue; } r -= I_DN;
        if (r < I_QKV) { transpose_item(F.w_qkv, 1024, NQKV, (bf16*)(F.ws + WS_WQKV), scr, r, F.lane); continue; } r -= I_QKV;
        if (r < I_WO) { transpose_item(F.w_o, 1024, 1024, (bf16*)(F.ws + WS_WO), scr, r, F.lane); continue; } r -= I_WO;
        { const int mat = r >> 5; transpose_item(F.pool_w + (size_t)mat * 65536, 256, 256, (bf16*)(F.ws + WS_WPOOL) + (size_t)mat * 65536, scr, r & 31, F.lane); }
    }
    float* wrt = (float*)(F.ws + WS_WRT);
    for (int i = blockIdx.x * NTHREADS + F.tid; i < 2 * 32 * 1024; i += F.G * NTHREADS) { const int l = i >> 15, e = (i >> 10) & 31, c = i & 1023; wrt[i] = F.w_router[(size_t)l * 32768 + c * 32 + e]; }
}

__device__ __forceinline__ void router_tile(Frame& F, int layer, int tok0) {
    LAS int* hist = (LAS int*)(F.lds + L_HIST); LAS int* base = (LAS int*)(F.lds + L_BASE);
    LAS int* slot_e = (LAS int*)(F.lds + L_SLOTE); LAS int* slot_p = (LAS int*)(F.lds + L_SLOTP); LAS float* slot_g = (LAS float*)(F.lds + L_SLOTG);
    const int lane = F.lane;
    if (F.tid < 32) hist[F.tid] = 0;
    __syncthreads();
    const float* wrt = (const float*)(F.ws + WS_WRT) + (size_t)layer * 32 * 1024;
    const float* g2 = F.norm_ffn_g + layer * 1024;
    bf16* H2 = (bf16*)(F.ws + WS_H2);
    f32x4 gv[4];
#pragma unroll
    for (int j = 0; j < 4; ++j) gv[j] = *(const f32x4*)(g2 + lane * 4 + 256 * j);
    const float brl = (lane < 32) ? F.b_router[layer * 32 + lane] : 0.f;
    for (int half = 0; half < 2; ++half) {
        const int rb = F.wave * 8 + half * 4;
        f32x4 h[4][4];
#pragma unroll
        for (int r = 0; r < 4; ++r) {
            const int tok = tok0 + rb + r;
            const GAS f32x4* xr = (const GAS f32x4*)(F.out + (size_t)tok * 1024) + lane;
            float ss = 0.f;
#pragma unroll
            for (int j = 0; j < 4; ++j) { h[r][j] = xr[64 * j]; ss += (h[r][j].x * h[r][j].x + h[r][j].y * h[r][j].y) + (h[r][j].z * h[r][j].z + h[r][j].w * h[r][j].w); }
            const float rstd = rsqrtf(wave_sum(ss) * (1.f / 1024.f) + EPS);
            GAS u32x2* o8 = (GAS u32x2*)(H2 + (size_t)tok * 1024) + lane;
#pragma unroll
            for (int j = 0; j < 4; ++j) { h[r][j] = h[r][j] * rstd * gv[j]; u32x2 w; w.x = pk2(h[r][j].x, h[r][j].y); w.y = pk2(h[r][j].z, h[r][j].w); o8[64 * j] = w; }
        }
        float lg[4] = {0.f, 0.f, 0.f, 0.f};
        for (int e = 0; e < 32; ++e) {
            f32x4 w[4];
#pragma unroll
            for (int j = 0; j < 4; ++j) w[j] = *(const f32x4*)(wrt + e * 1024 + lane * 4 + 256 * j);
#pragma unroll
            for (int r = 0; r < 4; ++r) {
                float p = 0.f;
#pragma unroll
                for (int j = 0; j < 4; ++j) p += (h[r][j].x * w[j].x + h[r][j].y * w[j].y) + (h[r][j].z * w[j].z + h[r][j].w * w[j].w);
                p = wave_sum(p);
                lg[r] = (lane == e) ? p : lg[r];
            }
        }
#pragma unroll
        for (int r = 0; r < 4; ++r) {
            float v = (lane < 32) ? lg[r] + brl : -INFINITY;
            float tv[4]; int ti[4];
#pragma unroll
            for (int k = 0; k < 4; ++k) {
                float bv = v; int bi = lane;
#pragma unroll
                for (int off = 32; off >= 1; off >>= 1) { const float ov = __shfl_xor(bv, off); const int oi = __shfl_xor(bi, off); if (ov > bv || (ov == bv && oi < bi)) { bv = ov; bi = oi; } }
                tv[k] = bv; ti[k] = bi; if (lane == bi) v = -INFINITY;
            }
            const float e1 = __expf(tv[1] - tv[0]), e2 = __expf(tv[2] - tv[0]), e3 = __expf(tv[3] - tv[0]);
            const float inv = 1.f / (1.f + e1 + e2 + e3);
            if (lane < 4) {
                const int e = lane == 0 ? ti[0] : lane == 1 ? ti[1] : lane == 2 ? ti[2] : ti[3];
                const float gt = (lane == 0 ? 1.f : lane == 1 ? e1 : lane == 2 ? e2 : e3) * inv;
                const int lp = atomicAdd((int*)(hist + e), 1);
                const int s = (rb + r) * 4 + lane;
                slot_e[s] = e; slot_p[s] = lp; slot_g[s] = gt;
            }
        }
    }
    __syncthreads();
    if (F.tid < 32) base[F.tid] = (int)__hip_atomic_fetch_add((unsigned*)(F.ctl + CW_CNT + layer * 32 + F.tid), (unsigned)hist[F.tid], RLX_AGENT);
    __syncthreads();
    if (F.tid < 256) {
        const int e = slot_e[F.tid]; const int pos = base[e] + slot_p[F.tid];
        ((int*)(F.ws + WS_ROWSLOT))[e * CAP + pos] = (tok0 + (F.tid >> 2)) * 4 + (F.tid & 3);
        ((float*)(F.ws + WS_ROWGATE))[e * CAP + pos] = slot_g[F.tid];
    }
    __syncthreads();
}

__device__ __forceinline__ int pswz(int r, int c) { return r * 2048 + ((((c >> 3) ^ (r & 7)) << 4) | ((c & 7) << 1)); }
template <int W>
__device__ __forceinline__ void pool_window(const float* x, int tok0, int s0, const LAS float* rstd1, float gx, float gy, LAS unsigned char* P, int tid) {
    float rx[W], ry[W];
    const GAS f32x2* xp = (const GAS f32x2*)x + tid;
#pragma unroll
    for (int j = 0; j < W; ++j) { const int s = s0 - W + j; float hx = 0.f, hy = 0.f;
        if (s >= 0) { const f32x2 v = xp[(size_t)(tok0 - W + j) * 512]; const float r = rstd1[16 - W + j]; hx = v.x * r * gx; hy = v.y * r * gy; }
        rx[j] = hx; ry[j] = hy; }
    for (int sc = 0; sc < 4; ++sc) {
        f32x2 v[16];
#pragma unroll
        for (int j = 0; j < 16; ++j) v[j] = xp[(size_t)(tok0 + sc * 16 + j) * 512];
#pragma unroll
        for (int j = 0; j < 16; ++j) {
            const int tl = sc * 16 + j; const float r = rstd1[16 + tl];
            const float hx = v[j].x * r * gx, hy = v[j].y * r * gy;
            rx[j % W] = hx; ry[j % W] = hy;
            float sx = 0.f, sy = 0.f;
#pragma unroll
            for (int q = 0; q < W; ++q) { sx += rx[q]; sy += ry[q]; }
            const int s = s0 + tl; const int cn = (s + 1 < W) ? (s + 1) : W; const float inv = 1.f / (float)cn;
            *(LAS unsigned*)(P + pswz(tl, 2 * tid)) = pk2(sx * inv - hx, sy * inv - hy);
        }
    }
}
__device__ __forceinline__ void phase_pool(Frame& F) {
    LAS unsigned char* P = F.lds;
    LAS float* rstd1 = (LAS float*)(F.lds + L_RSTD);
    const int lane = F.lane, wave = F.wave, tid = F.tid;
    const int fr = lane & 15, fq = lane >> 4;
    for (int tile = blockIdx.x; tile < NTOK / 64; tile += F.G) {
        const int tok0 = tile * 64, s0 = tok0 & (SEQ - 1);
        for (int rr = wave; rr < 80; rr += 8) {
            const int s = s0 - 16 + rr; float r = 0.f;
            if (s >= 0) {
                const GAS f32x4* xr = (const GAS f32x4*)(F.x + (size_t)(tok0 - 16 + rr) * 1024) + lane; float ss = 0.f;
#pragma unroll
                for (int j = 0; j < 4; ++j) { const f32x4 v = xr[64 * j]; ss += (v.x * v.x + v.y * v.y) + (v.z * v.z + v.w * v.w); }
                r = rsqrtf(wave_sum(ss) * (1.f / 1024.f) + EPS);
            }
            if (lane == 0) rstd1[rr] = r;
        }
        __syncthreads();
        { const float gx = F.norm_mix_g[2 * tid], gy = F.norm_mix_g[2 * tid + 1];
          const int grp = wave >> 1;
          if (grp == 0) pool_window<2>(F.x, tok0, s0, rstd1, gx, gy, P, tid);
          else if (grp == 1) pool_window<4>(F.x, tok0, s0, rstd1, gx, gy, P, tid);
          else if (grp == 2) pool_window<8>(F.x, tok0, s0, rstd1, gx, gy, P, tid);
          else pool_window<16>(F.x, tok0, s0, rstd1, gx, gy, P, tid); }
        __syncthreads();
        { const int gi = wave >> 1, nh = wave & 1;
          const bf16* Wt = (const bf16*)(F.ws + WS_WPOOL) + (size_t)gi * 65536 + (size_t)(nh * 128) * 256;
          f32x4 acc[4][8];
#pragma unroll
          for (int m = 0; m < 4; ++m)
#pragma unroll
              for (int n = 0; n < 8; ++n) acc[m][n] = (f32x4){0.f, 0.f, 0.f, 0.f};
#pragma unroll 2
          for (int ks = 0; ks < 8; ++ks) {
              bf16x8 a[4];
#pragma unroll
              for (int m = 0; m < 4; ++m) a[m] = *(const LAS bf16x8*)(P + pswz(m * 16 + fr, gi * 256 + ks * 32 + fq * 8));
#pragma unroll
              for (int n = 0; n < 8; ++n) {
                  const bf16x8 b = *(const GAS bf16x8*)(Wt + (size_t)(n * 16 + fr) * 256 + ks * 32 + fq * 8);
#pragma unroll
                  for (int m = 0; m < 4; ++m) acc[m][n] = __builtin_amdgcn_mfma_f32_16x16x32_bf16(b, a[m], acc[m][n], 0, 0, 0);
              }
          }
#pragma unroll
          for (int n = 0; n < 8; ++n) {
              const int col = gi * 256 + nh * 128 + n * 16 + fq * 4;
              const f32x4 sc = *(const f32x4*)(F.pool_scale + col);
#pragma unroll
              for (int m = 0; m < 4; ++m) {
                  const size_t off = (size_t)(tok0 + m * 16 + fr) * 1024 + col;
                  const f32x4 xv = *(const GAS f32x4*)(F.x + off);
                  *(GAS f32x4*)(F.out + off) = xv + acc[m][n] * sc;
              }
          }
        }
        VM_WAIT();
        __syncthreads();
        router_tile(F, 0, tok0);
    }
}
__device__ __forceinline__ void phase_router(Frame& F, int layer) {
    for (int tile = blockIdx.x; tile < NTOK / 64; tile += F.G) router_tile(F, layer, tile * 64);
}

__device__ __forceinline__ void moe_tables(Frame& F, int layer) {
    LAS int* cntL = (LAS int*)(F.lds + L_CNT); LAS int* prow0 = (LAS int*)(F.lds + L_PROW0); LAS int* ntp = (LAS int*)(F.lds + L_NT);
    LAS int* tileE = (LAS int*)(F.lds + L_TILEE); LAS int* tileRow = (LAS int*)(F.lds + L_TILEROW);
    __syncthreads();
    if (F.tid == 0) {
        int acc = 0, T = 0;
        for (int e = 0; e < 32; ++e) {
            int c = (int)__hip_atomic_load((unsigned*)(F.ctl + CW_CNT + layer * 32 + e), RLX_AGENT);
            if (c > CAP) c = CAP;
            cntL[e] = c; prow0[e] = acc;
            const int mt = (c + 255) >> 8;
            for (int m = 0; m < mt && T < MAXT; ++m) { tileE[T] = e; tileRow[T] = acc + m * 256; ++T; }
            acc += mt * 256;
        }
        ntp[0] = T;
    }
    __syncthreads();
}
__device__ __forceinline__ void phase_gather(Frame& F, int layer) {
    moe_tables(F, layer);
    const LAS int* cntL = (const LAS int*)(F.lds + L_CNT); const LAS int* prow0 = (const LAS int*)(F.lds + L_PROW0);
    const LAS int* tileE = (const LAS int*)(F.lds + L_TILEE);
    const int NT = *(const LAS int*)(F.lds + L_NT);
    const int gw = blockIdx.x * NWAVES + F.wave, NGW = F.G * NWAVES;
    const int* rowslot = (const int*)(F.ws + WS_ROWSLOT);
    const bf16* H2 = (const bf16*)(F.ws + WS_H2); bf16* XP = (bf16*)(F.ws + WS_XPAD);
    for (int pr = gw; pr < NT * 256; pr += NGW) {
        const int e = tileE[pr >> 8]; const int pos = pr - prow0[e];
        if (pos < cntL[e]) {
            const int tok = rowslot[e * CAP + pos] >> 2;
            const GAS u32x4* src = (const GAS u32x4*)(H2 + (size_t)tok * 1024) + F.lane;
            GAS u32x4* dst = (GAS u32x4*)(XP + (size_t)pr * 1024) + F.lane;
            const u32x4 v0 = src[0], v1 = src[64];
            dst[0] = v0; dst[64] = v1;
        }
    }
}

struct MoeOrder {
    int NT, nN, G, c; const LAS int* tileE; const LAS int* tileRow; const char* Abase; const char* Bbase; size_t bExp, bTile;
    __device__ __forceinline__ bool next(int i, pg8::Unit& u) const {
        int T, pn; if (!pg8::tile_order(i, G, c, NT, nN, T, pn)) return false;
        const int e = tileE[T], row0 = tileRow[T];
        u.a = Abase + (size_t)row0 * 2048; u.b = Bbase + (size_t)e * bExp + (size_t)pn * bTile; u.i0 = T; u.i1 = pn; u.i2 = e; u.i3 = row0; return true;
    }
};
struct EpiGU {
    static __host__ __device__ __forceinline__ int brow(int R) { return (R & ~31) + pg8::perm32(R & 31); }
    bf16* ACT; const float* bgu;
    __device__ __forceinline__ void operator()(const f32x4 (&acc)[2][2][4][2], const pg8::Unit& u, int wr, int wc, int fr, int fq) const {
        const int e = u.i2, f0 = u.i1 * 128 + wc * 32 + 8 * fq;
        const float* bg = bgu + (size_t)e * 2048 + f0;
        const f32x4 bg0 = *(const f32x4*)(bg), bg1 = *(const f32x4*)(bg + 4), bu0 = *(const f32x4*)(bg + 1024), bu1 = *(const f32x4*)(bg + 1028);
#pragma unroll
        for (int ai = 0; ai < 2; ++ai)
#pragma unroll
            for (int m = 0; m < 4; ++m) {
                bf16* rowp = ACT + (size_t)(u.i3 + ai * 128 + wr * 64 + m * 16 + fr) * 1024 + f0;
                const f32x4 g0 = acc[ai][0][m][0] + bg0, g1 = acc[ai][0][m][1] + bg1, u0 = acc[ai][1][m][0] + bu0, u1 = acc[ai][1][m][1] + bu1;
                float o[8];
#pragma unroll
                for (int j = 0; j < 8; ++j) {
                    const float g = fminf(j < 4 ? g0[j & 3] : g1[j & 3], 7.f);
                    const float up = fminf(fmaxf(j < 4 ? u0[j & 3] : u1[j & 3], -7.f), 7.f);
                    const float sg = __builtin_amdgcn_rcpf(1.f + __builtin_amdgcn_exp2f(-1.702f * 1.4426950408889634f * g));
                    o[j] = (up + 1.f) * (g * sg);
                }
                u32x4 w; w.x = cvt_pk_bf16(o[0], o[1]); w.y = cvt_pk_bf16(o[2], o[3]); w.z = cvt_pk_bf16(o[4], o[5]); w.w = cvt_pk_bf16(o[6], o[7]);
                *(GAS u32x4*)rowp = w;
            }
    }
};
struct EpiDN {
    static __host__ __device__ __forceinline__ int brow(int R) { return (R & ~31) + pg8::perm32(R & 31); }
    bf16* Y; const float* bdn; const int* rowslot; const float* rowgate; const LAS int* cntL; const LAS int* prow0;
    __device__ __forceinline__ void operator()(const f32x4 (&acc)[2][2][4][2], const pg8::Unit& u, int wr, int wc, int fr, int fq) const {
        const int e = u.i2, col0 = u.i1 * 256 + wc * 32 + 8 * fq;
        const float* bp = bdn + (size_t)e * 1024 + col0;
        f32x4 bv[2][2];
#pragma unroll
        for (int bj = 0; bj < 2; ++bj)
#pragma unroll
            for (int n = 0; n < 2; ++n) bv[bj][n] = *(const f32x4*)(bp + bj * 128 + 4 * n);
        const int pbase = u.i3 - prow0[e], cn = cntL[e];
#pragma unroll
        for (int ai = 0; ai < 2; ++ai)
#pragma unroll
            for (int m = 0; m < 4; ++m) {
                const int pos = pbase + ai * 128 + wr * 64 + m * 16 + fr;
                if (pos < cn) {
                    const int slot = rowslot[e * CAP + pos]; const float gt = rowgate[e * CAP + pos];
                    bf16* rowp = Y + (size_t)slot * 1024 + col0;
#pragma unroll
                    for (int bj = 0; bj < 2; ++bj) {
                        const f32x4 v0 = (acc[ai][bj][m][0] + bv[bj][0]) * gt, v1 = (acc[ai][bj][m][1] + bv[bj][1]) * gt;
                        u32x4 w; w.x = cvt_pk_bf16(v0[0], v0[1]); w.y = cvt_pk_bf16(v0[2], v0[3]); w.z = cvt_pk_bf16(v1[0], v1[1]); w.w = cvt_pk_bf16(v1[2], v1[3]);
                        *(GAS u32x4*)(rowp + bj * 128) = w;
                    }
                }
            }
    }
};
__device__ __forceinline__ void phase_moe_gu(Frame& F, int layer) {
    moe_tables(F, layer);
    MoeOrder S; S.NT = *(const LAS int*)(F.lds + L_NT); S.nN = 8; S.G = F.G; S.c = blockIdx.x; S.tileE = (const LAS int*)(F.lds + L_TILEE); S.tileRow = (const LAS int*)(F.lds + L_TILEROW);
    S.Abase = (const char*)(F.ws + WS_XPAD); S.Bbase = (const char*)(F.ws + WS_WGU) + (size_t)layer * 32 * 2048 * 1024 * 2; S.bExp = (size_t)2048 * 1024 * 2; S.bTile = (size_t)128 * 1024 * 2;
    EpiGU E; E.ACT = (bf16*)(F.ws + WS_ACT); E.bgu = F.b_gu + (size_t)layer * 32 * 2048;
    pg8::gemm_phase<EpiGU, MoeOrder, true, true>(F.lds, (size_t)1024 * 1024 * 2, S, E);
}
__device__ __forceinline__ void phase_moe_dn(Frame& F, int layer) {
    moe_tables(F, layer);
    MoeOrder S; S.NT = *(const LAS int*)(F.lds + L_NT); S.nN = 4; S.G = F.G; S.c = blockIdx.x; S.tileE = (const LAS int*)(F.lds + L_TILEE); S.tileRow = (const LAS int*)(F.lds + L_TILEROW);
    S.Abase = (const char*)(F.ws + WS_ACT); S.Bbase = (const char*)(F.ws + WS_WDN) + (size_t)layer * 32 * 1024 * 1024 * 2; S.bExp = (size_t)1024 * 1024 * 2; S.bTile = (size_t)256 * 1024 * 2;
    EpiDN E; E.Y = (bf16*)(F.ws + WS_Y); E.bdn = F.b_dn + (size_t)layer * 32 * 1024; E.rowslot = (const int*)(F.ws + WS_ROWSLOT); E.rowgate = (const float*)(F.ws + WS_ROWGATE);
    E.cntL = (const LAS int*)(F.lds + L_CNT); E.prow0 = (const LAS int*)(F.lds + L_PROW0);
    pg8::gemm_phase<EpiDN, MoeOrder, true, true>(F.lds, (size_t)128 * 1024 * 2, S, E);
}

__device__ __forceinline__ void phase_combine(Frame& F, int layer) {
    const int gw = blockIdx.x * NWAVES + F.wave, NGW = F.G * NWAVES, lane = F.lane;
    const bf16* Y = (const bf16*)(F.ws + WS_Y); bf16* H2 = (bf16*)(F.ws + WS_H2);
    f32x4 gv[4];
#pragma unroll
    for (int j = 0; j < 4; ++j) gv[j] = *(const f32x4*)(F.norm_mix_g + 1024 + lane * 4 + 256 * j);
    for (int tok = gw; tok < NTOK; tok += NGW) {
        GAS f32x4* xr = (GAS f32x4*)(F.out + (size_t)tok * 1024) + lane;
        f32x4 v[4];
#pragma unroll
        for (int j = 0; j < 4; ++j) v[j] = xr[64 * j];
#pragma unroll
        for (int k = 0; k < 4; ++k) {
            const GAS u32x2* yr = (const GAS u32x2*)(Y + (size_t)(tok * 4 + k) * 1024) + lane;
#pragma unroll
            for (int j = 0; j < 4; ++j) { const u32x2 w = yr[64 * j]; v[j].x += bflo(w.x); v[j].y += bfhi(w.x); v[j].z += bflo(w.y); v[j].w += bfhi(w.y); }
        }
        float ss = 0.f;
#pragma unroll
        for (int j = 0; j < 4; ++j) { xr[64 * j] = v[j]; ss += (v[j].x * v[j].x + v[j].y * v[j].y) + (v[j].z * v[j].z + v[j].w * v[j].w); }
        if (layer == 0) {
            const float rstd = rsqrtf(wave_sum(ss) * (1.f / 1024.f) + EPS);
            GAS u32x2* o8 = (GAS u32x2*)(H2 + (size_t)tok * 1024) + lane;
#pragma unroll
            for (int j = 0; j < 4; ++j) { const f32x4 h = v[j] * rstd * gv[j]; u32x2 w; w.x = pk2(h.x, h.y); w.y = pk2(h.z, h.w); o8[64 * j] = w; }
        }
    }
}

struct DenseOrder {
    int nM, nN, G, c; const char* Abase; const char* Bbase;
    __device__ __forceinline__ bool next(int i, pg8::Unit& u) const {
        int pm, pn; if (!pg8::tile_order(i, G, c, nM, nN, pm, pn)) return false;
        u.a = Abase + (size_t)pm * 256 * 2048; u.b = Bbase + (size_t)pn * 256 * 2048; u.i0 = pm; u.i1 = pn; u.i2 = 0; u.i3 = 0; return true;
    }
};
struct EpiQKV {
    static __host__ __device__ __forceinline__ int brow(int R) { return 2 * (R & ~31) + pg8::perm32(R & 31); }
    bf16* O; const float* qg; const float* kg;
    __device__ __forceinline__ void operator()(const f32x4 (&acc)[2][2][4][2], const pg8::Unit& u, int wr, int wc, int fr, int fq) const {
        const int pn = u.i1, which = pn / 12;
        const int colh = pn * 256 + wc * 64;
        f32x4 gn[2][2];
#pragma unroll
        for (int bj = 0; bj < 2; ++bj)
#pragma unroll
            for (int n = 0; n < 2; ++n) {
                const int hd = bj * 32 + 8 * fq + 4 * n;
                gn[bj][n] = which == 0 ? *(const f32x4*)(qg + hd) * 0.125f : which == 1 ? *(const f32x4*)(kg + hd) : (f32x4){1.f, 1.f, 1.f, 1.f};
            }
#pragma unroll
        for (int ai = 0; ai < 2; ++ai)
#pragma unroll
            for (int m = 0; m < 4; ++m) {
                float ss = 0.f;
#pragma unroll
                for (int bj = 0; bj < 2; ++bj)
#pragma unroll
                    for (int n = 0; n < 2; ++n) { const f32x4 v = acc[ai][bj][m][n]; ss += (v[0] * v[0] + v[1] * v[1]) + (v[2] * v[2] + v[3] * v[3]); }
                ss += __shfl_xor(ss, 16); ss += __shfl_xor(ss, 32);
                const float rs = which == 2 ? 1.f : rsqrtf(ss * (1.f / 64.f) + EPS);
                bf16* rowp = O + (size_t)(u.i0 * 256 + ai * 128 + wr * 64 + m * 16 + fr) * NQKV + colh + 8 * fq;
#pragma unroll
                for (int bj = 0; bj < 2; ++bj) {
                    const f32x4 v0 = acc[ai][bj][m][0] * rs * gn[bj][0], v1 = acc[ai][bj][m][1] * rs * gn[bj][1];
                    u32x4 w; w.x = cvt_pk_bf16(v0[0], v0[1]); w.y = cvt_pk_bf16(v0[2], v0[3]); w.z = cvt_pk_bf16(v1[0], v1[1]); w.w = cvt_pk_bf16(v1[2], v1[3]);
                    *(GAS u32x4*)(rowp + bj * 32) = w;
                }
            }
    }
};
__device__ __forceinline__ void phase_qkv(Frame& F) {
    DenseOrder S; S.nM = NTOK / 256; S.nN = NQKV / 256; S.G = F.G; S.c = blockIdx.x; S.Abase = (const char*)(F.ws + WS_H2); S.Bbase = (const char*)(F.ws + WS_WQKV);
    EpiQKV E; E.O = (bf16*)(F.ws + WS_QKV); E.qg = F.q_gain; E.kg = F.k_gain;
    pg8::gemm_phase<EpiQKV, DenseOrder, true, true>(F.lds, (size_t)32 * 1024 * 2, S, E);
}

struct EpiWo {
    static __host__ __device__ __forceinline__ int brow(int R) { return R; }
    float* X;
    __device__ __forceinline__ void operator()(const f32x4 (&acc)[2][2][4][2], const pg8::Unit& u, int wr, int wc, int fr, int fq) const {
        const int row0 = u.i0 * 256 + wr * 64 + fr, col0 = u.i1 * 256 + wc * 32 + 4 * fq;
#pragma unroll
        for (int ai = 0; ai < 2; ++ai)
#pragma unroll
            for (int m = 0; m < 4; ++m) { float* rowp = X + (size_t)(row0 + ai * 128 + m * 16) * 1024 + col0;
#pragma unroll
                for (int bj = 0; bj < 2; ++bj)
#pragma unroll
                    for (int n = 0; n < 2; ++n) { GAS f32x4* p = (GAS f32x4*)(rowp + bj * 128 + n * 16); *p = *p + acc[ai][bj][m][n]; } }
    }
};
__device__ __forceinline__ void phase_wo(Frame& F) {
    DenseOrder S; S.nM = NTOK / 256; S.nN = 4; S.G = F.G; S.c = blockIdx.x; S.Abase = (const char*)(F.ws + WS_OB); S.Bbase = (const char*)(F.ws + WS_WO);
    EpiWo E; E.X = F.out;
    pg8::gemm_phase<EpiWo, DenseOrder, false, true>(F.lds, (size_t)128 * 1024 * 2, S, E);
}

typedef short v4i16_t __attribute__((ext_vector_type(4)));
__device__ __forceinline__ s16x4 vtr(const LAS unsigned char* p) { return __builtin_bit_cast(s16x4, __builtin_amdgcn_ds_read_tr16_b64_v4i16((LAS v4i16_t*)p)); }
__device__ __forceinline__ void phase_attn(Frame& F) {
    LAS unsigned char* lds = F.lds;
    LAS float* biasL = (LAS float*)(lds + L_BIAS); LAS int* bucketL = (LAS int*)(lds + L_BUCKET);
    const int tid = F.tid, lane = F.lane, wave = F.wave;
    for (int i = tid; i < 3 * 129; i += NTHREADS) {
        const int g = i / 129, d = i % 129; const int n = d * (g == 0 ? 1 : g == 1 ? 4 : 16);
        int bk;
        if (n < 16) bk = n;
        else { const float nf = (float)n; int lg = 16 + (int)(logf(nf / 16.f) / 4.852030263919617f * 16.f); bk = lg < 31 ? lg : 31; }
        bucketL[g * 132 + d] = bk;
    }
    __syncthreads();
    const int hg = wave >> 2, w = wave & 3, t2 = tid & 255;
    const int q = lane & 31, hh = lane >> 5;
    const bf16* QKV = (const bf16*)(F.ws + WS_QKV);
    LAS unsigned char* Kb = lds + hg * 32768;
    LAS unsigned char* Vb = lds + 65536 + hg * 32768;
    for (int item = blockIdx.x; item < 3072; item += F.G) {
        const int hp = item & 7, gb = item >> 3, g = gb >> 7, blk = gb & 127;
        const int dil = g == 0 ? 1 : g == 1 ? 4 : 16;
        const int nb = 16 / dil;
        const int z = blk / nb, i = blk % nb, b = z / dil, r = z % dil;
        const int head = hp * 2 + hg;
        const size_t rowbase = (size_t)b * SEQ + r;
        {
            const int it0 = (i == 0) ? 4 : 0;
            u32x4 kv[8], vv[8];
#pragma unroll
            for (int it = 0; it < 8; ++it) {
                if (it >= it0) {
                    const int cidx = t2 + 256 * it, row = cidx >> 3, ch = cidx & 7;
                    const long j = (long)(i - 1) * 128 + row;
                    const bf16* src = QKV + (rowbase + (size_t)dil * j) * NQKV + g * 1024 + head * 64 + ch * 8;
                    kv[it] = *(const GAS u32x4*)(src + 3072); vv[it] = *(const GAS u32x4*)(src + 6144);
                }
            }
#pragma unroll
            for (int it = 0; it < 8; ++it) {
                if (it >= it0) {
                    const int cidx = t2 + 256 * it, row = cidx >> 3, ch = cidx & 7;
                    const int off = row * 128 + ((ch ^ (row & 7)) << 4);
                    *(LAS u32x4*)(Kb + off) = kv[it]; *(LAS u32x4*)(Vb + off) = vv[it];
                }
            }
            if (t2 < 129) biasL[hg * 132 + t2] = F.rel_bias[bucketL[g * 132 + t2] * 48 + g * 16 + head];
        }
        bf16x8 qf[4];
        const size_t qrow = rowbase + (size_t)dil * ((size_t)i * 128 + 32 * w + q);
        {
            const bf16* qp = QKV + qrow * NQKV + g * 1024 + head * 64 + 8 * hh;
#pragma unroll
            for (int ks = 0; ks < 4; ++ks) qf[ks] = *(const GAS bf16x8*)(qp + 16 * ks);
        }
        __syncthreads();
        const int kt_lo = (i == 0 && w < 4) ? 4 : w;
        f32x16 S[5];
#pragma unroll
        for (int t = 0; t < 5; ++t) {
#pragma unroll
            for (int rg = 0; rg < 16; ++rg) S[t][rg] = 0.f;
            const int kt = w + t;
            if (kt >= kt_lo) {
                const int row = 32 * kt + q;
#pragma unroll
                for (int ks = 0; ks < 4; ++ks) {
                    const bf16x8 kf = *(const LAS bf16x8*)(Kb + row * 128 + (((2 * ks + hh) ^ (row & 7)) << 4));
                    S[t] = __builtin_amdgcn_mfma_f32_32x32x16_bf16(kf, qf[ks], S[t], 0, 0, 0);
                }
            }
        }
        float mx = -1e30f;
#pragma unroll
        for (int t = 0; t < 5; ++t) {
            const bool tv = (w + t) >= kt_lo;
#pragma unroll
            for (int rg = 0; rg < 16; ++rg) {
                const int keyl = (rg & 3) + 8 * (rg >> 2) + 4 * hh;
                const int delta = 128 + q - 32 * t - keyl;
                const bool valid = tv && delta >= 0 && delta <= 128;
                const int dc = delta < 0 ? 0 : (delta > 128 ? 128 : delta);
                const float sv = valid ? S[t][rg] + biasL[hg * 132 + dc] : -1e30f;
                S[t][rg] = sv; mx = fmaxf(mx, sv);
            }
        }
        mx = fmaxf(mx, __shfl_xor(mx, 32));
        float lsum = 0.f;
#pragma unroll
        for (int t = 0; t < 5; ++t)
#pragma unroll
            for (int rg = 0; rg < 16; ++rg) { const float p = __expf(S[t][rg] - mx); S[t][rg] = p; lsum += p; }
        lsum += __shfl_xor(lsum, 32);
        f32x16 O[2];
#pragma unroll
        for (int dt = 0; dt < 2; ++dt)
#pragma unroll
            for (int rg = 0; rg < 16; ++rg) O[dt][rg] = 0.f;
        const int g16 = lane >> 4, i16 = lane & 15, qsel = i16 >> 2, psel = i16 & 3;
#pragma unroll
        for (int t = 0; t < 5; ++t) {
            const int kt = w + t;
            if (kt >= kt_lo) {
#pragma unroll
                for (int s2 = 0; s2 < 2; ++s2) {
                    bf16x8 pf;
                    { const unsigned w0 = cvt_pk_bf16(S[t][8 * s2 + 0], S[t][8 * s2 + 1]), w1 = cvt_pk_bf16(S[t][8 * s2 + 2], S[t][8 * s2 + 3]),
                                     w2 = cvt_pk_bf16(S[t][8 * s2 + 4], S[t][8 * s2 + 5]), w3 = cvt_pk_bf16(S[t][8 * s2 + 6], S[t][8 * s2 + 7]);
                      const u32x4 pw = (u32x4){w0, w1, w2, w3}; pf = __builtin_bit_cast(bf16x8, pw); }
#pragma unroll
                    for (int dt = 0; dt < 2; ++dt) {
                        const int krow = 32 * kt + 16 * s2 + 4 * hh + qsel;
                        const int ch = 4 * dt + 2 * (g16 & 1) + (psel >> 1);
                        const s16x4 lo = vtr(Vb + krow * 128 + ((ch ^ (krow & 7)) << 4) + (psel & 1) * 8);
                        const int krow2 = krow + 8;
                        const s16x4 hi = vtr(Vb + krow2 * 128 + ((ch ^ (krow2 & 7)) << 4) + (psel & 1) * 8);
                        const bf16x8 vf = (bf16x8){lo[0], lo[1], lo[2], lo[3], hi[0], hi[1], hi[2], hi[3]};
                        O[dt] = __builtin_amdgcn_mfma_f32_32x32x16_bf16(vf, pf, O[dt], 0, 0, 0);
                    }
                }
            }
        }
        {
            const float inv = 1.f / lsum;
            bf16* op = (bf16*)(F.ws + WS_OG) + ((size_t)g * NTOK + qrow) * 1024 + head * 64;
#pragma unroll
            for (int dt = 0; dt < 2; ++dt)
#pragma unroll
                for (int r4 = 0; r4 < 4; ++r4) {
                    u32x2 wv; wv.x = cvt_pk_bf16(O[dt][4 * r4 + 0] * inv, O[dt][4 * r4 + 1] * inv); wv.y = cvt_pk_bf16(O[dt][4 * r4 + 2] * inv, O[dt][4 * r4 + 3] * inv);
                    *(GAS u32x2*)(op + dt * 32 + 8 * r4 + 4 * hh) = wv;
                }
            if (hh == 0) ((float*)(F.ws + WS_LSE))[((size_t)g * NTOK + qrow) * 16 + head] = mx + __logf(lsum);
        }
        __syncthreads();
    }
}
__device__ __forceinline__ void phase_attn_combine(Frame& F) {
    const int gw = blockIdx.x * NWAVES + F.wave, NGW = F.G * NWAVES, lane = F.lane;
    const float* LSE = (const float*)(F.ws + WS_LSE); const bf16* OG = (const bf16*)(F.ws + WS_OG); bf16* OB = (bf16*)(F.ws + WS_OB);
    for (int tok = gw; tok < NTOK; tok += NGW) {
        const int head = lane >> 2;
        const float l0 = LSE[((size_t)0 * NTOK + tok) * 16 + head], l1 = LSE[((size_t)1 * NTOK + tok) * 16 + head], l2 = LSE[((size_t)2 * NTOK + tok) * 16 + head];
        const float m = fmaxf(l0, fmaxf(l1, l2));
        float a0 = __expf(l0 - m), a1 = __expf(l1 - m), a2 = __expf(l2 - m); const float inv = 1.f / (a0 + a1 + a2); a0 *= inv; a1 *= inv; a2 *= inv;
        const GAS u32x4* p0 = (const GAS u32x4*)(OG + ((size_t)0 * NTOK + tok) * 1024) + 2 * lane;
        const GAS u32x4* p1 = (const GAS u32x4*)(OG + ((size_t)1 * NTOK + tok) * 1024) + 2 * lane;
        const GAS u32x4* p2 = (const GAS u32x4*)(OG + ((size_t)2 * NTOK + tok) * 1024) + 2 * lane;
        GAS u32x4* po = (GAS u32x4*)(OB + (size_t)tok * 1024) + 2 * lane;
#pragma unroll
        for (int c = 0; c < 2; ++c) {
            const u32x4 v0 = p0[c], v1 = p1[c], v2 = p2[c]; u32x4 o;
#pragma unroll
            for (int k = 0; k < 4; ++k) {
                const float lo = a0 * bflo(v0[k]) + a1 * bflo(v1[k]) + a2 * bflo(v2[k]);
                const float hi = a0 * bfhi(v0[k]) + a1 * bfhi(v1[k]) + a2 * bfhi(v2[k]);
                o[k] = pk2(lo, hi);
            }
            po[c] = o;
        }
    }
}

constexpr int NPHASE = 15;
__global__ void __launch_bounds__(NTHREADS, 2) fwd_kernel(Args args) {
    extern __shared__ __attribute__((aligned(16))) unsigned char lds_raw[];
    Frame F;
    F.lds = (LAS unsigned char*)lds_raw;
    F.tid = threadIdx.x; F.lane = F.tid & 63; F.wave = __builtin_amdgcn_readfirstlane(F.tid >> 6); F.G = gridDim.x;
    F.ws = args.ws; F.out = args.out; F.ctl = (gu32*)(args.ws + WS_CTL);
    F.x = args.in[0]; F.norm_mix_g = args.in[1]; F.norm_ffn_g = args.in[2]; F.pool_w = args.in[3]; F.pool_scale = args.in[4]; F.w_qkv = args.in[5];
    F.q_gain = args.in[6]; F.k_gain = args.in[7]; F.w_o = args.in[8]; F.rel_bias = args.in[9]; F.w_router = args.in[10]; F.b_router = args.in[11];
    F.w_gu = args.in[12]; F.b_gu = args.in[13]; F.w_dn = args.in[14]; F.b_dn = args.in[15];
    if (F.tid < 16) ((LAS unsigned*)(F.lds + L_BARST))[F.tid] = 0u;
    __syncthreads();
    if (args.never) cg::this_grid().sync();
#if MK_MULTI
#define GRID_BAR() do { } while (0)
#else
    XcdBarrier bar = xcd_barrier_post((unsigned*)(F.ctl + CW_BAR), (volatile LAS unsigned*)(F.lds + L_BARST));
#define GRID_BAR() xcd_barrier(bar)
#endif
    const int lo = args.ph_lo, hi = args.ph_hi;
#define IN(k) (lo <= (k) && (k) < hi)
#define SEAM(k) do { if (IN(k) && IN((k) + 1)) GRID_BAR(); } while (0)
    if (IN(0)) phase_convert(F);          SEAM(0);
    if (IN(1)) phase_pool(F);             SEAM(1);
    if (IN(2)) phase_gather(F, 0);        SEAM(2);
    if (IN(3)) phase_moe_gu(F, 0);        SEAM(3);
    if (IN(4)) phase_moe_dn(F, 0);        SEAM(4);
    if (IN(5)) phase_combine(F, 0);       SEAM(5);
    if (IN(6)) phase_qkv(F);              SEAM(6);
    if (IN(7)) phase_attn(F);             SEAM(7);
    if (IN(8)) phase_attn_combine(F);     SEAM(8);
    if (IN(9)) phase_wo(F);               SEAM(9);
    if (IN(10)) phase_router(F, 1);       SEAM(10);
    if (IN(11)) phase_gather(F, 1);       SEAM(11);
    if (IN(12)) phase_moe_gu(F, 1);       SEAM(12);
    if (IN(13)) phase_moe_dn(F, 1);       SEAM(13);
    if (IN(14)) phase_combine(F, 1);
#undef IN
#undef SEAM
}

extern "C" void kernel_launch(void* const* d_in, const int* in_sizes, int n_in, void* d_out, int out_size, void* d_ws, size_t ws_size, hipStream_t stream) {
    static int grid = 0;
    if (grid == 0) {
        if (n_in != 16 || in_sizes[0] != NTOK * DM || out_size != NTOK * DM || ws_size < WS_END) {
            fprintf(stderr, "kernel_launch: unexpected shapes (n_in %d, in0 %d, out %d, ws %zu < %zu); nothing launched\n", n_in, n_in > 0 ? in_sizes[0] : -1, out_size, ws_size, (size_t)WS_END); grid = -1; return; }
        int dev = 0, cus = 0, per_cu = 0;
        if (hipGetDevice(&dev) != hipSuccess || hipDeviceGetAttribute(&cus, hipDeviceAttributeMultiprocessorCount, dev) != hipSuccess) { grid = -1; return; }
        if (hipFuncSetAttribute((const void*)fwd_kernel, hipFuncAttributeMaxDynamicSharedMemorySize, LDS_BYTES) != hipSuccess) { fprintf(stderr, "kernel_launch: hipFuncSetAttribute failed\n"); grid = -1; return; }
        if (hipOccupancyMaxActiveBlocksPerMultiprocessor(&per_cu, (const void*)fwd_kernel, NTHREADS, LDS_BYTES) != hipSuccess || per_cu < 1) { fprintf(stderr, "kernel_launch: occupancy query says %d blocks/CU\n", per_cu); (void)hipGetLastError(); grid = -1; return; }
        grid = cus;
    }
    if (grid < 0) return;
    if (hipMemsetAsync((char*)d_ws + WS_CTL, 0, CTL_BYTES, stream) != hipSuccess) { fprintf(stderr, "kernel_launch: memset failed\n"); return; }
    Args a{};
    for (int i = 0; i < 16; ++i) a.in[i] = (const float*)d_in[i];
    a.out = (float*)d_out; a.ws = (unsigned char*)d_ws; a.never = 0; a.pad = 0;
#if MK_MULTI
    for (int p = 0; p < NPHASE; ++p) { a.ph_lo = p; a.ph_hi = p + 1; hipLaunchKernelGGL(fwd_kernel, dim3(grid), dim3(NTHREADS), LDS_BYTES, stream, a); }
#else
    a.ph_lo = 0; a.ph_hi = NPHASE;
    void* kargs[] = {&a};
    hipError_t e = hipLaunchCooperativeKernel((const void*)fwd_kernel, dim3(grid), dim3(NTHREADS), kargs, LDS_BYTES, stream);
    if (e != hipSuccess) fprintf(stderr, "kernel_launch: cooperative launch failed: %s (grid %d)\n", hipGetErrorString(e), grid);
#endif
}
```

```cpp
#include <hip/hip_runtime.h>
#include <hip/hip_cooperative_groups.h>
#include <cstdio>
#include <cstdint>
namespace cg = cooperative_groups;

#ifndef DUP_MASK
#define DUP_MASK 0
#endif
#ifndef MK_MULTI
#define MK_MULTI 0
#endif

#define LAS __attribute__((address_space(3)))
#define GAS __attribute__((address_space(1)))
typedef unsigned short bf16;
typedef short bf16x8 __attribute__((ext_vector_type(8)));
typedef short s16x4 __attribute__((ext_vector_type(4)));
typedef float f32x2 __attribute__((ext_vector_type(2)));
typedef float f32x4 __attribute__((ext_vector_type(4)));
typedef float f32x16 __attribute__((ext_vector_type(16)));
typedef int v4i __attribute__((ext_vector_type(4)));
typedef int v8i __attribute__((ext_vector_type(8)));
typedef unsigned u32x4 __attribute__((ext_vector_type(4)));
typedef unsigned u32x2 __attribute__((ext_vector_type(2)));
typedef GAS unsigned gu32;

constexpr int NTOK = 16384, DM = 1024, SEQ = 2048, NEXP = 32, TOPK = 4, FF = 1024, NQKV = 9216;
constexpr int CAP = 16384;
constexpr int MAXT = 288;
constexpr int PMAX = MAXT * 256;
constexpr float EPS = 1e-6f;
constexpr int NWAVES = 8, NTHREADS = 512;

constexpr size_t MiB = 1u << 20;
constexpr size_t WS_CTL = 0, CTL_BYTES = 1 * MiB;
constexpr size_t WS_WRT = 1 * MiB;
constexpr size_t WS_WPOOL = WS_WRT + 512 * 1024;
constexpr size_t WS_WO = 2 * MiB;
constexpr size_t WS_SC_GU = 4 * MiB;
constexpr size_t WS_SC_QKV = 4 * MiB + 512 * 1024;
constexpr size_t WS_SC_DN = 5 * MiB;
constexpr size_t WS_HS = 6 * MiB;
constexpr size_t WS_WQKV = 8 * MiB;
constexpr size_t WS_WGU = 18 * MiB;
constexpr size_t WS_WDN = WS_WGU + 128 * MiB;
constexpr size_t WS_ROWSLOT = WS_WDN + 128 * MiB;
constexpr size_t WS_ROWGATE = WS_ROWSLOT + 2 * MiB;
constexpr size_t WS_ROWHS = WS_ROWGATE + 2 * MiB;
constexpr size_t WS_LSE = WS_ROWHS + 2 * MiB;
constexpr size_t WS_H2 = WS_LSE + 3 * MiB;
constexpr size_t WS_BIG = WS_H2 + 16 * MiB;
constexpr size_t WS_ACT = WS_BIG, WS_QKV = WS_BIG;
constexpr size_t WS_Y = WS_BIG + 288 * MiB;
constexpr size_t WS_OG = WS_Y, WS_OB = WS_Y + 96 * MiB;
constexpr size_t WS_END = WS_Y + 128 * MiB;
static_assert(WS_END <= 874 * MiB, "workspace map must fit the guaranteed d_ws size");
constexpr int CW_CNT = 64;
constexpr int CW_BAR = 4096;

constexpr int RING_BYTES = 131072;
constexpr int MISC_OFF = RING_BYTES;
constexpr int L_BARST = MISC_OFF + 0;
constexpr int L_CNT = MISC_OFF + 64;
constexpr int L_PROW0 = MISC_OFF + 192;
constexpr int L_NT = MISC_OFF + 320;
constexpr int L_TILEE = MISC_OFF + 336;
constexpr int L_TILEROW = MISC_OFF + 1488;
constexpr int L_HIST = MISC_OFF + 2640;
constexpr int L_BASE = MISC_OFF + 2768;
constexpr int L_SLOTE = MISC_OFF + 2896;
constexpr int L_SLOTP = MISC_OFF + 3920;
constexpr int L_SLOTG = MISC_OFF + 4944;
constexpr int L_RSTD = MISC_OFF + 5968;
constexpr int L_BIAS = MISC_OFF + 6288;
constexpr int L_BUCKET = MISC_OFF + 7344;
constexpr int LDS_BYTES = 147456;
static_assert(L_BUCKET + 3 * 132 * 4 <= LDS_BYTES, "LDS map");

#define RLX_AGENT __ATOMIC_RELAXED, __HIP_MEMORY_SCOPE_AGENT
#define LDS_WAIT() asm volatile("s_waitcnt lgkmcnt(0)" ::: "memory")
#define VM_WAIT() asm volatile("s_waitcnt vmcnt(0)" ::: "memory")
__device__ __forceinline__ unsigned f2bf(float f) { unsigned u = __builtin_bit_cast(unsigned, f); return (u + 0x7fffu + ((u >> 16) & 1u)) >> 16; }
__device__ __forceinline__ unsigned pk2(float lo, float hi) { return f2bf(lo) | (f2bf(hi) << 16); }
__device__ __forceinline__ float bf2f(unsigned short b) { return __builtin_bit_cast(float, ((unsigned)b) << 16); }
__device__ __forceinline__ float bflo(unsigned w) { return __builtin_bit_cast(float, w << 16); }
__device__ __forceinline__ float bfhi(unsigned w) { return __builtin_bit_cast(float, w & 0xffff0000u); }
__device__ __forceinline__ unsigned cvt_pk_bf16(float lo, float hi) { unsigned r; asm volatile("v_cvt_pk_bf16_f32 %0, %1, %2" : "=v"(r) : "v"(lo), "v"(hi)); return r; }
__device__ __forceinline__ float wave_sum(float v) {
#pragma unroll
    for (int o = 1; o < 64; o <<= 1) v += __shfl_xor(v, o);
    return v;
}

#define XB_TMO      128
#define XB_XCNT(j)  (256  + 64 * (j))
#define XB_XSUB(j)  (1280 + 64 * (j))
#define XB_XGEN(j)  (2304 + 64 * (j))
#define XB_TOP      3328
#define XB_TOPGEN   3392
#define XCD_BAR_WORDS 3456
#define XB_SPIN_CAP (1u << 20)
__device__ __forceinline__ unsigned xb_ld(unsigned* p)              { return __hip_atomic_load(p, __ATOMIC_RELAXED, __HIP_MEMORY_SCOPE_AGENT); }
__device__ __forceinline__ unsigned xb_add(unsigned* p, unsigned v) { return __hip_atomic_fetch_add(p, v, __ATOMIC_RELAXED, __HIP_MEMORY_SCOPE_AGENT); }
__device__ __forceinline__ unsigned xb_xcc_id() { return (unsigned)__builtin_amdgcn_s_getreg((3 << 11) | 20) & 0xFu; }
#define XB_SPIN(cond, bar) do { unsigned _sp = 0; while (cond) { __builtin_amdgcn_s_sleep(1); \
    if ((++_sp & 255u) == 0u) { if (xb_ld(&(bar)[XB_TMO])) break; if (_sp > XB_SPIN_CAP) { atomicAdd(&(bar)[XB_TMO], 1u); break; } } } } while (0)
struct XcdBarrier { unsigned* bar; unsigned x; volatile LAS unsigned* st; };
__device__ __forceinline__ XcdBarrier xcd_barrier_post(unsigned* bar, volatile LAS unsigned* st) {
    XcdBarrier b; b.bar = bar; b.x = xb_xcc_id(); b.st = st;
    if (threadIdx.x == 0) (void)xb_add(&bar[XB_XCNT(b.x)], 1u);
    return b;
}
__device__ __forceinline__ void xcd_barrier_complete(unsigned* bar, unsigned x, unsigned& nloc, unsigned& nx) {
    const unsigned G = gridDim.x * gridDim.y * gridDim.z;
    unsigned sum, cnt, mine, sp = 0u;
    for (;;) {
        sum = 0u; cnt = 0u; mine = 0u;
#pragma unroll
        for (unsigned j = 0; j < 16; ++j) { const unsigned c = xb_ld(&bar[XB_XCNT(j)]); sum += c; cnt += (c > 0u) ? 1u : 0u; mine = (j == x) ? c : mine; }
        if (sum == G) break;
        __builtin_amdgcn_s_sleep(1);
        if ((++sp & 255u) == 0u) { if (xb_ld(&bar[XB_TMO])) break; if (sp > XB_SPIN_CAP) { atomicAdd(&bar[XB_TMO], 1u); break; } }
    }
    nloc = mine > 0u ? mine : 1u; nx = cnt > 0u ? cnt : 1u;
}
__device__ __forceinline__ void xcd_barrier(const XcdBarrier& b) {
    asm volatile("s_waitcnt vmcnt(0)" ::: "memory");
    __syncthreads();
    if (threadIdx.x == 0) {
        unsigned* bar = b.bar;
        __builtin_amdgcn_s_waitcnt(0);
        unsigned nloc = b.st[0], nx = b.st[1];
        if (nloc == 0u) { xcd_barrier_complete(bar, b.x, nloc, nx); b.st[0] = nloc; b.st[1] = nx; }
        const unsigned old = xb_add(&bar[XB_XSUB(b.x)], 1u);
        const unsigned gen = old / nloc;
        if (old + 1u == (gen + 1u) * nloc) {
            __builtin_amdgcn_fence(__ATOMIC_RELEASE, "agent");
            asm volatile("s_waitcnt vmcnt(0)" ::: "memory");
            const unsigned og = xb_add(&bar[XB_TOP], 1u);
            const unsigned tg = og / nx;
            if (og + 1u == (tg + 1u) * nx) xb_add(&bar[XB_TOPGEN], 1u);
            else XB_SPIN(xb_ld(&bar[XB_TOPGEN]) == tg, bar);
            __builtin_amdgcn_fence(__ATOMIC_ACQUIRE, "agent");
            xb_add(&bar[XB_XGEN(b.x)], 1u);
            asm volatile("s_waitcnt vmcnt(0)" ::: "memory");
        } else {
            XB_SPIN(xb_ld(&bar[XB_XGEN(b.x)]) == gen, bar);
            __builtin_amdgcn_fence(__ATOMIC_ACQUIRE, "agent");
            asm volatile("s_waitcnt vmcnt(0)" ::: "memory");
        }
    }
    __syncthreads();
}

namespace pg8 {
constexpr int BM = 256, BK = 64, HALF = 128, HTB = HALF * BK * 2, STAGE_BYTES = 8 * HTB, NXCD = 8, WGM = 8, KD = 1024;
__host__ __device__ __forceinline__ int lds_byte(int r, int c) { const int st = (r >> 4) * 2 + (c >> 5), rr = r & 15, cc = c & 31, ob = rr * 64 + cc * 2; return st * 1024 + (ob ^ (((ob >> 9) & 1) << 5)); }
__host__ __device__ __forceinline__ void stage_rc(int b, int& R, int& C) { const int st = b / 1024, sb = b % 1024, swz = sb ^ (((sb >> 9) & 1) << 5); R = (st >> 1) * 16 + swz / 64; C = (st & 1) * 32 + (swz % 64) / 2; }
__host__ __device__ __forceinline__ int perm32(int rho) { const int n = rho >> 4, i = rho & 15; return 8 * (i >> 2) + 4 * n + (i & 3); }

struct Unit { const char* a; const char* b; int i0, i1, i2, i3; };
template <int M> struct Frag { bf16x8 v[2]; };
template <> struct Frag<2> { v8i w; };

__device__ __forceinline__ bool tile_order(int i, int G, int c, int nM, int nN, int& pm, int& pn) {
    const int nwg = nM * nN; const long L = (long)i * G + c; if (L >= nwg) return false;
    int wgid = (int)L; { const int q = nwg / NXCD, r = nwg % NXCD, xcd = wgid % NXCD, off = wgid / NXCD; wgid = (xcd < r ? xcd * (q + 1) : r * (q + 1) + (xcd - r) * q) + off; }
    const int nig = WGM * nN, gid = wgid / nig, fm = gid * WGM, gsz = (nM - fm) < WGM ? (nM - fm) : WGM;
    pm = fm + ((wgid % nig) % gsz); pn = (wgid % nig) / gsz; return true;
}

template <class Epi, class Sched, bool ALIGN_EPI, bool SP2>
__device__ __forceinline__ void gemm_phase(LAS unsigned char* lds, const size_t hstepB, const Sched& S, const Epi& E) {
    typedef typename Epi::ACC ACC; constexpr int MODE = Epi::MODE;
    const int tid = threadIdx.x, wid = __builtin_amdgcn_readfirstlane(tid >> 6), lane = tid & 63, wr = wid >> 2, wc = wid & 3, fr = lane & 15, fq = lane >> 4;
    constexpr int ROWB = (MODE == 0) ? KD * 2 : KD;
    constexpr int nt = ROWB / 128;
    constexpr bool GATHER = Sched::GATHER;
    unsigned voffA[2], voffB[2]; int Rst[2], Cst[2];
#pragma unroll
    for (int i = 0; i < 2; ++i) { int R, C; stage_rc(tid * 16 + i * 8192, R, C); const int Rb = Epi::brow(R); Rst[i] = R; Cst[i] = C;
        voffA[i] = (unsigned)(R * ROWB + C * 2); voffB[i] = (unsigned)(Rb * ROWB + C * 2); }
    unsigned gc[4] = {0u, 0u, 0u, 0u}, gn[4] = {0u, 0u, 0u, 0u};
    const size_t kstep = (size_t)(BK * 2);
    const size_t hstepA = (size_t)HALF * ROWB;
    const unsigned ldsw = (unsigned)wid * 1024u;
    const int aoff = lds_byte(wr * 64 + fr, fq * 8), boff = lds_byte(wc * 32 + fr, fq * 8);
#define PG8_SA(b, h) (((b) * 2 + (h)) * HTB)
#define PG8_SB(b, h) ((4 + (b) * 2 + (h)) * HTB)
#define PG8_STAGE(bufoff, gbase, voff) do { _Pragma("unroll") for (int _i = 0; _i < 2; ++_i) \
        __builtin_amdgcn_global_load_lds((const unsigned*)((const char*)(gbase) + (voff)[_i]), (LAS unsigned*)(lds + (bufoff) + ldsw + _i * 8192), 16, 0, 0); } while (0)
#define PG8_STAGE4(bufoff, gbase, o0, o1) do { \
        __builtin_amdgcn_global_load_lds((const unsigned*)((const char*)(gbase) + (o0)), (LAS unsigned*)(lds + (bufoff) + ldsw), 16, 0, 0); \
        __builtin_amdgcn_global_load_lds((const unsigned*)((const char*)(gbase) + (o1)), (LAS unsigned*)(lds + (bufoff) + ldsw + 8192), 16, 0, 0); } while (0)
#define PG8_STAGEA(bufoff, p, h, g) do { if constexpr (GATHER) PG8_STAGE4(bufoff, p, (g)[2 * (h)], (g)[2 * (h) + 1]); else PG8_STAGE4(bufoff, (p) + (h) * hstepA, voffA[0], voffA[1]); } while (0)
#define PG8_LDA(dst, b, h) do { _Pragma("unroll") for (int m = 0; m < 4; ++m) { if constexpr (MODE == 2) { dst[m].w.lo = *(const LAS v4i*)(lds + PG8_SA(b, h) + aoff + m * 2048); dst[m].w.hi = *(const LAS v4i*)(lds + PG8_SA(b, h) + aoff + m * 2048 + 1024); } \
        else { dst[m].v[0] = *(const LAS bf16x8*)(lds + PG8_SA(b, h) + aoff + m * 2048); dst[m].v[1] = *(const LAS bf16x8*)(lds + PG8_SA(b, h) + aoff + m * 2048 + 1024); } } } while (0)
#define PG8_LDB(dst, b, h) do { _Pragma("unroll") for (int n = 0; n < 2; ++n) { if constexpr (MODE == 2) { dst[n].w.lo = *(const LAS v4i*)(lds + PG8_SB(b, h) + boff + n * 2048); dst[n].w.hi = *(const LAS v4i*)(lds + PG8_SB(b, h) + boff + n * 2048 + 1024); } \
        else { dst[n].v[0] = *(const LAS bf16x8*)(lds + PG8_SB(b, h) + boff + n * 2048); dst[n].v[1] = *(const LAS bf16x8*)(lds + PG8_SB(b, h) + boff + n * 2048 + 1024); } } } while (0)
#define PG8_MMA(ai, bj, At, Bt) do { __builtin_amdgcn_s_setprio(1); _Pragma("unroll") for (int m = 0; m < 4; ++m) _Pragma("unroll") for (int n = 0; n < 2; ++n) { \
        if constexpr (MODE == 0) { _Pragma("unroll") for (int k = 0; k < 2; ++k) acc[ai][bj][m][n] = __builtin_amdgcn_mfma_f32_16x16x32_bf16(Bt[n].v[k], At[m].v[k], acc[ai][bj][m][n], 0, 0, 0); } \
        else if constexpr (MODE == 1) { _Pragma("unroll") for (int k = 0; k < 2; ++k) acc[ai][bj][m][n] = __builtin_amdgcn_mfma_i32_16x16x64_i8(__builtin_bit_cast(v4i, Bt[n].v[k]), __builtin_bit_cast(v4i, At[m].v[k]), acc[ai][bj][m][n], 0, 0, 0); } \
        else { acc[ai][bj][m][n] = __builtin_amdgcn_mfma_scale_f32_16x16x128_f8f6f4(Bt[n].w, At[m].w, acc[ai][bj][m][n], 0, 0, 0, 0x7f7f7f7f, 0, 0x7f7f7f7f); } \
        } __builtin_amdgcn_s_setprio(0); } while (0)
#define PG8_WAIT_V(n) asm volatile("s_waitcnt vmcnt(" #n ")" ::: "memory")
#define PG8_WAIT_L(n) asm volatile("s_waitcnt lgkmcnt(" #n ")" ::: "memory")
#define PG8_BAR __builtin_amdgcn_s_barrier()
#define PG8_SCHED __builtin_amdgcn_sched_barrier(0)
    Unit cur, nxt, nn; int ui = 0;
    if (!S.next(0, cur)) return;
    bool has_next = S.next(1, nxt);
    if constexpr (GATHER) {
#pragma unroll
        for (int h = 0; h < 2; ++h)
#pragma unroll
            for (int i = 0; i < 2; ++i) { gc[2 * h + i] = (unsigned)S.row_src(cur, h * HALF + Rst[i]) * (unsigned)ROWB + (unsigned)(Cst[i] * 2);
                                          gn[2 * h + i] = has_next ? (unsigned)S.row_src(nxt, h * HALF + Rst[i]) * (unsigned)ROWB + (unsigned)(Cst[i] * 2) : 0u; }
    }
    ACC acc[2][2][4][2];
#pragma unroll
    for (int a = 0; a < 2; ++a)
#pragma unroll
        for (int b = 0; b < 2; ++b)
#pragma unroll
            for (int m = 0; m < 4; ++m)
#pragma unroll
                for (int n = 0; n < 2; ++n) acc[a][b][m][n] = (ACC){0, 0, 0, 0};
    Frag<MODE> At[4], B0[2], B1[2];
    const char* cA = cur.a; const char* cB = cur.b;
    if constexpr (SP2) {
        PG8_STAGE(PG8_SB(0, 0), cB, voffB); PG8_STAGE(PG8_SB(0, 1), cB + hstepB, voffB); PG8_STAGEA(PG8_SA(0, 0), cA, 0, gc); PG8_STAGEA(PG8_SA(0, 1), cA, 1, gc);
        if (wr == 1) PG8_BAR;
        PG8_WAIT_V(2); PG8_BAR;
        PG8_STAGE(PG8_SB(1, 0), cB + kstep, voffB); PG8_STAGEA(PG8_SA(1, 0), cA + kstep, 0, gc); PG8_STAGE(PG8_SB(1, 1), cB + hstepB + kstep, voffB);
        PG8_WAIT_V(6); PG8_BAR;
    } else {
        PG8_STAGE(PG8_SB(0, 0), cB, voffB); PG8_STAGEA(PG8_SA(0, 0), cA, 0, gc); PG8_STAGE(PG8_SB(0, 1), cB + hstepB, voffB); PG8_STAGEA(PG8_SA(0, 1), cA, 1, gc);
        if (wr == 1) PG8_BAR;
        PG8_WAIT_V(4); PG8_BAR;
        PG8_STAGE(PG8_SB(1, 0), cB + kstep, voffB); PG8_STAGEA(PG8_SA(1, 0), cA + kstep, 0, gc); PG8_STAGE(PG8_SB(1, 1), cB + hstepB + kstep, voffB);
        PG8_WAIT_V(6); PG8_BAR;
    }
    for (;;) {
        const char* nA = has_next ? nxt.a : cA; const char* nB = has_next ? nxt.b : cB;
        for (int t = 0; t < nt; t += 2) {
            const bool last = (t == nt - 2);
            const char* a1 = cA + (size_t)(t + 1) * kstep;
            const char* a2 = last ? nA : cA + (size_t)(t + 2) * kstep; const char* b2 = last ? nB : cB + (size_t)(t + 2) * kstep;
            const char* a3 = a2 + kstep; const char* b3 = b2 + kstep;
            unsigned g2[4];
#pragma unroll
            for (int i = 0; i < 4; ++i) g2[i] = (last && has_next) ? gn[i] : gc[i];
            if constexpr (SP2) {
            PG8_LDB(B0, 0, 0); PG8_LDB(B1, 0, 1); PG8_SCHED; PG8_LDA(At, 0, 0); PG8_STAGEA(PG8_SA(1, 1), a1, 1, gc);
            PG8_WAIT_V(8); PG8_WAIT_L(0); PG8_BAR; PG8_MMA(0, 0, At, B0); PG8_MMA(0, 1, At, B1); PG8_BAR; PG8_SCHED;
            PG8_LDA(At, 0, 1); PG8_STAGE(PG8_SB(0, 0), b2, voffB); PG8_STAGE(PG8_SB(0, 1), b2 + hstepB, voffB); PG8_STAGEA(PG8_SA(0, 0), a2, 0, g2);
            PG8_WAIT_V(8); PG8_WAIT_L(0); PG8_BAR; PG8_MMA(1, 0, At, B0); PG8_MMA(1, 1, At, B1); PG8_BAR; PG8_SCHED;
            PG8_LDB(B0, 1, 0); PG8_LDB(B1, 1, 1); PG8_SCHED; PG8_LDA(At, 1, 0); PG8_STAGEA(PG8_SA(0, 1), a2, 1, g2);
            PG8_WAIT_V(8); PG8_WAIT_L(0); PG8_BAR; PG8_MMA(0, 0, At, B0); PG8_MMA(0, 1, At, B1); PG8_BAR; PG8_SCHED;
            PG8_LDA(At, 1, 1); PG8_STAGE(PG8_SB(1, 0), b3, voffB); PG8_STAGE(PG8_SB(1, 1), b3 + hstepB, voffB); PG8_STAGEA(PG8_SA(1, 0), a3, 0, g2);
            PG8_WAIT_V(8); PG8_WAIT_L(0); PG8_BAR; PG8_MMA(1, 0, At, B0); PG8_MMA(1, 1, At, B1); PG8_BAR; PG8_SCHED;
            } else {
            PG8_LDB(B0, 0, 0); PG8_SCHED; PG8_LDA(At, 0, 0); PG8_STAGEA(PG8_SA(1, 1), a1, 1, gc);
            PG8_WAIT_L(8); PG8_BAR; PG8_WAIT_L(0); PG8_MMA(0, 0, At, B0); PG8_BAR; PG8_SCHED;
            PG8_LDB(B1, 0, 1); PG8_STAGE(PG8_SB(0, 0), b2, voffB);
            PG8_BAR; PG8_WAIT_L(0); PG8_MMA(0, 1, At, B1); PG8_BAR;
            PG8_LDA(At, 0, 1); PG8_STAGEA(PG8_SA(0, 0), a2, 0, g2);
            PG8_BAR; PG8_WAIT_L(0); PG8_MMA(1, 0, At, B0); PG8_BAR; PG8_SCHED;
            PG8_STAGE(PG8_SB(0, 1), b2 + hstepB, voffB);
            PG8_WAIT_V(6); PG8_BAR; PG8_MMA(1, 1, At, B1); PG8_BAR;
            PG8_LDB(B0, 1, 0); PG8_SCHED; PG8_LDA(At, 1, 0); PG8_STAGEA(PG8_SA(0, 1), a2, 1, g2);
            PG8_WAIT_L(8); PG8_BAR; PG8_WAIT_L(0); PG8_MMA(0, 0, At, B0); PG8_BAR; PG8_SCHED;
            PG8_LDB(B1, 1, 1); PG8_STAGE(PG8_SB(1, 0), b3, voffB);
            PG8_BAR; PG8_WAIT_L(0); PG8_MMA(0, 1, At, B1); PG8_BAR;
            PG8_LDA(At, 1, 1); PG8_STAGEA(PG8_SA(1, 0), a3, 0, g2);
            PG8_BAR; PG8_WAIT_L(0); PG8_MMA(1, 0, At, B0); PG8_BAR; PG8_SCHED;
            PG8_STAGE(PG8_SB(1, 1), b3 + hstepB, voffB);
            PG8_WAIT_V(6); PG8_BAR; PG8_MMA(1, 1, At, B1); PG8_BAR;
            }
        }
        if constexpr (ALIGN_EPI) { if (wr == 0) PG8_BAR; }
        const bool has_nn = has_next && S.next(ui + 2, nn);
        unsigned g3[4] = {0u, 0u, 0u, 0u};
        if constexpr (GATHER) { if (has_nn) {
#pragma unroll
            for (int h = 0; h < 2; ++h)
#pragma unroll
                for (int i = 0; i < 2; ++i) g3[2 * h + i] = (unsigned)S.row_src(nn, h * HALF + Rst[i]) * (unsigned)ROWB + (unsigned)(Cst[i] * 2); } }
        E(acc, cur, wr, wc, fr, fq);
        if constexpr (GATHER) asm volatile("" : "+v"(g3[0]), "+v"(g3[1]), "+v"(g3[2]), "+v"(g3[3]));
        if (!has_next) break;
#pragma unroll
        for (int a = 0; a < 2; ++a)
#pragma unroll
            for (int b = 0; b < 2; ++b)
#pragma unroll
                for (int m = 0; m < 4; ++m)
#pragma unroll
                    for (int n = 0; n < 2; ++n) acc[a][b][m][n] = (ACC){0, 0, 0, 0};
#pragma unroll
        for (int i = 0; i < 4; ++i) { gc[i] = gn[i]; gn[i] = g3[i]; }
        cur = nxt; cA = nA; cB = nB; ++ui; nxt = nn; has_next = has_nn;
        if constexpr (ALIGN_EPI) { if (wr == 1) PG8_BAR; }
    }
    PG8_WAIT_V(0);
    if constexpr (!ALIGN_EPI) { if (wr == 0) PG8_BAR; }
    PG8_BAR;
#undef PG8_SA
#undef PG8_SB
#undef PG8_STAGE
#undef PG8_STAGE4
#undef PG8_STAGEA
#undef PG8_LDA
#undef PG8_LDB
#undef PG8_MMA
#undef PG8_WAIT_V
#undef PG8_WAIT_L
#undef PG8_BAR
#undef PG8_SCHED
}
}

struct Args { const float* in[16]; float* out; unsigned char* ws; int ph_lo, ph_hi; int never, pad; };
struct Frame {
    LAS unsigned char* lds;
    gu32* ctl;
    int tid, lane, wave, G;
    const float *x, *norm_mix_g, *norm_ffn_g, *pool_w, *pool_scale, *w_qkv, *q_gain, *k_gain, *w_o, *rel_bias, *w_router, *b_router, *w_gu, *b_gu, *w_dn, *b_dn;
    float* out; unsigned char* ws;
};

__device__ __forceinline__ void transpose_item(const float* W, int K, int N, bf16* WT, LAS float* scr, int item, int lane) {
    const int nblk = N / 32, kb = item / nblk, nb = item % nblk, k0 = 64 * kb, n0 = 32 * nb;
#pragma unroll 8
    for (int i = 0; i < 32; ++i) { const int kk = 2 * i + (lane >> 5); scr[kk * 33 + (lane & 31)] = W[(size_t)(k0 + kk) * N + n0 + (lane & 31)]; }
    LDS_WAIT(); asm volatile("" ::: "memory");
    const int c = lane & 7;
#pragma unroll
    for (int j = 0; j < 4; ++j) { const int n = (lane >> 3) + 8 * j; const LAS float* s = scr + (8 * c) * 33 + n;
        u32x4 o; o.x = pk2(s[0 * 33], s[1 * 33]); o.y = pk2(s[2 * 33], s[3 * 33]); o.z = pk2(s[4 * 33], s[5 * 33]); o.w = pk2(s[6 * 33], s[7 * 33]);
        *(GAS u32x4*)(WT + (size_t)(n0 + n) * K + k0 + 8 * c) = o; }
    LDS_WAIT(); asm volatile("" ::: "memory");
}
__device__ __forceinline__ int slab_pos(int k, int n) { return k * 32 + ((n + (k >> 4) + (k & 3)) & 31); }
template <int FMT>
__device__ __forceinline__ void quant_slab(Frame& F, const float* W, int N, int n0, unsigned char* Q, float* SC) {
    LAS float* S = (LAS float*)F.lds;
    LAS float* red = (LAS float*)(F.lds + L_SLOTE);
    LAS float* scl = (LAS float*)(F.lds + L_HIST);
    const int tid = F.tid;
#pragma unroll 4
    for (int i = tid; i < 8192; i += NTHREADS) { const int k = i >> 3, c4 = i & 7; const f32x4 v = *(const GAS f32x4*)(W + (size_t)k * N + n0 + c4 * 4);
        S[slab_pos(k, c4 * 4 + 0)] = v.x; S[slab_pos(k, c4 * 4 + 1)] = v.y; S[slab_pos(k, c4 * 4 + 2)] = v.z; S[slab_pos(k, c4 * 4 + 3)] = v.w; }
    __syncthreads();
    { const int n = tid & 31, part = tid >> 5; float am = 0.f;
#pragma unroll 8
      for (int kk = 0; kk < 64; ++kk) am = fmaxf(am, fabsf(S[slab_pos(part * 64 + kk, n)]));
      am = fmaxf(am, __shfl_xor(am, 32));
      if (F.lane < 32) red[F.wave * 32 + n] = am; }
    __syncthreads();
    if (tid < 32) { float am = 0.f;
#pragma unroll
        for (int w = 0; w < 8; ++w) am = fmaxf(am, red[w * 32 + tid]);
        float qs, inv;
        if (FMT == 1) { qs = am > 0.f ? 127.f / am : 0.f; inv = am * (1.f / 127.f); }
        else { int ex = 0; (void)frexpf(am > 0.f ? am : 1.f, &ex); qs = ldexpf(1.f, 7 - ex); inv = ldexpf(1.f, ex - 7); }
        scl[tid] = qs; SC[n0 + tid] = inv; }
    __syncthreads();
#pragma unroll
    for (int it = 0; it < 4; ++it) {
        const int n = (tid >> 6) + 8 * it, c = tid & 63; const float qs = scl[n];
        float v[16];
#pragma unroll
        for (int i = 0; i < 16; ++i) v[i] = S[slab_pos(16 * c + i, n)] * qs;
        u32x4 o;
        if (FMT == 1) {
#pragma unroll
            for (int d = 0; d < 4; ++d) { const int q0 = (int)rintf(v[4 * d]), q1 = (int)rintf(v[4 * d + 1]), q2 = (int)rintf(v[4 * d + 2]), q3 = (int)rintf(v[4 * d + 3]);
                o[d] = (unsigned)(q0 & 255) | ((unsigned)(q1 & 255) << 8) | ((unsigned)(q2 & 255) << 16) | ((unsigned)q3 << 24); }
        } else {
#pragma unroll
            for (int d = 0; d < 4; ++d) { int w = __builtin_amdgcn_cvt_pk_fp8_f32(v[4 * d], v[4 * d + 1], 0, false); w = __builtin_amdgcn_cvt_pk_fp8_f32(v[4 * d + 2], v[4 * d + 3], w, true); o[d] = (unsigned)w; }
        }
        *(GAS u32x4*)(Q + (size_t)(n0 + n) * 1024 + 16 * c) = o;
    }
    __syncthreads();
}
__device__ __forceinline__ void phase_convert(Frame& F) {
    constexpr int S_GU = 64 * 64, S_DN = 0, S_QKV = 288;
    for (int sl = blockIdx.x; sl < S_GU + S_DN + S_QKV; sl += F.G) {
        if (sl < S_GU) { const int mat = sl >> 6, n0 = (sl & 63) * 32;
            quant_slab<1>(F, F.w_gu + (size_t)mat * 1024 * 2048, 2048, n0, F.ws + WS_WGU + (size_t)mat * 2048 * 1024, (float*)(F.ws + WS_SC_GU) + mat * 2048); }
        else if (sl < S_GU + S_DN) { const int r = sl - S_GU, mat = r >> 5, n0 = (r & 31) * 32;
            quant_slab<2>(F, F.w_dn + (size_t)mat * 1024 * 1024, 1024, n0, F.ws + WS_WDN + (size_t)mat * 1024 * 1024, (float*)(F.ws + WS_SC_DN) + mat * 1024); }
        else { const int n0 = (sl - S_GU - S_DN) * 32; quant_slab<1>(F, F.w_qkv, NQKV, n0, F.ws + WS_WQKV, (float*)(F.ws + WS_SC_QKV)); }
    }
    LAS float* scr = (LAS float*)(F.lds + F.wave * 16384);
    const int gw = blockIdx.x * NWAVES + F.wave, NGW = F.G * NWAVES;
    constexpr int I_DN = 64 * 512, I_WO = 512, I_POOL = 4 * 32;
    constexpr int NITEMS = I_DN + I_WO + I_POOL;
    for (int it = gw; it < NITEMS; it += NGW) {
        int r = it;
        if (r < I_DN) { const int mat = r >> 9; transpose_item(F.w_dn + (size_t)mat * 1024 * 1024, 1024, 1024, (bf16*)(F.ws + WS_WDN) + (size_t)mat * 1024 * 1024, scr, r & 511, F.lane); continue; } r -= I_DN;
        if (r < I_WO) { transpose_item(F.w_o, 1024, 1024, (bf16*)(F.ws + WS_WO), scr, r, F.lane); continue; } r -= I_WO;
        { const int mat = r >> 5; transpose_item(F.pool_w + (size_t)mat * 65536, 256, 256, (bf16*)(F.ws + WS_WPOOL) + (size_t)mat * 65536, scr, r & 31, F.lane); }
    }
    float* wrt = (float*)(F.ws + WS_WRT);
    for (int i = blockIdx.x * NTHREADS + F.tid; i < 2 * 32 * 1024; i += F.G * NTHREADS) { const int l = i >> 15, e = (i >> 10) & 31, c = i & 1023; wrt[i] = F.w_router[(size_t)l * 32768 + c * 32 + e]; }
}

__device__ __forceinline__ void quant_row_i8(const f32x4 (&h)[4], unsigned (&w)[4], float& inv) {
    float am = 0.f;
#pragma unroll
    for (int j = 0; j < 4; ++j) am = fmaxf(fmaxf(am, fmaxf(fabsf(h[j].x), fabsf(h[j].y))), fmaxf(fabsf(h[j].z), fabsf(h[j].w)));
#pragma unroll
    for (int o = 1; o < 64; o <<= 1) am = fmaxf(am, __shfl_xor(am, o));
    const float qs = am > 0.f ? 127.f / am : 0.f; inv = am * (1.f / 127.f);
#pragma unroll
    for (int j = 0; j < 4; ++j) { const int q0 = (int)rintf(h[j].x * qs), q1 = (int)rintf(h[j].y * qs), q2 = (int)rintf(h[j].z * qs), q3 = (int)rintf(h[j].w * qs);
        w[j] = (unsigned)(q0 & 255) | ((unsigned)(q1 & 255) << 8) | ((unsigned)(q2 & 255) << 16) | ((unsigned)q3 << 24); }
}

__device__ __forceinline__ void router_tile(Frame& F, int layer, int tok0) {
    LAS int* hist = (LAS int*)(F.lds + L_HIST); LAS int* base = (LAS int*)(F.lds + L_BASE);
    LAS int* slot_e = (LAS int*)(F.lds + L_SLOTE); LAS int* slot_p = (LAS int*)(F.lds + L_SLOTP); LAS float* slot_g = (LAS float*)(F.lds + L_SLOTG);
    const int lane = F.lane;
    if (F.tid < 32) hist[F.tid] = 0;
    __syncthreads();
    const float* wrt = (const float*)(F.ws + WS_WRT) + (size_t)layer * 32 * 1024;
    const float* g2 = F.norm_ffn_g + layer * 1024;
    unsigned char* H2 = F.ws + WS_H2; float* HS = (float*)(F.ws + WS_HS);
    f32x4 gv[4];
#pragma unroll
    for (int j = 0; j < 4; ++j) gv[j] = *(const f32x4*)(g2 + lane * 4 + 256 * j);
    const float brl = (lane < 32) ? F.b_router[layer * 32 + lane] : 0.f;
    for (int half = 0; half < 2; ++half) {
        const int rb = F.wave * 8 + half * 4;
        f32x4 h[4][4];
#pragma unroll
        for (int r = 0; r < 4; ++r) {
            const int tok = tok0 + rb + r;
            const GAS f32x4* xr = (const GAS f32x4*)(F.out + (size_t)tok * 1024) + lane;
            float ss = 0.f;
#pragma unroll
            for (int j = 0; j < 4; ++j) { h[r][j] = xr[64 * j]; ss += (h[r][j].x * h[r][j].x + h[r][j].y * h[r][j].y) + (h[r][j].z * h[r][j].z + h[r][j].w * h[r][j].w); }
            const float rstd = rsqrtf(wave_sum(ss) * (1.f / 1024.f) + EPS);
#pragma unroll
            for (int j = 0; j < 4; ++j) h[r][j] = h[r][j] * rstd * gv[j];
            unsigned qw[4]; float inv; quant_row_i8(h[r], qw, inv);
            GAS unsigned* o4 = (GAS unsigned*)(H2 + (size_t)tok * 1024) + lane;
#pragma unroll
            for (int j = 0; j < 4; ++j) o4[64 * j] = qw[j];
            if (lane == 0) HS[tok] = inv;
        }
        float lg[4] = {0.f, 0.f, 0.f, 0.f};
        for (int e = 0; e < 32; ++e) {
            f32x4 w[4];
#pragma unroll
            for (int j = 0; j < 4; ++j) w[j] = *(const f32x4*)(wrt + e * 1024 + lane * 4 + 256 * j);
#pragma unroll
            for (int r = 0; r < 4; ++r) {
                float p = 0.f;
#pragma unroll
                for (int j = 0; j < 4; ++j) p += (h[r][j].x * w[j].x + h[r][j].y * w[j].y) + (h[r][j].z * w[j].z + h[r][j].w * w[j].w);
                p = wave_sum(p);
                lg[r] = (lane == e) ? p : lg[r];
            }
        }
#pragma unroll
        for (int r = 0; r < 4; ++r) {
            float v = (lane < 32) ? lg[r] + brl : -INFINITY;
            float tv[4]; int ti[4];
#pragma unroll
            for (int k = 0; k < 4; ++k) {
                float bv = v; int bi = lane;
#pragma unroll
                for (int off = 32; off >= 1; off >>= 1) { const float ov = __shfl_xor(bv, off); const int oi = __shfl_xor(bi, off); if (ov > bv || (ov == bv && oi < bi)) { bv = ov; bi = oi; } }
                tv[k] = bv; ti[k] = bi; if (lane == bi) v = -INFINITY;
            }
            const float e1 = __expf(tv[1] - tv[0]), e2 = __expf(tv[2] - tv[0]), e3 = __expf(tv[3] - tv[0]);
            const float inv = 1.f / (1.f + e1 + e2 + e3);
            if (lane < 4) {
                const int e = lane == 0 ? ti[0] : lane == 1 ? ti[1] : lane == 2 ? ti[2] : ti[3];
                const float gt = (lane == 0 ? 1.f : lane == 1 ? e1 : lane == 2 ? e2 : e3) * inv;
                const int lp = atomicAdd((int*)(hist + e), 1);
                const int s = (rb + r) * 4 + lane;
                slot_e[s] = e; slot_p[s] = lp; slot_g[s] = gt;
            }
        }
    }
    __syncthreads();
    if (F.tid < 32) base[F.tid] = (int)__hip_atomic_fetch_add((unsigned*)(F.ctl + CW_CNT + layer * 32 + F.tid), (unsigned)hist[F.tid], RLX_AGENT);
    __syncthreads();
    if (F.tid < 256) {
        const int e = slot_e[F.tid]; const int pos = base[e] + slot_p[F.tid];
        ((int*)(F.ws + WS_ROWSLOT))[e * CAP + pos] = (tok0 + (F.tid >> 2)) * 4 + (F.tid & 3);
        ((float*)(F.ws + WS_ROWGATE))[e * CAP + pos] = slot_g[F.tid];
        ((float*)(F.ws + WS_ROWHS))[e * CAP + pos] = ((const float*)(F.ws + WS_HS))[tok0 + (F.tid >> 2)];
    }
    __syncthreads();
}

__device__ __forceinline__ int pswz(int r, int c) { return r * 2048 + ((((c >> 3) ^ (r & 7)) << 4) | ((c & 7) << 1)); }
template <int W>
__device__ __forceinline__ void pool_window(const float* x, int tok0, int s0, const LAS float* rstd1, float gx, float gy, LAS unsigned char* P, int tid) {
    float rx[W], ry[W];
    const GAS f32x2* xp = (const GAS f32x2*)x + tid;
#pragma unroll
    for (int j = 0; j < W; ++j) { const int s = s0 - W + j; float hx = 0.f, hy = 0.f;
        if (s >= 0) { const f32x2 v = xp[(size_t)(tok0 - W + j) * 512]; const float r = rstd1[16 - W + j]; hx = v.x * r * gx; hy = v.y * r * gy; }
        rx[j] = hx; ry[j] = hy; }
    for (int sc = 0; sc < 4; ++sc) {
        f32x2 v[16];
#pragma unroll
        for (int j = 0; j < 16; ++j) v[j] = xp[(size_t)(tok0 + sc * 16 + j) * 512];
#pragma unroll
        for (int j = 0; j < 16; ++j) {
            const int tl = sc * 16 + j; const float r = rstd1[16 + tl];
            const float hx = v[j].x * r * gx, hy = v[j].y * r * gy;
            rx[j % W] = hx; ry[j % W] = hy;
            float sx = 0.f, sy = 0.f;
#pragma unroll
            for (int q = 0; q < W; ++q) { sx += rx[q]; sy += ry[q]; }
            const int s = s0 + tl; const int cn = (s + 1 < W) ? (s + 1) : W; const float inv = 1.f / (float)cn;
            *(LAS unsigned*)(P + pswz(tl, 2 * tid)) = pk2(sx * inv - hx, sy * inv - hy);
        }
    }
}
__device__ __forceinline__ void phase_pool(Frame& F) {
    LAS unsigned char* P = F.lds;
    LAS float* rstd1 = (LAS float*)(F.lds + L_RSTD);
    const int lane = F.lane, wave = F.wave, tid = F.tid;
    const int fr = lane & 15, fq = lane >> 4;
    for (int tile = blockIdx.x; tile < NTOK / 64; tile += F.G) {
        const int tok0 = tile * 64, s0 = tok0 & (SEQ - 1);
        for (int rr = wave; rr < 80; rr += 8) {
            const int s = s0 - 16 + rr; float r = 0.f;
            if (s >= 0) {
                const GAS f32x4* xr = (const GAS f32x4*)(F.x + (size_t)(tok0 - 16 + rr) * 1024) + lane; float ss = 0.f;
#pragma unroll
                for (int j = 0; j < 4; ++j) { const f32x4 v = xr[64 * j]; ss += (v.x * v.x + v.y * v.y) + (v.z * v.z + v.w * v.w); }
                r = rsqrtf(wave_sum(ss) * (1.f / 1024.f) + EPS);
            }
            if (lane == 0) rstd1[rr] = r;
        }
        __syncthreads();
        { const float gx = F.norm_mix_g[2 * tid], gy = F.norm_mix_g[2 * tid + 1];
          const int grp = wave >> 1;
          if (grp == 0) pool_window<2>(F.x, tok0, s0, rstd1, gx, gy, P, tid);
          else if (grp == 1) pool_window<4>(F.x, tok0, s0, rstd1, gx, gy, P, tid);
          else if (grp == 2) pool_window<8>(F.x, tok0, s0, rstd1, gx, gy, P, tid);
          else pool_window<16>(F.x, tok0, s0, rstd1, gx, gy, P, tid); }
        __syncthreads();
        { const int gi = wave >> 1, nh = wave & 1;
          const bf16* Wt = (const bf16*)(F.ws + WS_WPOOL) + (size_t)gi * 65536 + (size_t)(nh * 128) * 256;
          f32x4 acc[4][8];
#pragma unroll
          for (int m = 0; m < 4; ++m)
#pragma unroll
              for (int n = 0; n < 8; ++n) acc[m][n] = (f32x4){0.f, 0.f, 0.f, 0.f};
#pragma unroll 2
          for (int ks = 0; ks < 8; ++ks) {
              bf16x8 a[4];
#pragma unroll
              for (int m = 0; m < 4; ++m) a[m] = *(const LAS bf16x8*)(P + pswz(m * 16 + fr, gi * 256 + ks * 32 + fq * 8));
#pragma unroll
              for (int n = 0; n < 8; ++n) {
                  const bf16x8 b = *(const GAS bf16x8*)(Wt + (size_t)(n * 16 + fr) * 256 + ks * 32 + fq * 8);
#pragma unroll
                  for (int m = 0; m < 4; ++m) acc[m][n] = __builtin_amdgcn_mfma_f32_16x16x32_bf16(b, a[m], acc[m][n], 0, 0, 0);
              }
          }
#pragma unroll
          for (int n = 0; n < 8; ++n) {
              const int col = gi * 256 + nh * 128 + n * 16 + fq * 4;
              const f32x4 sc = *(const f32x4*)(F.pool_scale + col);
#pragma unroll
              for (int m = 0; m < 4; ++m) {
                  const size_t off = (size_t)(tok0 + m * 16 + fr) * 1024 + col;
                  const f32x4 xv = *(const GAS f32x4*)(F.x + off);
                  *(GAS f32x4*)(F.out + off) = xv + acc[m][n] * sc;
              }
          }
        }
        VM_WAIT();
        __syncthreads();
        router_tile(F, 0, tok0);
    }
}
__device__ __forceinline__ void phase_router(Frame& F, int layer) {
    for (int tile = blockIdx.x; tile < NTOK / 64; tile += F.G) router_tile(F, layer, tile * 64);
}

__device__ __forceinline__ void moe_tables(Frame& F, int layer) {
    LAS int* cntL = (LAS int*)(F.lds + L_CNT); LAS int* prow0 = (LAS int*)(F.lds + L_PROW0); LAS int* ntp = (LAS int*)(F.lds + L_NT);
    LAS int* tileE = (LAS int*)(F.lds + L_TILEE); LAS int* tileRow = (LAS int*)(F.lds + L_TILEROW);
    __syncthreads();
    if (F.tid == 0) {
        int acc = 0, T = 0;
        for (int e = 0; e < 32; ++e) {
            int c = (int)__hip_atomic_load((unsigned*)(F.ctl + CW_CNT + layer * 32 + e), RLX_AGENT);
            if (c > CAP) c = CAP;
            cntL[e] = c; prow0[e] = acc;
            const int mt = (c + 255) >> 8;
            for (int m = 0; m < mt && T < MAXT; ++m) { tileE[T] = e; tileRow[T] = acc + m * 256; ++T; }
            acc += mt * 256;
        }
        ntp[0] = T;
    }
    __syncthreads();
}
template <bool GATH>
struct MoeOrderT {
    static constexpr bool GATHER = GATH;
    int NT, nN, G, c; const LAS int* tileE; const LAS int* tileRow; const LAS int* cntL; const LAS int* prow0; const int* rowslot;
    const char* Abase; const char* Bbase; size_t bExp, bTile; int aPitch;
    __device__ __forceinline__ bool next(int i, pg8::Unit& u) const {
        int T, pn; if (!pg8::tile_order(i, G, c, NT, nN, T, pn)) return false;
        const int e = tileE[T], row0 = tileRow[T];
        u.a = GATH ? Abase : Abase + (size_t)row0 * aPitch; u.b = Bbase + (size_t)e * bExp + (size_t)pn * bTile; u.i0 = T; u.i1 = pn; u.i2 = e; u.i3 = row0; return true;
    }
    __device__ __forceinline__ int row_src(const pg8::Unit& u, int r) const {
        const int e = u.i2, cn = cntL[e]; int pos = u.i3 - prow0[e] + r; pos = pos < cn ? pos : cn - 1;
        return rowslot[e * CAP + pos] >> 2;
    }
};
struct EpiGU {
    typedef v4i ACC; static constexpr int MODE = 1;
    static __host__ __device__ __forceinline__ int brow(int R) { return (R & ~31) + pg8::perm32(R & 31); }
    bf16* ACT; const float* bgu; const float* wsc; const float* rowhs; const LAS int* prow0;
    __device__ __forceinline__ void operator()(const v4i (&acc)[2][2][4][2], const pg8::Unit& u, int wr, int wc, int fr, int fq) const {
        const int e = u.i2, f0 = u.i1 * 128 + wc * 32 + 8 * fq;
        const float* bg = bgu + (size_t)e * 2048 + f0; const float* sp = wsc + (size_t)e * 2048 + f0;
        const f32x4 bg0 = *(const f32x4*)(bg), bg1 = *(const f32x4*)(bg + 4), bu0 = *(const f32x4*)(bg + 1024), bu1 = *(const f32x4*)(bg + 1028);
        const f32x4 sg0 = *(const f32x4*)(sp), sg1 = *(const f32x4*)(sp + 4), su0 = *(const f32x4*)(sp + 1024), su1 = *(const f32x4*)(sp + 1028);
        const int pbase = u.i3 - prow0[e];
        float rsv[2][4];
#pragma unroll
        for (int ai = 0; ai < 2; ++ai)
#pragma unroll
            for (int m = 0; m < 4; ++m) rsv[ai][m] = rowhs[e * CAP + pbase + ai * 128 + wr * 64 + m * 16 + fr];
#pragma unroll
        for (int ai = 0; ai < 2; ++ai)
#pragma unroll
            for (int m = 0; m < 4; ++m) {
                const int prow = u.i3 + ai * 128 + wr * 64 + m * 16 + fr; const float rs = rsv[ai][m];
                const f32x4 g0 = __builtin_convertvector(acc[ai][0][m][0], f32x4) * (sg0 * rs) + bg0, g1 = __builtin_convertvector(acc[ai][0][m][1], f32x4) * (sg1 * rs) + bg1;
                const f32x4 u0 = __builtin_convertvector(acc[ai][1][m][0], f32x4) * (su0 * rs) + bu0, u1 = __builtin_convertvector(acc[ai][1][m][1], f32x4) * (su1 * rs) + bu1;
                float o[8];
#pragma unroll
                for (int j = 0; j < 8; ++j) {
                    const float g = fminf(j < 4 ? g0[j & 3] : g1[j & 3], 7.f);
                    const float up = fminf(fmaxf(j < 4 ? u0[j & 3] : u1[j & 3], -7.f), 7.f);
                    const float sg = __builtin_amdgcn_rcpf(1.f + __builtin_amdgcn_exp2f(-1.702f * 1.4426950408889634f * g));
                    o[j] = (up + 1.f) * (g * sg);
                }
                u32x4 w; w.x = cvt_pk_bf16(o[0], o[1]); w.y = cvt_pk_bf16(o[2], o[3]); w.z = cvt_pk_bf16(o[4], o[5]); w.w = cvt_pk_bf16(o[6], o[7]);
                *(GAS u32x4*)(ACT + (size_t)prow * 1024 + f0) = w;
            }
    }
};
struct EpiDN {
    typedef f32x4 ACC; static constexpr int MODE = 0;
    static __host__ __device__ __forceinline__ int brow(int R) { return (R & ~31) + pg8::perm32(R & 31); }
    bf16* Y; const float* bdn; const float* wsc; const int* rowslot; const float* rowgate; const LAS int* cntL; const LAS int* prow0;
    __device__ __forceinline__ void operator()(const f32x4 (&acc)[2][2][4][2], const pg8::Unit& u, int wr, int wc, int fr, int fq) const {
        const int e = u.i2, col0 = u.i1 * 256 + wc * 32 + 8 * fq;
        const float* bp = bdn + (size_t)e * 1024 + col0;
        f32x4 bv[2][2], sv[2][2];
#pragma unroll
        for (int bj = 0; bj < 2; ++bj)
#pragma unroll
            for (int n = 0; n < 2; ++n) { bv[bj][n] = *(const f32x4*)(bp + bj * 128 + 4 * n); sv[bj][n] = (f32x4){1.f, 1.f, 1.f, 1.f}; }
        const int pbase = u.i3 - prow0[e], cn = cntL[e];
#pragma unroll
        for (int ai = 0; ai < 2; ++ai)
#pragma unroll
            for (int m = 0; m < 4; ++m) {
                const int pos = pbase + ai * 128 + wr * 64 + m * 16 + fr;
                if (pos < cn) {
                    const int slot = rowslot[e * CAP + pos]; const float gt = rowgate[e * CAP + pos];
                    bf16* rowp = Y + (size_t)slot * 1024 + col0;
#pragma unroll
                    for (int bj = 0; bj < 2; ++bj) {
                        const f32x4 v0 = (acc[ai][bj][m][0] * sv[bj][0] + bv[bj][0]) * gt, v1 = (acc[ai][bj][m][1] * sv[bj][1] + bv[bj][1]) * gt;
                        u32x4 w; w.x = cvt_pk_bf16(v0[0], v0[1]); w.y = cvt_pk_bf16(v0[2], v0[3]); w.z = cvt_pk_bf16(v1[0], v1[1]); w.w = cvt_pk_bf16(v1[2], v1[3]);
                        *(GAS u32x4*)(rowp + bj * 128) = w;
                    }
                }
            }
    }
};
__device__ __forceinline__ void phase_moe_gu(Frame& F, int layer) {
    moe_tables(F, layer);
    typedef MoeOrderT<true> Ord;
    Ord S; S.NT = *(const LAS int*)(F.lds + L_NT); S.nN = 8; S.G = F.G; S.c = blockIdx.x; S.tileE = (const LAS int*)(F.lds + L_TILEE); S.tileRow = (const LAS int*)(F.lds + L_TILEROW);
    S.cntL = (const LAS int*)(F.lds + L_CNT); S.prow0 = (const LAS int*)(F.lds + L_PROW0); S.rowslot = (const int*)(F.ws + WS_ROWSLOT);
    S.Abase = (const char*)(F.ws + WS_H2); S.Bbase = (const char*)(F.ws + WS_WGU) + (size_t)layer * 32 * 2048 * 1024; S.bExp = (size_t)2048 * 1024; S.bTile = (size_t)128 * 1024; S.aPitch = 1024;
    EpiGU E; E.ACT = (bf16*)(F.ws + WS_ACT); E.bgu = F.b_gu + (size_t)layer * 32 * 2048; E.wsc = (const float*)(F.ws + WS_SC_GU) + (size_t)layer * 32 * 2048; E.rowhs = (const float*)(F.ws + WS_ROWHS);
    E.prow0 = (const LAS int*)(F.lds + L_PROW0);
    pg8::gemm_phase<EpiGU, Ord, true, true>(F.lds, (size_t)1024 * 1024, S, E);
}
__device__ __forceinline__ void phase_moe_dn(Frame& F, int layer) {
    moe_tables(F, layer);
    typedef MoeOrderT<false> Ord;
    Ord S; S.NT = *(const LAS int*)(F.lds + L_NT); S.nN = 4; S.G = F.G; S.c = blockIdx.x; S.tileE = (const LAS int*)(F.lds + L_TILEE); S.tileRow = (const LAS int*)(F.lds + L_TILEROW);
    S.cntL = (const LAS int*)(F.lds + L_CNT); S.prow0 = (const LAS int*)(F.lds + L_PROW0); S.rowslot = (const int*)(F.ws + WS_ROWSLOT);
    S.Abase = (const char*)(F.ws + WS_ACT); S.Bbase = (const char*)(F.ws + WS_WDN) + (size_t)layer * 32 * 1024 * 1024 * 2; S.bExp = (size_t)1024 * 1024 * 2; S.bTile = (size_t)256 * 1024 * 2; S.aPitch = 2048;
    EpiDN E; E.Y = (bf16*)(F.ws + WS_Y); E.bdn = F.b_dn + (size_t)layer * 32 * 1024; E.wsc = (const float*)(F.ws + WS_SC_DN) + (size_t)layer * 32 * 1024;
    E.rowslot = (const int*)(F.ws + WS_ROWSLOT); E.rowgate = (const float*)(F.ws + WS_ROWGATE);
    E.cntL = (const LAS int*)(F.lds + L_CNT); E.prow0 = (const LAS int*)(F.lds + L_PROW0);
    pg8::gemm_phase<EpiDN, Ord, true, true>(F.lds, (size_t)128 * 1024 * 2, S, E);
}

__device__ __forceinline__ void phase_combine(Frame& F, int layer) {
    const int gw = blockIdx.x * NWAVES + F.wave, NGW = F.G * NWAVES, lane = F.lane;
    const bf16* Y = (const bf16*)(F.ws + WS_Y); unsigned char* H2 = F.ws + WS_H2; float* HS = (float*)(F.ws + WS_HS);
    f32x4 gv[4];
#pragma unroll
    for (int j = 0; j < 4; ++j) gv[j] = *(const f32x4*)(F.norm_mix_g + 1024 + lane * 4 + 256 * j);
    for (int tok = gw; tok < NTOK; tok += NGW) {
        GAS f32x4* xr = (GAS f32x4*)(F.out + (size_t)tok * 1024) + lane;
        f32x4 v[4];
#pragma unroll
        for (int j = 0; j < 4; ++j) v[j] = xr[64 * j];
#pragma unroll
        for (int k = 0; k < 4; ++k) {
            const GAS u32x2* yr = (const GAS u32x2*)(Y + (size_t)(tok * 4 + k) * 1024) + lane;
#pragma unroll
            for (int j = 0; j < 4; ++j) { const u32x2 w = yr[64 * j]; v[j].x += bflo(w.x); v[j].y += bfhi(w.x); v[j].z += bflo(w.y); v[j].w += bfhi(w.y); }
        }
        float ss = 0.f;
#pragma unroll
        for (int j = 0; j < 4; ++j) { xr[64 * j] = v[j]; ss += (v[j].x * v[j].x + v[j].y * v[j].y) + (v[j].z * v[j].z + v[j].w * v[j].w); }
        if (layer == 0) {
            const float rstd = rsqrtf(wave_sum(ss) * (1.f / 1024.f) + EPS);
            f32x4 h[4];
#pragma unroll
            for (int j = 0; j < 4; ++j) h[j] = v[j] * rstd * gv[j];
            unsigned qw[4]; float inv; quant_row_i8(h, qw, inv);
            GAS unsigned* o4 = (GAS unsigned*)(H2 + (size_t)tok * 1024) + lane;
#pragma unroll
            for (int j = 0; j < 4; ++j) o4[64 * j] = qw[j];
            if (lane == 0) HS[tok] = inv;
        }
    }
}

struct DenseOrder {
    static constexpr bool GATHER = false;
    __device__ __forceinline__ int row_src(const pg8::Unit&, int) const { return 0; }
    int nM, nN, G, c; const char* Abase; const char* Bbase; int pitch;
    __device__ __forceinline__ bool next(int i, pg8::Unit& u) const {
        int pm, pn; if (!pg8::tile_order(i, G, c, nM, nN, pm, pn)) return false;
        u.a = Abase + (size_t)pm * 256 * pitch; u.b = Bbase + (size_t)pn * 256 * pitch; u.i0 = pm; u.i1 = pn; u.i2 = 0; u.i3 = 0; return true;
    }
};
struct EpiQKV {
    typedef v4i ACC; static constexpr int MODE = 1;
    static __host__ __device__ __forceinline__ int brow(int R) { return 2 * (R & ~31) + pg8::perm32(R & 31); }
    bf16* O; const float* qg; const float* kg; const float* wsc; const float* hs;
    __device__ __forceinline__ void operator()(const v4i (&acc)[2][2][4][2], const pg8::Unit& u, int wr, int wc, int fr, int fq) const {
        const int pn = u.i1, which = pn / 12;
        const int colh = pn * 256 + wc * 64;
        f32x4 gn[2][2], sc[2][2];
#pragma unroll
        for (int bj = 0; bj < 2; ++bj)
#pragma unroll
            for (int n = 0; n < 2; ++n) {
                const int hd = bj * 32 + 8 * fq + 4 * n;
                gn[bj][n] = which == 0 ? *(const f32x4*)(qg + hd) * 0.125f : which == 1 ? *(const f32x4*)(kg + hd) : (f32x4){1.f, 1.f, 1.f, 1.f};
                sc[bj][n] = *(const f32x4*)(wsc + colh + hd);
            }
#pragma unroll
        for (int ai = 0; ai < 2; ++ai)
#pragma unroll
            for (int m = 0; m < 4; ++m) {
                const int row = u.i0 * 256 + ai * 128 + wr * 64 + m * 16 + fr; const float rsc = hs[row];
                f32x4 v[2][2]; float ss = 0.f;
#pragma unroll
                for (int bj = 0; bj < 2; ++bj)
#pragma unroll
                    for (int n = 0; n < 2; ++n) { v[bj][n] = __builtin_convertvector(acc[ai][bj][m][n], f32x4) * (sc[bj][n] * rsc); const f32x4 t = v[bj][n]; ss += (t[0] * t[0] + t[1] * t[1]) + (t[2] * t[2] + t[3] * t[3]); }
                ss += __shfl_xor(ss, 16); ss += __shfl_xor(ss, 32);
                const float rs = which == 2 ? 1.f : rsqrtf(ss * (1.f / 64.f) + EPS);
                bf16* rowp = O + (size_t)row * NQKV + colh + 8 * fq;
#pragma unroll
                for (int bj = 0; bj < 2; ++bj) {
                    const f32x4 v0 = v[bj][0] * rs * gn[bj][0], v1 = v[bj][1] * rs * gn[bj][1];
                    u32x4 w; w.x = cvt_pk_bf16(v0[0], v0[1]); w.y = cvt_pk_bf16(v0[2], v0[3]); w.z = cvt_pk_bf16(v1[0], v1[1]); w.w = cvt_pk_bf16(v1[2], v1[3]);
                    *(GAS u32x4*)(rowp + bj * 32) = w;
                }
            }
    }
};
__device__ __forceinline__ void phase_qkv(Frame& F) {
    DenseOrder S; S.nM = NTOK / 256; S.nN = NQKV / 256; S.G = F.G; S.c = blockIdx.x; S.Abase = (const char*)(F.ws + WS_H2); S.Bbase = (const char*)(F.ws + WS_WQKV); S.pitch = 1024;
    EpiQKV E; E.O = (bf16*)(F.ws + WS_QKV); E.qg = F.q_gain; E.kg = F.k_gain; E.wsc = (const float*)(F.ws + WS_SC_QKV); E.hs = (const float*)(F.ws + WS_HS);
    pg8::gemm_phase<EpiQKV, DenseOrder, true, true>(F.lds, (size_t)32 * 1024, S, E);
}

struct EpiWo {
    typedef f32x4 ACC; static constexpr int MODE = 0;
    static __host__ __device__ __forceinline__ int brow(int R) { return R; }
    float* X;
    __device__ __forceinline__ void operator()(const f32x4 (&acc)[2][2][4][2], const pg8::Unit& u, int wr, int wc, int fr, int fq) const {
        const int row0 = u.i0 * 256 + wr * 64 + fr, col0 = u.i1 * 256 + wc * 32 + 4 * fq;
#pragma unroll
        for (int ai = 0; ai < 2; ++ai)
#pragma unroll
            for (int m = 0; m < 4; ++m) { float* rowp = X + (size_t)(row0 + ai * 128 + m * 16) * 1024 + col0;
#pragma unroll
                for (int bj = 0; bj < 2; ++bj)
#pragma unroll
                    for (int n = 0; n < 2; ++n) { GAS f32x4* p = (GAS f32x4*)(rowp + bj * 128 + n * 16); *p = *p + acc[ai][bj][m][n]; } }
    }
};
__device__ __forceinline__ void phase_wo(Frame& F) {
    DenseOrder S; S.nM = NTOK / 256; S.nN = 4; S.G = F.G; S.c = blockIdx.x; S.Abase = (const char*)(F.ws + WS_OB); S.Bbase = (const char*)(F.ws + WS_WO); S.pitch = 2048;
    EpiWo E; E.X = F.out;
    pg8::gemm_phase<EpiWo, DenseOrder, false, true>(F.lds, (size_t)128 * 1024 * 2, S, E);
}

typedef short v4i16_t __attribute__((ext_vector_type(4)));
__device__ __forceinline__ s16x4 vtr(const LAS unsigned char* p) { return __builtin_bit_cast(s16x4, __builtin_amdgcn_ds_read_tr16_b64_v4i16((LAS v4i16_t*)p)); }
__device__ __forceinline__ void phase_attn(Frame& F) {
    LAS unsigned char* lds = F.lds;
    LAS float* biasL = (LAS float*)(lds + L_BIAS); LAS int* bucketL = (LAS int*)(lds + L_BUCKET);
    const int tid = F.tid, lane = F.lane, wave = F.wave;
    for (int i = tid; i < 3 * 129; i += NTHREADS) {
        const int g = i / 129, d = i % 129; const int n = d * (g == 0 ? 1 : g == 1 ? 4 : 16);
        int bk;
        if (n < 16) bk = n;
        else { const float nf = (float)n; int lg = 16 + (int)(logf(nf / 16.f) / 4.852030263919617f * 16.f); bk = lg < 31 ? lg : 31; }
        bucketL[g * 132 + d] = bk;
    }
    __syncthreads();
    const int hg = wave >> 2, w = wave & 3, t2 = tid & 255;
    const int q = lane & 31, hh = lane >> 5;
    const bf16* QKV = (const bf16*)(F.ws + WS_QKV);
    LAS unsigned char* Kb = lds + hg * 32768;
    LAS unsigned char* Vb = lds + 65536 + hg * 32768;
    for (int item = blockIdx.x; item < 3072; item += F.G) {
        const int hp = item & 7, gb = item >> 3, g = gb >> 7, blk = gb & 127;
        const int dil = g == 0 ? 1 : g == 1 ? 4 : 16;
        const int nb = 16 / dil;
        const int z = blk / nb, i = blk % nb, b = z / dil, r = z % dil;
        const int head = hp * 2 + hg;
        const size_t rowbase = (size_t)b * SEQ + r;
        {
            const int it0 = (i == 0) ? 4 : 0;
            u32x4 kv[8], vv[8];
#pragma unroll
            for (int it = 0; it < 8; ++it) {
                if (it >= it0) {
                    const int cidx = t2 + 256 * it, row = cidx >> 3, ch = cidx & 7;
                    const long j = (long)(i - 1) * 128 + row;
                    const bf16* src = QKV + (rowbase + (size_t)dil * j) * NQKV + g * 1024 + head * 64 + ch * 8;
                    kv[it] = *(const GAS u32x4*)(src + 3072); vv[it] = *(const GAS u32x4*)(src + 6144);
                }
            }
#pragma unroll
            for (int it = 0; it < 8; ++it) {
                if (it >= it0) {
                    const int cidx = t2 + 256 * it, row = cidx >> 3, ch = cidx & 7;
                    const int off = row * 128 + ((ch ^ (row & 7)) << 4);
                    *(LAS u32x4*)(Kb + off) = kv[it]; *(LAS u32x4*)(Vb + off) = vv[it];
                }
            }
            if (t2 < 129) biasL[hg * 132 + t2] = F.rel_bias[bucketL[g * 132 + t2] * 48 + g * 16 + head];
        }
        bf16x8 qf[4];
        const size_t qrow = rowbase + (size_t)dil * ((size_t)i * 128 + 32 * w + q);
        {
            const bf16* qp = QKV + qrow * NQKV + g * 1024 + head * 64 + 8 * hh;
#pragma unroll
            for (int ks = 0; ks < 4; ++ks) qf[ks] = *(const GAS bf16x8*)(qp + 16 * ks);
        }
        __syncthreads();
        const int kt_lo = (i == 0 && w < 4) ? 4 : w;
        f32x16 S[5];
#pragma unroll
        for (int t = 0; t < 5; ++t) {
#pragma unroll
            for (int rg = 0; rg < 16; ++rg) S[t][rg] = 0.f;
            const int kt = w + t;
            if (kt >= kt_lo) {
                const int row = 32 * kt + q;
#pragma unroll
                for (int ks = 0; ks < 4; ++ks) {
                    const bf16x8 kf = *(const LAS bf16x8*)(Kb + row * 128 + (((2 * ks + hh) ^ (row & 7)) << 4));
                    S[t] = __builtin_amdgcn_mfma_f32_32x32x16_bf16(kf, qf[ks], S[t], 0, 0, 0);
                }
            }
        }
        float mx = -1e30f;
#pragma unroll
        for (int t = 0; t < 5; ++t) {
            const bool tv = (w + t) >= kt_lo;
#pragma unroll
            for (int rg = 0; rg < 16; ++rg) {
                const int keyl = (rg & 3) + 8 * (rg >> 2) + 4 * hh;
                const int delta = 128 + q - 32 * t - keyl;
                const bool valid = tv && delta >= 0 && delta <= 128;
                const int dc = delta < 0 ? 0 : (delta > 128 ? 128 : delta);
                const float sv = valid ? S[t][rg] + biasL[hg * 132 + dc] : -1e30f;
                S[t][rg] = sv; mx = fmaxf(mx, sv);
            }
        }
        mx = fmaxf(mx, __shfl_xor(mx, 32));
        float lsum = 0.f;
#pragma unroll
        for (int t = 0; t < 5; ++t)
#pragma unroll
            for (int rg = 0; rg < 16; ++rg) { const float p = __expf(S[t][rg] - mx); S[t][rg] = p; lsum += p; }
        lsum += __shfl_xor(lsum, 32);
        f32x16 O[2];
#pragma unroll
        for (int dt = 0; dt < 2; ++dt)
#pragma unroll
            for (int rg = 0; rg < 16; ++rg) O[dt][rg] = 0.f;
        const int g16 = lane >> 4, i16 = lane & 15, qsel = i16 >> 2, psel = i16 & 3;
#pragma unroll
        for (int t = 0; t < 5; ++t) {
            const int kt = w + t;
            if (kt >= kt_lo) {
#pragma unroll
                for (int s2 = 0; s2 < 2; ++s2) {
                    bf16x8 pf;
                    { const unsigned w0 = cvt_pk_bf16(S[t][8 * s2 + 0], S[t][8 * s2 + 1]), w1 = cvt_pk_bf16(S[t][8 * s2 + 2], S[t][8 * s2 + 3]),
                                     w2 = cvt_pk_bf16(S[t][8 * s2 + 4], S[t][8 * s2 + 5]), w3 = cvt_pk_bf16(S[t][8 * s2 + 6], S[t][8 * s2 + 7]);
                      const u32x4 pw = (u32x4){w0, w1, w2, w3}; pf = __builtin_bit_cast(bf16x8, pw); }
#pragma unroll
                    for (int dt = 0; dt < 2; ++dt) {
                        const int krow = 32 * kt + 16 * s2 + 4 * hh + qsel;
                        const int ch = 4 * dt + 2 * (g16 & 1) + (psel >> 1);
                        const s16x4 lo = vtr(Vb + krow * 128 + ((ch ^ (krow & 7)) << 4) + (psel & 1) * 8);
                        const int krow2 = krow + 8;
                        const s16x4 hi = vtr(Vb + krow2 * 128 + ((ch ^ (krow2 & 7)) << 4) + (psel & 1) * 8);
                        const bf16x8 vf = (bf16x8){lo[0], lo[1], lo[2], lo[3], hi[0], hi[1], hi[2], hi[3]};
                        O[dt] = __builtin_amdgcn_mfma_f32_32x32x16_bf16(vf, pf, O[dt], 0, 0, 0);
                    }
                }
            }
        }
        {
            const float inv = 1.f / lsum;
            bf16* op = (bf16*)(F.ws + WS_OG) + ((size_t)g * NTOK + qrow) * 1024 + head * 64;
#pragma unroll
            for (int dt = 0; dt < 2; ++dt)
#pragma unroll
                for (int r4 = 0; r4 < 4; ++r4) {
                    u32x2 wv; wv.x = cvt_pk_bf16(O[dt][4 * r4 + 0] * inv, O[dt][4 * r4 + 1] * inv); wv.y = cvt_pk_bf16(O[dt][4 * r4 + 2] * inv, O[dt][4 * r4 + 3] * inv);
                    *(GAS u32x2*)(op + dt * 32 + 8 * r4 + 4 * hh) = wv;
                }
            if (hh == 0) ((float*)(F.ws + WS_LSE))[((size_t)g * NTOK + qrow) * 16 + head] = mx + __logf(lsum);
        }
        __syncthreads();
    }
}
__device__ __forceinline__ void phase_attn_combine(Frame& F) {
    const int gw = blockIdx.x * NWAVES + F.wave, NGW = F.G * NWAVES, lane = F.lane;
    const float* LSE = (const float*)(F.ws + WS_LSE); const bf16* OG = (const bf16*)(F.ws + WS_OG); bf16* OB = (bf16*)(F.ws + WS_OB);
    for (int tok = gw; tok < NTOK; tok += NGW) {
        const int head = lane >> 2;
        const float l0 = LSE[((size_t)0 * NTOK + tok) * 16 + head], l1 = LSE[((size_t)1 * NTOK + tok) * 16 + head], l2 = LSE[((size_t)2 * NTOK + tok) * 16 + head];
        const float m = fmaxf(l0, fmaxf(l1, l2));
        float a0 = __expf(l0 - m), a1 = __expf(l1 - m), a2 = __expf(l2 - m); const float inv = 1.f / (a0 + a1 + a2); a0 *= inv; a1 *= inv; a2 *= inv;
        const GAS u32x4* p0 = (const GAS u32x4*)(OG + ((size_t)0 * NTOK + tok) * 1024) + 2 * lane;
        const GAS u32x4* p1 = (const GAS u32x4*)(OG + ((size_t)1 * NTOK + tok) * 1024) + 2 * lane;
        const GAS u32x4* p2 = (const GAS u32x4*)(OG + ((size_t)2 * NTOK + tok) * 1024) + 2 * lane;
        GAS u32x4* po = (GAS u32x4*)(OB + (size_t)tok * 1024) + 2 * lane;
#pragma unroll
        for (int c = 0; c < 2; ++c) {
            const u32x4 v0 = p0[c], v1 = p1[c], v2 = p2[c]; u32x4 o;
#pragma unroll
            for (int k = 0; k < 4; ++k) {
                const float lo = a0 * bflo(v0[k]) + a1 * bflo(v1[k]) + a2 * bflo(v2[k]);
                const float hi = a0 * bfhi(v0[k]) + a1 * bfhi(v1[k]) + a2 * bfhi(v2[k]);
                o[k] = pk2(lo, hi);
            }
            po[c] = o;
        }
    }
}

constexpr int NPHASE = 13;
__global__ void __launch_bounds__(NTHREADS, 2) fwd_kernel(Args args) {
    extern __shared__ __attribute__((aligned(16))) unsigned char lds_raw[];
    Frame F;
    F.lds = (LAS unsigned char*)lds_raw;
    F.tid = threadIdx.x; F.lane = F.tid & 63; F.wave = __builtin_amdgcn_readfirstlane(F.tid >> 6); F.G = gridDim.x;
    F.ws = args.ws; F.out = args.out; F.ctl = (gu32*)(args.ws + WS_CTL);
    F.x = args.in[0]; F.norm_mix_g = args.in[1]; F.norm_ffn_g = args.in[2]; F.pool_w = args.in[3]; F.pool_scale = args.in[4]; F.w_qkv = args.in[5];
    F.q_gain = args.in[6]; F.k_gain = args.in[7]; F.w_o = args.in[8]; F.rel_bias = args.in[9]; F.w_router = args.in[10]; F.b_router = args.in[11];
    F.w_gu = args.in[12]; F.b_gu = args.in[13]; F.w_dn = args.in[14]; F.b_dn = args.in[15];
    if (F.tid < 16) ((LAS unsigned*)(F.lds + L_BARST))[F.tid] = 0u;
    __syncthreads();
    if (args.never) cg::this_grid().sync();
#if MK_MULTI
#define GRID_BAR() do { } while (0)
#else
    XcdBarrier bar = xcd_barrier_post((unsigned*)(F.ctl + CW_BAR), (volatile LAS unsigned*)(F.lds + L_BARST));
#define GRID_BAR() xcd_barrier(bar)
#endif
    const int lo = args.ph_lo, hi = args.ph_hi;
#define IN(k) (lo <= (k) && (k) < hi)
#define SEAM(k) do { if (IN(k) && IN((k) + 1)) GRID_BAR(); } while (0)
#define RUN(k, call) do { if (IN(k)) { call; if ((DUP_MASK >> (k)) & 1) { GRID_BAR(); call; } } } while (0)
    RUN(0, phase_convert(F));          SEAM(0);
    RUN(1, phase_pool(F));             SEAM(1);
    RUN(2, phase_moe_gu(F, 0));        SEAM(2);
    RUN(3, phase_moe_dn(F, 0));        SEAM(3);
    RUN(4, phase_combine(F, 0));       SEAM(4);
    RUN(5, phase_qkv(F));              SEAM(5);
    RUN(6, phase_attn(F));             SEAM(6);
    RUN(7, phase_attn_combine(F));     SEAM(7);
    RUN(8, phase_wo(F));               SEAM(8);
    RUN(9, phase_router(F, 1));        SEAM(9);
    RUN(10, phase_moe_gu(F, 1));       SEAM(10);
    RUN(11, phase_moe_dn(F, 1));       SEAM(11);
    RUN(12, phase_combine(F, 1));
#undef RUN
#undef IN
#undef SEAM
}

extern "C" void kernel_launch(void* const* d_in, const int* in_sizes, int n_in, void* d_out, int out_size, void* d_ws, size_t ws_size, hipStream_t stream) {
    static int grid = 0;
    if (grid == 0) {
        if (n_in != 16 || in_sizes[0] != NTOK * DM || out_size != NTOK * DM || ws_size < WS_END) {
            fprintf(stderr, "kernel_launch: unexpected shapes (n_in %d, in0 %d, out %d, ws %zu < %zu); nothing launched\n", n_in, n_in > 0 ? in_sizes[0] : -1, out_size, ws_size, (size_t)WS_END); grid = -1; return; }
        int dev = 0, cus = 0, per_cu = 0;
        if (hipGetDevice(&dev) != hipSuccess || hipDeviceGetAttribute(&cus, hipDeviceAttributeMultiprocessorCount, dev) != hipSuccess) { grid = -1; return; }
        if (hipFuncSetAttribute((const void*)fwd_kernel, hipFuncAttributeMaxDynamicSharedMemorySize, LDS_BYTES) != hipSuccess) { fprintf(stderr, "kernel_launch: hipFuncSetAttribute failed\n"); grid = -1; return; }
        if (hipOccupancyMaxActiveBlocksPerMultiprocessor(&per_cu, (const void*)fwd_kernel, NTHREADS, LDS_BYTES) != hipSuccess || per_cu < 1) { fprintf(stderr, "kernel_launch: occupancy query says %d blocks/CU\n", per_cu); (void)hipGetLastError(); grid = -1; return; }
        grid = cus;
    }
    if (grid < 0) return;
    if (hipMemsetAsync((char*)d_ws + WS_CTL, 0, CTL_BYTES, stream) != hipSuccess) { fprintf(stderr, "kernel_launch: memset failed\n"); return; }
    Args a{};
    for (int i = 0; i < 16; ++i) a.in[i] = (const float*)d_in[i];
    a.out = (float*)d_out; a.ws = (unsigned char*)d_ws; a.never = 0; a.pad = 0;
#if MK_MULTI
    for (int p = 0; p < NPHASE; ++p) { a.ph_lo = p; a.ph_hi = p + 1; hipLaunchKernelGGL(fwd_kernel, dim3(grid), dim3(NTHREADS), LDS_BYTES, stream, a); }
#else
    a.ph_lo = 0; a.ph_hi = NPHASE;
    void* kargs[] = {&a};
    hipError_t e = hipLaunchCooperativeKernel((const void*)fwd_kernel, dim3(grid), dim3(NTHREADS), kargs, LDS_BYTES, stream);
    if (e != hipSuccess) fprintf(stderr, "kernel_launch: cooperative launch failed: %s (grid %d)\n", hipGetErrorString(e), grid);
#endif
}
```

```cpp
#include <hip/hip_runtime.h>
#include <hip/hip_cooperative_groups.h>
#include <cstdio>
#include <cstdint>
namespace cg = cooperative_groups;

#ifndef DUP_MASK
#define DUP_MASK 0
#endif
#ifndef MK_MULTI
#define MK_MULTI 0
#endif

#define LAS __attribute__((address_space(3)))
#define GAS __attribute__((address_space(1)))
typedef unsigned short bf16;
typedef short bf16x8 __attribute__((ext_vector_type(8)));
typedef short s16x4 __attribute__((ext_vector_type(4)));
typedef float f32x2 __attribute__((ext_vector_type(2)));
typedef float f32x4 __attribute__((ext_vector_type(4)));
typedef float f32x16 __attribute__((ext_vector_type(16)));
typedef int v4i __attribute__((ext_vector_type(4)));
typedef int v8i __attribute__((ext_vector_type(8)));
typedef unsigned u32x4 __attribute__((ext_vector_type(4)));
typedef unsigned u32x2 __attribute__((ext_vector_type(2)));
typedef GAS unsigned gu32;

constexpr int NTOK = 16384, DM = 1024, SEQ = 2048, NEXP = 32, TOPK = 4, FF = 1024, NQKV = 9216;
constexpr int CAP = 16384;
constexpr int MAXT = 288;
constexpr int PMAX = MAXT * 256;
constexpr float EPS = 1e-6f;
constexpr int NWAVES = 8, NTHREADS = 512;

constexpr size_t MiB = 1u << 20;
constexpr size_t WS_CTL = 0, CTL_BYTES = 1 * MiB;
constexpr size_t WS_WRT = 1 * MiB;
constexpr size_t WS_WPOOL = WS_WRT + 512 * 1024;
constexpr size_t WS_WO = 2 * MiB;
constexpr size_t WS_SC_GU = 4 * MiB;
constexpr size_t WS_SC_QKV = 4 * MiB + 512 * 1024;
constexpr size_t WS_SC_DN = 5 * MiB;
constexpr size_t WS_HS = 6 * MiB;
constexpr size_t WS_WQKV = 8 * MiB;
constexpr size_t WS_WGU = 18 * MiB;
constexpr size_t WS_WDN = WS_WGU + 128 * MiB;
constexpr size_t WS_ROWSLOT = WS_WDN + 128 * MiB;
constexpr size_t WS_ROWGATE = WS_ROWSLOT + 2 * MiB;
constexpr size_t WS_ROWHS = WS_ROWGATE + 2 * MiB;
constexpr size_t WS_LSE = WS_ROWHS + 2 * MiB;
constexpr size_t WS_H2 = WS_LSE + 3 * MiB;
constexpr size_t WS_BIG = WS_H2 + 16 * MiB;
constexpr size_t WS_ACT = WS_BIG, WS_QKV = WS_BIG;
constexpr size_t WS_Y = WS_BIG + 288 * MiB;
constexpr size_t WS_OG = WS_Y, WS_OB = WS_Y + 96 * MiB;
constexpr size_t WS_END = WS_Y + 128 * MiB;
static_assert(WS_END <= 874 * MiB, "workspace map must fit the guaranteed d_ws size");
constexpr int CW_CNT = 64;
constexpr int CW_BAR = 4096;

constexpr int RING_BYTES = 131072;
constexpr int MISC_OFF = RING_BYTES;
constexpr int L_BARST = MISC_OFF + 0;
constexpr int L_CNT = MISC_OFF + 64;
constexpr int L_PROW0 = MISC_OFF + 192;
constexpr int L_NT = MISC_OFF + 320;
constexpr int L_TILEE = MISC_OFF + 336;
constexpr int L_TILEROW = MISC_OFF + 1488;
constexpr int L_HIST = MISC_OFF + 2640;
constexpr int L_BASE = MISC_OFF + 2768;
constexpr int L_SLOTE = MISC_OFF + 2896;
constexpr int L_SLOTP = MISC_OFF + 3920;
constexpr int L_SLOTG = MISC_OFF + 4944;
constexpr int L_RSTD = MISC_OFF + 5968;
constexpr int L_BIAS = MISC_OFF + 6288;
constexpr int L_BUCKET = MISC_OFF + 7344;
constexpr int L_BTAB = MISC_OFF + 8960;
constexpr int LDS_BYTES = 147456;
static_assert(L_BTAB + 2 * 192 * 4 <= LDS_BYTES, "LDS map");

#define RLX_AGENT __ATOMIC_RELAXED, __HIP_MEMORY_SCOPE_AGENT
#define LDS_WAIT() asm volatile("s_waitcnt lgkmcnt(0)" ::: "memory")
#define VM_WAIT() asm volatile("s_waitcnt vmcnt(0)" ::: "memory")
__device__ __forceinline__ unsigned f2bf(float f) { unsigned u = __builtin_bit_cast(unsigned, f); return (u + 0x7fffu + ((u >> 16) & 1u)) >> 16; }
__device__ __forceinline__ unsigned pk2(float lo, float hi) { return f2bf(lo) | (f2bf(hi) << 16); }
__device__ __forceinline__ float bf2f(unsigned short b) { return __builtin_bit_cast(float, ((unsigned)b) << 16); }
__device__ __forceinline__ float bflo(unsigned w) { return __builtin_bit_cast(float, w << 16); }
__device__ __forceinline__ float bfhi(unsigned w) { return __builtin_bit_cast(float, w & 0xffff0000u); }
__device__ __forceinline__ unsigned cvt_pk_bf16(float lo, float hi) { unsigned r; asm volatile("v_cvt_pk_bf16_f32 %0, %1, %2" : "=v"(r) : "v"(lo), "v"(hi)); return r; }
__device__ __forceinline__ float wave_sum(float v) {
#pragma unroll
    for (int o = 1; o < 64; o <<= 1) v += __shfl_xor(v, o);
    return v;
}

#define XB_TMO      128
#define XB_XCNT(j)  (256  + 64 * (j))
#define XB_XSUB(j)  (1280 + 64 * (j))
#define XB_XGEN(j)  (2304 + 64 * (j))
#define XB_TOP      3328
#define XB_TOPGEN   3392
#define XCD_BAR_WORDS 3456
#define XB_SPIN_CAP (1u << 20)
__device__ __forceinline__ unsigned xb_ld(unsigned* p)              { return __hip_atomic_load(p, __ATOMIC_RELAXED, __HIP_MEMORY_SCOPE_AGENT); }
__device__ __forceinline__ unsigned xb_add(unsigned* p, unsigned v) { return __hip_atomic_fetch_add(p, v, __ATOMIC_RELAXED, __HIP_MEMORY_SCOPE_AGENT); }
__device__ __forceinline__ unsigned xb_xcc_id() { return (unsigned)__builtin_amdgcn_s_getreg((3 << 11) | 20) & 0xFu; }
#define XB_SPIN(cond, bar) do { unsigned _sp = 0; while (cond) { __builtin_amdgcn_s_sleep(1); \
    if ((++_sp & 255u) == 0u) { if (xb_ld(&(bar)[XB_TMO])) break; if (_sp > XB_SPIN_CAP) { atomicAdd(&(bar)[XB_TMO], 1u); break; } } } } while (0)
struct XcdBarrier { unsigned* bar; unsigned x; volatile LAS unsigned* st; };
__device__ __forceinline__ XcdBarrier xcd_barrier_post(unsigned* bar, volatile LAS unsigned* st) {
    XcdBarrier b; b.bar = bar; b.x = xb_xcc_id(); b.st = st;
    if (threadIdx.x == 0) (void)xb_add(&bar[XB_XCNT(b.x)], 1u);
    return b;
}
__device__ __forceinline__ void xcd_barrier_complete(unsigned* bar, unsigned x, unsigned& nloc, unsigned& nx) {
    const unsigned G = gridDim.x * gridDim.y * gridDim.z;
    unsigned sum, cnt, mine, sp = 0u;
    for (;;) {
        sum = 0u; cnt = 0u; mine = 0u;
#pragma unroll
        for (unsigned j = 0; j < 16; ++j) { const unsigned c = xb_ld(&bar[XB_XCNT(j)]); sum += c; cnt += (c > 0u) ? 1u : 0u; mine = (j == x) ? c : mine; }
        if (sum == G) break;
        __builtin_amdgcn_s_sleep(1);
        if ((++sp & 255u) == 0u) { if (xb_ld(&bar[XB_TMO])) break; if (sp > XB_SPIN_CAP) { atomicAdd(&bar[XB_TMO], 1u); break; } }
    }
    nloc = mine > 0u ? mine : 1u; nx = cnt > 0u ? cnt : 1u;
}
__device__ __forceinline__ void xcd_barrier(const XcdBarrier& b) {
    asm volatile("s_waitcnt vmcnt(0)" ::: "memory");
    __syncthreads();
    if (threadIdx.x == 0) {
        unsigned* bar = b.bar;
        __builtin_amdgcn_s_waitcnt(0);
        unsigned nloc = b.st[0], nx = b.st[1];
        if (nloc == 0u) { xcd_barrier_complete(bar, b.x, nloc, nx); b.st[0] = nloc; b.st[1] = nx; }
        const unsigned old = xb_add(&bar[XB_XSUB(b.x)], 1u);
        const unsigned gen = old / nloc;
        if (old + 1u == (gen + 1u) * nloc) {
            __builtin_amdgcn_fence(__ATOMIC_RELEASE, "agent");
            asm volatile("s_waitcnt vmcnt(0)" ::: "memory");
            const unsigned og = xb_add(&bar[XB_TOP], 1u);
            const unsigned tg = og / nx;
            if (og + 1u == (tg + 1u) * nx) xb_add(&bar[XB_TOPGEN], 1u);
            else XB_SPIN(xb_ld(&bar[XB_TOPGEN]) == tg, bar);
            __builtin_amdgcn_fence(__ATOMIC_ACQUIRE, "agent");
            xb_add(&bar[XB_XGEN(b.x)], 1u);
            asm volatile("s_waitcnt vmcnt(0)" ::: "memory");
        } else {
            XB_SPIN(xb_ld(&bar[XB_XGEN(b.x)]) == gen, bar);
            __builtin_amdgcn_fence(__ATOMIC_ACQUIRE, "agent");
            asm volatile("s_waitcnt vmcnt(0)" ::: "memory");
        }
    }
    __syncthreads();
}

namespace pg8 {
constexpr int BM = 256, BK = 64, HALF = 128, HTB = HALF * BK * 2, STAGE_BYTES = 8 * HTB, NXCD = 8, WGM = 8, KD = 1024;
__host__ __device__ __forceinline__ int lds_byte(int r, int c) { const int st = (r >> 4) * 2 + (c >> 5), rr = r & 15, cc = c & 31, ob = rr * 64 + cc * 2; return st * 1024 + (ob ^ (((ob >> 9) & 1) << 5)); }
__host__ __device__ __forceinline__ void stage_rc(int b, int& R, int& C) { const int st = b / 1024, sb = b % 1024, swz = sb ^ (((sb >> 9) & 1) << 5); R = (st >> 1) * 16 + swz / 64; C = (st & 1) * 32 + (swz % 64) / 2; }
__host__ __device__ __forceinline__ int perm32(int rho) { const int n = rho >> 4, i = rho & 15; return 8 * (i >> 2) + 4 * n + (i & 3); }

struct Unit { const char* a; const char* b; int i0, i1, i2, i3; };
template <int M> struct Frag { bf16x8 v[2]; };
template <> struct Frag<2> { v8i w; };

__device__ __forceinline__ bool tile_order(int i, int G, int c, int nM, int nN, int& pm, int& pn) {
    const int nwg = nM * nN; const long L = (long)i * G + c; if (L >= nwg) return false;
    int wgid = (int)L; { const int q = nwg / NXCD, r = nwg % NXCD, xcd = wgid % NXCD, off = wgid / NXCD; wgid = (xcd < r ? xcd * (q + 1) : r * (q + 1) + (xcd - r) * q) + off; }
    const int nig = WGM * nN, gid = wgid / nig, fm = gid * WGM, gsz = (nM - fm) < WGM ? (nM - fm) : WGM;
    pm = fm + ((wgid % nig) % gsz); pn = (wgid % nig) / gsz; return true;
}

template <class Epi, class Sched, bool ALIGN_EPI, bool SP2>
__device__ __forceinline__ void gemm_phase(LAS unsigned char* lds, const size_t hstepB, const Sched& S, const Epi& E) {
    typedef typename Epi::ACC ACC; constexpr int MODE = Epi::MODE;
    const int tid = threadIdx.x, wid = __builtin_amdgcn_readfirstlane(tid >> 6), lane = tid & 63, wr = wid >> 2, wc = wid & 3, fr = lane & 15, fq = lane >> 4;
    constexpr int ROWB = (MODE == 0) ? KD * 2 : KD;
    constexpr int nt = ROWB / 128;
    constexpr bool GATHER = Sched::GATHER;
    unsigned voffA[2], voffB[2]; int Rst[2], Cst[2];
#pragma unroll
    for (int i = 0; i < 2; ++i) { int R, C; stage_rc(tid * 16 + i * 8192, R, C); const int Rb = Epi::brow(R); Rst[i] = R; Cst[i] = C;
        voffA[i] = (unsigned)(R * ROWB + C * 2); voffB[i] = (unsigned)(Rb * ROWB + C * 2); }
    unsigned gc[4] = {0u, 0u, 0u, 0u}, gn[4] = {0u, 0u, 0u, 0u};
    const size_t kstep = (size_t)(BK * 2);
    const size_t hstepA = (size_t)HALF * ROWB;
    const unsigned ldsw = (unsigned)wid * 1024u;
    const int aoff = lds_byte(wr * 64 + fr, fq * 8), boff = lds_byte(wc * 32 + fr, fq * 8);
#define PG8_SA(b, h) (((b) * 2 + (h)) * HTB)
#define PG8_SB(b, h) ((4 + (b) * 2 + (h)) * HTB)
#define PG8_STAGE(bufoff, gbase, voff) do { _Pragma("unroll") for (int _i = 0; _i < 2; ++_i) \
        __builtin_amdgcn_global_load_lds((const unsigned*)((const char*)(gbase) + (voff)[_i]), (LAS unsigned*)(lds + (bufoff) + ldsw + _i * 8192), 16, 0, 0); } while (0)
#define PG8_STAGE4(bufoff, gbase, o0, o1) do { \
        __builtin_amdgcn_global_load_lds((const unsigned*)((const char*)(gbase) + (o0)), (LAS unsigned*)(lds + (bufoff) + ldsw), 16, 0, 0); \
        __builtin_amdgcn_global_load_lds((const unsigned*)((const char*)(gbase) + (o1)), (LAS unsigned*)(lds + (bufoff) + ldsw + 8192), 16, 0, 0); } while (0)
#define PG8_STAGEA(bufoff, p, h, g) do { if constexpr (GATHER) PG8_STAGE4(bufoff, p, (g)[2 * (h)], (g)[2 * (h) + 1]); else PG8_STAGE4(bufoff, (p) + (h) * hstepA, voffA[0], voffA[1]); } while (0)
#define PG8_LDA(dst, b, h) do { _Pragma("unroll") for (int m = 0; m < 4; ++m) { if constexpr (MODE == 2) { dst[m].w.lo = *(const LAS v4i*)(lds + PG8_SA(b, h) + aoff + m * 2048); dst[m].w.hi = *(const LAS v4i*)(lds + PG8_SA(b, h) + aoff + m * 2048 + 1024); } \
        else { dst[m].v[0] = *(const LAS bf16x8*)(lds + PG8_SA(b, h) + aoff + m * 2048); dst[m].v[1] = *(const LAS bf16x8*)(lds + PG8_SA(b, h) + aoff + m * 2048 + 1024); } } } while (0)
#define PG8_LDB(dst, b, h) do { _Pragma("unroll") for (int n = 0; n < 2; ++n) { if constexpr (MODE == 2) { dst[n].w.lo = *(const LAS v4i*)(lds + PG8_SB(b, h) + boff + n * 2048); dst[n].w.hi = *(const LAS v4i*)(lds + PG8_SB(b, h) + boff + n * 2048 + 1024); } \
        else { dst[n].v[0] = *(const LAS bf16x8*)(lds + PG8_SB(b, h) + boff + n * 2048); dst[n].v[1] = *(const LAS bf16x8*)(lds + PG8_SB(b, h) + boff + n * 2048 + 1024); } } } while (0)
#define PG8_MMA(ai, bj, At, Bt) do { __builtin_amdgcn_s_setprio(1); _Pragma("unroll") for (int m = 0; m < 4; ++m) _Pragma("unroll") for (int n = 0; n < 2; ++n) { \
        if constexpr (MODE == 0) { _Pragma("unroll") for (int k = 0; k < 2; ++k) acc[ai][bj][m][n] = __builtin_amdgcn_mfma_f32_16x16x32_bf16(Bt[n].v[k], At[m].v[k], acc[ai][bj][m][n], 0, 0, 0); } \
        else if constexpr (MODE == 1) { _Pragma("unroll") for (int k = 0; k < 2; ++k) acc[ai][bj][m][n] = __builtin_amdgcn_mfma_i32_16x16x64_i8(__builtin_bit_cast(v4i, Bt[n].v[k]), __builtin_bit_cast(v4i, At[m].v[k]), acc[ai][bj][m][n], 0, 0, 0); } \
        else { acc[ai][bj][m][n] = __builtin_amdgcn_mfma_scale_f32_16x16x128_f8f6f4(Bt[n].w, At[m].w, acc[ai][bj][m][n], 0, 0, 0, 0x7f7f7f7f, 0, 0x7f7f7f7f); } \
        } __builtin_amdgcn_s_setprio(0); } while (0)
#define PG8_WAIT_V(n) asm volatile("s_waitcnt vmcnt(" #n ")" ::: "memory")
#define PG8_WAIT_L(n) asm volatile("s_waitcnt lgkmcnt(" #n ")" ::: "memory")
#define PG8_BAR __builtin_amdgcn_s_barrier()
#define PG8_SCHED __builtin_amdgcn_sched_barrier(0)
    Unit cur, nxt, nn; int ui = 0;
    if (!S.next(0, cur)) return;
    bool has_next = S.next(1, nxt);
    if constexpr (GATHER) {
#pragma unroll
        for (int h = 0; h < 2; ++h)
#pragma unroll
            for (int i = 0; i < 2; ++i) { gc[2 * h + i] = (unsigned)S.row_src(cur, h * HALF + Rst[i]) * (unsigned)ROWB + (unsigned)(Cst[i] * 2);
                                          gn[2 * h + i] = has_next ? (unsigned)S.row_src(nxt, h * HALF + Rst[i]) * (unsigned)ROWB + (unsigned)(Cst[i] * 2) : 0u; }
    }
    ACC acc[2][2][4][2];
#pragma unroll
    for (int a = 0; a < 2; ++a)
#pragma unroll
        for (int b = 0; b < 2; ++b)
#pragma unroll
            for (int m = 0; m < 4; ++m)
#pragma unroll
                for (int n = 0; n < 2; ++n) acc[a][b][m][n] = (ACC){0, 0, 0, 0};
    Frag<MODE> At[4], B0[2], B1[2];
    const char* cA = cur.a; const char* cB = cur.b;
    if constexpr (SP2) {
        PG8_STAGE(PG8_SB(0, 0), cB, voffB); PG8_STAGE(PG8_SB(0, 1), cB + hstepB, voffB); PG8_STAGEA(PG8_SA(0, 0), cA, 0, gc); PG8_STAGEA(PG8_SA(0, 1), cA, 1, gc);
        if (wr == 1) PG8_BAR;
        PG8_WAIT_V(2); PG8_BAR;
        PG8_STAGE(PG8_SB(1, 0), cB + kstep, voffB); PG8_STAGEA(PG8_SA(1, 0), cA + kstep, 0, gc); PG8_STAGE(PG8_SB(1, 1), cB + hstepB + kstep, voffB);
        PG8_WAIT_V(6); PG8_BAR;
    } else {
        PG8_STAGE(PG8_SB(0, 0), cB, voffB); PG8_STAGEA(PG8_SA(0, 0), cA, 0, gc); PG8_STAGE(PG8_SB(0, 1), cB + hstepB, voffB); PG8_STAGEA(PG8_SA(0, 1), cA, 1, gc);
        if (wr == 1) PG8_BAR;
        PG8_WAIT_V(4); PG8_BAR;
        PG8_STAGE(PG8_SB(1, 0), cB + kstep, voffB); PG8_STAGEA(PG8_SA(1, 0), cA + kstep, 0, gc); PG8_STAGE(PG8_SB(1, 1), cB + hstepB + kstep, voffB);
        PG8_WAIT_V(6); PG8_BAR;
    }
    for (;;) {
        const char* nA = has_next ? nxt.a : cA; const char* nB = has_next ? nxt.b : cB;
        for (int t = 0; t < nt; t += 2) {
            const bool last = (t == nt - 2);
            const char* a1 = cA + (size_t)(t + 1) * kstep;
            const char* a2 = last ? nA : cA + (size_t)(t + 2) * kstep; const char* b2 = last ? nB : cB + (size_t)(t + 2) * kstep;
            const char* a3 = a2 + kstep; const char* b3 = b2 + kstep;
            unsigned g2[4];
#pragma unroll
            for (int i = 0; i < 4; ++i) g2[i] = (last && has_next) ? gn[i] : gc[i];
            if constexpr (SP2) {
            PG8_LDB(B0, 0, 0); PG8_LDB(B1, 0, 1); PG8_SCHED; PG8_LDA(At, 0, 0); PG8_STAGEA(PG8_SA(1, 1), a1, 1, gc);
            PG8_WAIT_V(8); PG8_WAIT_L(0); PG8_BAR; PG8_MMA(0, 0, At, B0); PG8_MMA(0, 1, At, B1); PG8_BAR; PG8_SCHED;
            PG8_LDA(At, 0, 1); PG8_STAGE(PG8_SB(0, 0), b2, voffB); PG8_STAGE(PG8_SB(0, 1), b2 + hstepB, voffB); PG8_STAGEA(PG8_SA(0, 0), a2, 0, g2);
            PG8_WAIT_V(8); PG8_WAIT_L(0); PG8_BAR; PG8_MMA(1, 0, At, B0); PG8_MMA(1, 1, At, B1); PG8_BAR; PG8_SCHED;
            PG8_LDB(B0, 1, 0); PG8_LDB(B1, 1, 1); PG8_SCHED; PG8_LDA(At, 1, 0); PG8_STAGEA(PG8_SA(0, 1), a2, 1, g2);
            PG8_WAIT_V(8); PG8_WAIT_L(0); PG8_BAR; PG8_MMA(0, 0, At, B0); PG8_MMA(0, 1, At, B1); PG8_BAR; PG8_SCHED;
            PG8_LDA(At, 1, 1); PG8_STAGE(PG8_SB(1, 0), b3, voffB); PG8_STAGE(PG8_SB(1, 1), b3 + hstepB, voffB); PG8_STAGEA(PG8_SA(1, 0), a3, 0, g2);
            PG8_WAIT_V(8); PG8_WAIT_L(0); PG8_BAR; PG8_MMA(1, 0, At, B0); PG8_MMA(1, 1, At, B1); PG8_BAR; PG8_SCHED;
            } else {
            PG8_LDB(B0, 0, 0); PG8_SCHED; PG8_LDA(At, 0, 0); PG8_STAGEA(PG8_SA(1, 1), a1, 1, gc);
            PG8_WAIT_L(8); PG8_BAR; PG8_WAIT_L(0); PG8_MMA(0, 0, At, B0); PG8_BAR; PG8_SCHED;
            PG8_LDB(B1, 0, 1); PG8_STAGE(PG8_SB(0, 0), b2, voffB);
            PG8_BAR; PG8_WAIT_L(0); PG8_MMA(0, 1, At, B1); PG8_BAR;
            PG8_LDA(At, 0, 1); PG8_STAGEA(PG8_SA(0, 0), a2, 0, g2);
            PG8_BAR; PG8_WAIT_L(0); PG8_MMA(1, 0, At, B0); PG8_BAR; PG8_SCHED;
            PG8_STAGE(PG8_SB(0, 1), b2 + hstepB, voffB);
            PG8_WAIT_V(6); PG8_BAR; PG8_MMA(1, 1, At, B1); PG8_BAR;
            PG8_LDB(B0, 1, 0); PG8_SCHED; PG8_LDA(At, 1, 0); PG8_STAGEA(PG8_SA(0, 1), a2, 1, g2);
            PG8_WAIT_L(8); PG8_BAR; PG8_WAIT_L(0); PG8_MMA(0, 0, At, B0); PG8_BAR; PG8_SCHED;
            PG8_LDB(B1, 1, 1); PG8_STAGE(PG8_SB(1, 0), b3, voffB);
            PG8_BAR; PG8_WAIT_L(0); PG8_MMA(0, 1, At, B1); PG8_BAR;
            PG8_LDA(At, 1, 1); PG8_STAGEA(PG8_SA(1, 0), a3, 0, g2);
            PG8_BAR; PG8_WAIT_L(0); PG8_MMA(1, 0, At, B0); PG8_BAR; PG8_SCHED;
            PG8_STAGE(PG8_SB(1, 1), b3 + hstepB, voffB);
            PG8_WAIT_V(6); PG8_BAR; PG8_MMA(1, 1, At, B1); PG8_BAR;
            }
        }
        if constexpr (ALIGN_EPI) { if (wr == 0) PG8_BAR; }
        const bool has_nn = has_next && S.next(ui + 2, nn);
        unsigned g3[4] = {0u, 0u, 0u, 0u};
        if constexpr (GATHER) { if (has_nn) {
#pragma unroll
            for (int h = 0; h < 2; ++h)
#pragma unroll
                for (int i = 0; i < 2; ++i) g3[2 * h + i] = (unsigned)S.row_src(nn, h * HALF + Rst[i]) * (unsigned)ROWB + (unsigned)(Cst[i] * 2); } }
        E(acc, cur, wr, wc, fr, fq);
        if constexpr (GATHER) asm volatile("" : "+v"(g3[0]), "+v"(g3[1]), "+v"(g3[2]), "+v"(g3[3]));
        if (!has_next) break;
#pragma unroll
        for (int a = 0; a < 2; ++a)
#pragma unroll
            for (int b = 0; b < 2; ++b)
#pragma unroll
                for (int m = 0; m < 4; ++m)
#pragma unroll
                    for (int n = 0; n < 2; ++n) acc[a][b][m][n] = (ACC){0, 0, 0, 0};
#pragma unroll
        for (int i = 0; i < 4; ++i) { gc[i] = gn[i]; gn[i] = g3[i]; }
        cur = nxt; cA = nA; cB = nB; ++ui; nxt = nn; has_next = has_nn;
        if constexpr (ALIGN_EPI) { if (wr == 1) PG8_BAR; }
    }
    PG8_WAIT_V(0);
    if constexpr (!ALIGN_EPI) { if (wr == 0) PG8_BAR; }
    PG8_BAR;
#undef PG8_SA
#undef PG8_SB
#undef PG8_STAGE
#undef PG8_STAGE4
#undef PG8_STAGEA
#undef PG8_LDA
#undef PG8_LDB
#undef PG8_MMA
#undef PG8_WAIT_V
#undef PG8_WAIT_L
#undef PG8_BAR
#undef PG8_SCHED
}
}

struct Args { const float* in[16]; float* out; unsigned char* ws; int ph_lo, ph_hi; int never, pad; };
struct Frame {
    LAS unsigned char* lds;
    gu32* ctl;
    int tid, lane, wave, G;
    const float *x, *norm_mix_g, *norm_ffn_g, *pool_w, *pool_scale, *w_qkv, *q_gain, *k_gain, *w_o, *rel_bias, *w_router, *b_router, *w_gu, *b_gu, *w_dn, *b_dn;
    float* out; unsigned char* ws;
};

__device__ __forceinline__ void transpose_item(const float* W, int K, int N, bf16* WT, LAS float* scr, int item, int lane) {
    const int nblk = N / 32, kb = item / nblk, nb = item % nblk, k0 = 64 * kb, n0 = 32 * nb;
#pragma unroll 8
    for (int i = 0; i < 32; ++i) { const int kk = 2 * i + (lane >> 5); scr[kk * 33 + (lane & 31)] = W[(size_t)(k0 + kk) * N + n0 + (lane & 31)]; }
    LDS_WAIT(); asm volatile("" ::: "memory");
    const int c = lane & 7;
#pragma unroll
    for (int j = 0; j < 4; ++j) { const int n = (lane >> 3) + 8 * j; const LAS float* s = scr + (8 * c) * 33 + n;
        u32x4 o; o.x = pk2(s[0 * 33], s[1 * 33]); o.y = pk2(s[2 * 33], s[3 * 33]); o.z = pk2(s[4 * 33], s[5 * 33]); o.w = pk2(s[6 * 33], s[7 * 33]);
        *(GAS u32x4*)(WT + (size_t)(n0 + n) * K + k0 + 8 * c) = o; }
    LDS_WAIT(); asm volatile("" ::: "memory");
}
__device__ __forceinline__ int slab_pos(int k, int n) { return k * 32 + ((n + (k >> 4) + (k & 3)) & 31); }
__device__ __forceinline__ void slab_load(const float* W, int N, int n0, int tid, f32x4 (&v)[16]) {
#pragma unroll
    for (int j = 0; j < 16; ++j) { const int i = tid + j * NTHREADS, k = i >> 3, c4 = i & 7; v[j] = __builtin_nontemporal_load((const GAS f32x4*)(W + (size_t)k * N + n0 + c4 * 4)); }
}
template <int FMT>
__device__ __forceinline__ void slab_store_lds(Frame& F, const f32x4 (&v)[16]) {
    LAS float* S = (LAS float*)F.lds;
#pragma unroll
    for (int j = 0; j < 16; ++j) { const int i = F.tid + j * NTHREADS, k = i >> 3, c4 = i & 7;
        S[slab_pos(k, c4 * 4 + 0)] = v[j].x; S[slab_pos(k, c4 * 4 + 1)] = v[j].y; S[slab_pos(k, c4 * 4 + 2)] = v[j].z; S[slab_pos(k, c4 * 4 + 3)] = v[j].w; }
}
template <int FMT>
__device__ __forceinline__ void slab_process(Frame& F, int n0, unsigned char* Q, float* SC) {
    LAS float* S = (LAS float*)F.lds;
    LAS float* red = (LAS float*)(F.lds + L_SLOTE);
    LAS float* scl = (LAS float*)(F.lds + L_HIST);
    const int tid = F.tid;
    { const int n = tid & 31, part = tid >> 5; float am = 0.f;
#pragma unroll 8
      for (int kk = 0; kk < 64; ++kk) am = fmaxf(am, fabsf(S[slab_pos(part * 64 + kk, n)]));
      am = fmaxf(am, __shfl_xor(am, 32));
      if (F.lane < 32) red[F.wave * 32 + n] = am; }
    __syncthreads();
    if (tid < 32) { float am = 0.f;
#pragma unroll
        for (int w = 0; w < 8; ++w) am = fmaxf(am, red[w * 32 + tid]);
        float qs, inv;
        if (FMT == 1) { qs = am > 0.f ? 127.f / am : 0.f; inv = am * (1.f / 127.f); }
        else { int ex = 0; (void)frexpf(am > 0.f ? am : 1.f, &ex); qs = ldexpf(1.f, 7 - ex); inv = ldexpf(1.f, ex - 7); }
        scl[tid] = qs; SC[n0 + tid] = inv; }
    __syncthreads();
#pragma unroll
    for (int it = 0; it < 4; ++it) {
        const int n = (tid >> 6) + 8 * it, c = tid & 63; const float qs = scl[n];
        float v[16];
#pragma unroll
        for (int i = 0; i < 16; ++i) v[i] = S[slab_pos(16 * c + i, n)] * qs;
        u32x4 o;
        if (FMT == 1) {
#pragma unroll
            for (int d = 0; d < 4; ++d) { const int q0 = (int)rintf(v[4 * d]), q1 = (int)rintf(v[4 * d + 1]), q2 = (int)rintf(v[4 * d + 2]), q3 = (int)rintf(v[4 * d + 3]);
                o[d] = (unsigned)(q0 & 255) | ((unsigned)(q1 & 255) << 8) | ((unsigned)(q2 & 255) << 16) | ((unsigned)q3 << 24); }
        } else {
#pragma unroll
            for (int d = 0; d < 4; ++d) { int w = __builtin_amdgcn_cvt_pk_fp8_f32(v[4 * d], v[4 * d + 1], 0, false); w = __builtin_amdgcn_cvt_pk_fp8_f32(v[4 * d + 2], v[4 * d + 3], w, true); o[d] = (unsigned)w; }
        }
        *(GAS u32x4*)(Q + (size_t)(n0 + n) * 1024 + 16 * c) = o;
    }
    __syncthreads();
}
struct SlabDesc { const float* W; int N, n0; unsigned char* Q; float* SC; };
__device__ __forceinline__ SlabDesc slab_desc(Frame& F, int sl) {
    constexpr int S_GU = 64 * 64;
    SlabDesc d;
    if (sl < S_GU) { const int mat = sl >> 6; d.W = F.w_gu + (size_t)mat * 1024 * 2048; d.N = 2048; d.n0 = (sl & 63) * 32; d.Q = F.ws + WS_WGU + (size_t)mat * 2048 * 1024; d.SC = (float*)(F.ws + WS_SC_GU) + mat * 2048; }
    else { d.W = F.w_qkv; d.N = NQKV; d.n0 = (sl - S_GU) * 32; d.Q = F.ws + WS_WQKV; d.SC = (float*)(F.ws + WS_SC_QKV); }
    return d;
}
__device__ __forceinline__ void phase_convert(Frame& F) {
    constexpr int NSLAB = 64 * 64 + 288;
    {
        f32x4 v[16];
        int sl = blockIdx.x;
        if (sl < NSLAB) { const SlabDesc d = slab_desc(F, sl); slab_load(d.W, d.N, d.n0, F.tid, v); }
        for (; sl < NSLAB; sl += F.G) {
            const SlabDesc d = slab_desc(F, sl);
            slab_store_lds<1>(F, v);
            __syncthreads();
            if (sl + F.G < NSLAB) { const SlabDesc dn = slab_desc(F, sl + F.G); slab_load(dn.W, dn.N, dn.n0, F.tid, v); }
            slab_process<1>(F, d.n0, d.Q, d.SC);
        }
    }
    LAS float* scr = (LAS float*)(F.lds + F.wave * 16384);
    const int gw = blockIdx.x * NWAVES + F.wave, NGW = F.G * NWAVES;
    constexpr int I_DN = 64 * 512, I_WO = 512, I_POOL = 4 * 32;
    constexpr int NITEMS = I_DN + I_WO + I_POOL;
    for (int it = gw; it < NITEMS; it += NGW) {
        int r = it;
        if (r < I_DN) { const int mat = r >> 9; transpose_item(F.w_dn + (size_t)mat * 1024 * 1024, 1024, 1024, (bf16*)(F.ws + WS_WDN) + (size_t)mat * 1024 * 1024, scr, r & 511, F.lane); continue; } r -= I_DN;
        if (r < I_WO) { transpose_item(F.w_o, 1024, 1024, (bf16*)(F.ws + WS_WO), scr, r, F.lane); continue; } r -= I_WO;
        { const int mat = r >> 5; transpose_item(F.pool_w + (size_t)mat * 65536, 256, 256, (bf16*)(F.ws + WS_WPOOL) + (size_t)mat * 65536, scr, r & 31, F.lane); }
    }
    float* wrt = (float*)(F.ws + WS_WRT);
    for (int i = blockIdx.x * NTHREADS + F.tid; i < 2 * 32 * 1024; i += F.G * NTHREADS) wrt[i] = F.w_router[i] * F.norm_ffn_g[i >> 5];
}

__device__ __forceinline__ void quant_row_i8(const f32x4 (&h)[4], unsigned (&w)[4], float& inv) {
    float am = 0.f;
#pragma unroll
    for (int j = 0; j < 4; ++j) am = fmaxf(fmaxf(am, fmaxf(fabsf(h[j].x), fabsf(h[j].y))), fmaxf(fabsf(h[j].z), fabsf(h[j].w)));
#pragma unroll
    for (int o = 1; o < 64; o <<= 1) am = fmaxf(am, __shfl_xor(am, o));
    const float qs = am > 0.f ? 127.f / am : 0.f; inv = am * (1.f / 127.f);
#pragma unroll
    for (int j = 0; j < 4; ++j) { const int q0 = (int)rintf(h[j].x * qs), q1 = (int)rintf(h[j].y * qs), q2 = (int)rintf(h[j].z * qs), q3 = (int)rintf(h[j].w * qs);
        w[j] = (unsigned)(q0 & 255) | ((unsigned)(q1 & 255) << 8) | ((unsigned)(q2 & 255) << 16) | ((unsigned)q3 << 24); }
}

__device__ __forceinline__ void router_tile(Frame& F, int layer, int tok0, bool dry) {
    LAS int* hist = (LAS int*)(F.lds + L_HIST); LAS int* base = (LAS int*)(F.lds + L_BASE);
    LAS int* slot_e = (LAS int*)(F.lds + L_SLOTE); LAS int* slot_p = (LAS int*)(F.lds + L_SLOTP); LAS float* slot_g = (LAS float*)(F.lds + L_SLOTG);
    LAS float* rstdL = (LAS float*)(F.lds + L_RSTD);
    LAS float* part = (LAS float*)F.lds;
    const int lane = F.lane, wave = F.wave;
    if (F.tid < 32) hist[F.tid] = 0;
    const float* g2 = F.norm_ffn_g + layer * 1024;
    unsigned char* H2 = F.ws + WS_H2; float* HS = (float*)(F.ws + WS_HS);
    {
        f32x4 gv[4];
#pragma unroll
        for (int j = 0; j < 4; ++j) gv[j] = *(const f32x4*)(g2 + lane * 4 + 256 * j);
#pragma unroll 1
        for (int half = 0; half < 2; ++half) {
            f32x4 h[4][4];
#pragma unroll
            for (int r = 0; r < 4; ++r) { const GAS f32x4* xr = (const GAS f32x4*)(F.out + (size_t)(tok0 + wave * 8 + half * 4 + r) * 1024) + lane;
#pragma unroll
                for (int j = 0; j < 4; ++j) h[r][j] = xr[64 * j]; }
#pragma unroll
            for (int r = 0; r < 4; ++r) {
                const int row = wave * 8 + half * 4 + r, tok = tok0 + row;
                float ss = 0.f;
#pragma unroll
                for (int j = 0; j < 4; ++j) ss += (h[r][j].x * h[r][j].x + h[r][j].y * h[r][j].y) + (h[r][j].z * h[r][j].z + h[r][j].w * h[r][j].w);
                const float rstd = rsqrtf(wave_sum(ss) * (1.f / 1024.f) + EPS);
#pragma unroll
                for (int j = 0; j < 4; ++j) h[r][j] = h[r][j] * rstd * gv[j];
                unsigned qw[4]; float inv; quant_row_i8(h[r], qw, inv);
                GAS unsigned* o4 = (GAS unsigned*)(H2 + (size_t)tok * 1024) + lane;
#pragma unroll
                for (int j = 0; j < 4; ++j) o4[64 * j] = qw[j];
                if (lane == 0) { HS[tok] = inv; rstdL[row] = rstd; }
            }
        }
    }
    {
        const float* wrg = (const float*)(F.ws + WS_WRT) + (size_t)layer * 32 * 1024;
        const int r = lane & 31, kh = lane >> 5;
        const GAS f32x4* xa0 = (const GAS f32x4*)(F.out + (size_t)(tok0 + r) * 1024 + 128 * wave);
        const GAS f32x4* xa1 = (const GAS f32x4*)(F.out + (size_t)(tok0 + 32 + r) * 1024 + 128 * wave);
        const GAS float* wb = (const GAS float*)(wrg + (size_t)(128 * wave + kh) * 32 + r);
        f32x16 acc0, acc1;
#pragma unroll
        for (int i = 0; i < 16; ++i) { acc0[i] = 0.f; acc1[i] = 0.f; }
#pragma unroll 8
        for (int s4 = 0; s4 < 32; ++s4) {
            const f32x4 a0 = xa0[s4], a1 = xa1[s4];
            const float b0 = wb[(2 * s4) * 64], b1 = wb[(2 * s4 + 1) * 64];
            acc0 = __builtin_amdgcn_mfma_f32_32x32x2f32(kh ? a0.y : a0.x, b0, acc0, 0, 0, 0);
            acc1 = __builtin_amdgcn_mfma_f32_32x32x2f32(kh ? a1.y : a1.x, b0, acc1, 0, 0, 0);
            acc0 = __builtin_amdgcn_mfma_f32_32x32x2f32(kh ? a0.w : a0.z, b1, acc0, 0, 0, 0);
            acc1 = __builtin_amdgcn_mfma_f32_32x32x2f32(kh ? a1.w : a1.z, b1, acc1, 0, 0, 0);
        }
#pragma unroll
        for (int rg = 0; rg < 16; ++rg) { const int row = (rg & 3) + 8 * (rg >> 2) + 4 * kh;
            part[(wave * 64 + row) * 32 + r] = acc0[rg]; part[(wave * 64 + 32 + row) * 32 + r] = acc1[rg]; }
    }
    __syncthreads();
    {
        const int e = lane & 31, kh = lane >> 5;
        const float brl = F.b_router[layer * 32 + e];
#pragma unroll 1
        for (int rr = 0; rr < 4; ++rr) {
            const int row = wave * 8 + rr + 4 * kh;
            float v = 0.f;
#pragma unroll
            for (int w = 0; w < 8; ++w) v += part[(w * 64 + row) * 32 + e];
            v = v * rstdL[row] + brl;
            float tv[4]; int ti[4];
#pragma unroll
            for (int k = 0; k < 4; ++k) {
                float bv = v; int bi = e;
#pragma unroll
                for (int off = 16; off >= 1; off >>= 1) { const float ov = __shfl_xor(bv, off); const int oi = __shfl_xor(bi, off); if (ov > bv || (ov == bv && oi < bi)) { bv = ov; bi = oi; } }
                tv[k] = bv; ti[k] = bi; if (e == bi) v = -INFINITY;
            }
            const float e1 = __expf(tv[1] - tv[0]), e2 = __expf(tv[2] - tv[0]), e3 = __expf(tv[3] - tv[0]);
            const float inv = 1.f / (1.f + e1 + e2 + e3);
            if (e < 4) {
                const int ex = e == 0 ? ti[0] : e == 1 ? ti[1] : e == 2 ? ti[2] : ti[3];
                const float gt = (e == 0 ? 1.f : e == 1 ? e1 : e == 2 ? e2 : e3) * inv;
                const int lp = atomicAdd((int*)(hist + ex), 1);
                const int sl = row * 4 + e;
                slot_e[sl] = ex; slot_p[sl] = lp; slot_g[sl] = gt;
            }
        }
    }
    __syncthreads();
    if (dry) return;
    if (F.tid < 32) base[F.tid] = (int)__hip_atomic_fetch_add((unsigned*)(F.ctl + CW_CNT + layer * 32 + F.tid), (unsigned)hist[F.tid], RLX_AGENT);
    __syncthreads();
    if (F.tid < 256) {
        const int e = slot_e[F.tid]; const int pos = base[e] + slot_p[F.tid];
        ((int*)(F.ws + WS_ROWSLOT))[e * CAP + pos] = (tok0 + (F.tid >> 2)) * 4 + (F.tid & 3);
        ((float*)(F.ws + WS_ROWGATE))[e * CAP + pos] = slot_g[F.tid];
        ((float*)(F.ws + WS_ROWHS))[e * CAP + pos] = ((const float*)(F.ws + WS_HS))[tok0 + (F.tid >> 2)];
    }
    __syncthreads();
}

__device__ __forceinline__ int pswz(int r, int c) { return r * 2048 + ((((c >> 3) ^ (r & 7)) << 4) | ((c & 7) << 1)); }
template <int W>
__device__ __forceinline__ void pool_chunk(const f32x2 (&v)[16], int sc, int s0, const LAS float* rstd1, float gx, float gy, float (&rx)[W], float (&ry)[W], LAS unsigned char* P, int tid) {
#pragma unroll
    for (int j = 0; j < 16; ++j) {
        const int tl = sc * 16 + j; const float r = rstd1[16 + tl];
        const float hx = v[j].x * r * gx, hy = v[j].y * r * gy;
        rx[j % W] = hx; ry[j % W] = hy;
        float sx = 0.f, sy = 0.f;
#pragma unroll
        for (int q = 0; q < W; ++q) { sx += rx[q]; sy += ry[q]; }
        const int s = s0 + tl; const int cn = (s + 1 < W) ? (s + 1) : W; const float inv = 1.f / (float)cn;
        *(LAS unsigned*)(P + pswz(tl, 2 * tid)) = pk2(sx * inv - hx, sy * inv - hy);
    }
}
template <int W>
__device__ __forceinline__ void pool_window(const float* __restrict__ x, int tok0, int s0, const LAS float* rstd1, float gx, float gy, LAS unsigned char* P, int tid) {
    float rx[W], ry[W];
    const GAS f32x2* xp = (const GAS f32x2*)x + tid;
    const bool hist = s0 > 0;
    {
        const GAS f32x2* pw = xp + (size_t)(hist ? tok0 - W : tok0) * 512;
#pragma unroll
        for (int j = 0; j < W; ++j) { const f32x2 v = pw[(size_t)j * 512]; const float r = hist ? rstd1[16 - W + j] : 0.f; rx[j] = v.x * r * gx; ry[j] = v.y * r * gy; }
    }
    f32x2 va[16];
    { const GAS f32x2* p0 = xp + (size_t)tok0 * 512;
#pragma unroll
      for (int j = 0; j < 16; ++j) va[j] = p0[(size_t)j * 512]; }
#pragma unroll 1
    for (int sc = 0; sc < 4; ++sc) {
        f32x2 vb[16];
        const GAS f32x2* pn = xp + (size_t)(tok0 + 16 * (sc < 3 ? sc + 1 : 3)) * 512;
#pragma unroll
        for (int j = 0; j < 16; ++j) vb[j] = pn[(size_t)j * 512];
        pool_chunk<W>(va, sc, s0, rstd1, gx, gy, rx, ry, P, tid);
#pragma unroll
        for (int j = 0; j < 16; ++j) va[j] = vb[j];
    }
}
__device__ __forceinline__ void phase_pool(Frame& F, bool dry) {
    LAS unsigned char* P = F.lds;
    LAS float* rstd1 = (LAS float*)(F.lds + L_RSTD);
    const int lane = F.lane, wave = F.wave, tid = F.tid;
    const int fr = lane & 15, fq = lane >> 4;
    const float* __restrict__ xin = F.x; float* __restrict__ xo = F.out;
    for (int tile = blockIdx.x; tile < NTOK / 64; tile += F.G) {
        const int tok0 = tile * 64, s0 = tok0 & (SEQ - 1);
#pragma unroll 1
        for (int hb = 0; hb < 2; ++hb) {
            f32x4 v[5][4];
#pragma unroll
            for (int k = 0; k < 5; ++k) { const int rr = wave + 8 * (5 * hb + k); const bool ok = (s0 - 16 + rr) >= 0;
                const GAS f32x4* xr = (const GAS f32x4*)(xin + (size_t)(ok ? tok0 - 16 + rr : tok0) * 1024) + lane;
#pragma unroll
                for (int j = 0; j < 4; ++j) v[k][j] = xr[64 * j]; }
#pragma unroll
            for (int k = 0; k < 5; ++k) { const int rr = wave + 8 * (5 * hb + k); const bool ok = (s0 - 16 + rr) >= 0; float ss = 0.f;
#pragma unroll
                for (int j = 0; j < 4; ++j) ss += (v[k][j].x * v[k][j].x + v[k][j].y * v[k][j].y) + (v[k][j].z * v[k][j].z + v[k][j].w * v[k][j].w);
                const float r = rsqrtf(wave_sum(ss) * (1.f / 1024.f) + EPS);
                if (lane == 0) rstd1[rr] = ok ? r : 0.f; }
        }
        __syncthreads();
        { const float gx = F.norm_mix_g[2 * tid], gy = F.norm_mix_g[2 * tid + 1];
          const int grp = wave >> 1;
          if (grp == 0) pool_window<2>(xin, tok0, s0, rstd1, gx, gy, P, tid);
          else if (grp == 1) pool_window<4>(xin, tok0, s0, rstd1, gx, gy, P, tid);
          else if (grp == 2) pool_window<8>(xin, tok0, s0, rstd1, gx, gy, P, tid);
          else pool_window<16>(xin, tok0, s0, rstd1, gx, gy, P, tid); }
        __syncthreads();
        { const int gi = wave >> 1, nh = wave & 1;
#pragma unroll 1
          for (int np = 0; np < 2; ++np) {
              const bf16* Wt = (const bf16*)(F.ws + WS_WPOOL) + (size_t)gi * 65536 + (size_t)(nh * 128 + np * 64) * 256;
              f32x4 acc[4][4];
#pragma unroll
              for (int m = 0; m < 4; ++m)
#pragma unroll
                  for (int n = 0; n < 4; ++n) acc[m][n] = (f32x4){0.f, 0.f, 0.f, 0.f};
#pragma unroll 4
              for (int ks = 0; ks < 8; ++ks) {
                  bf16x8 a[4];
#pragma unroll
                  for (int m = 0; m < 4; ++m) a[m] = *(const LAS bf16x8*)(P + pswz(m * 16 + fr, gi * 256 + ks * 32 + fq * 8));
#pragma unroll
                  for (int n = 0; n < 4; ++n) {
                      const bf16x8 b = *(const GAS bf16x8*)(Wt + (size_t)(n * 16 + fr) * 256 + ks * 32 + fq * 8);
#pragma unroll
                      for (int m = 0; m < 4; ++m) acc[m][n] = __builtin_amdgcn_mfma_f32_16x16x32_bf16(b, a[m], acc[m][n], 0, 0, 0);
                  }
              }
              const int colb = gi * 256 + nh * 128 + np * 64 + fq * 4;
              f32x4 xv[4][4], sc[4];
#pragma unroll
              for (int n = 0; n < 4; ++n) { sc[n] = *(const f32x4*)(F.pool_scale + colb + n * 16);
#pragma unroll
                  for (int m = 0; m < 4; ++m) xv[n][m] = *(const GAS f32x4*)(xin + (size_t)(tok0 + m * 16 + fr) * 1024 + colb + n * 16); }
#pragma unroll
              for (int n = 0; n < 4; ++n)
#pragma unroll
                  for (int m = 0; m < 4; ++m) *(GAS f32x4*)(xo + (size_t)(tok0 + m * 16 + fr) * 1024 + colb + n * 16) = xv[n][m] + acc[m][n] * sc[n];
          }
        }
        VM_WAIT();
        __syncthreads();
        router_tile(F, 0, tok0, dry);
    }
}
__device__ __forceinline__ void phase_router(Frame& F, int layer, bool dry) {
    for (int tile = blockIdx.x; tile < NTOK / 64; tile += F.G) router_tile(F, layer, tile * 64, dry);
}

__device__ __forceinline__ void moe_tables(Frame& F, int layer) {
    LAS int* cntL = (LAS int*)(F.lds + L_CNT); LAS int* prow0 = (LAS int*)(F.lds + L_PROW0); LAS int* ntp = (LAS int*)(F.lds + L_NT);
    LAS int* tileE = (LAS int*)(F.lds + L_TILEE); LAS int* tileRow = (LAS int*)(F.lds + L_TILEROW);
    __syncthreads();
    if (F.tid < 64) {
        int c = 0;
        if (F.tid < 32) { c = (int)__hip_atomic_load((unsigned*)(F.ctl + CW_CNT + layer * 32 + F.tid), RLX_AGENT); if (c > CAP) c = CAP; }
        const int mt = (c + 255) >> 8;
        int incl = mt;
#pragma unroll
        for (int o = 1; o < 32; o <<= 1) { const int v = __shfl_up(incl, o); if ((F.tid & 63) >= o) incl += v; }
        const int excl = incl - mt;
        if (F.tid < 32) {
            cntL[F.tid] = c; prow0[F.tid] = excl * 256;
            for (int m = 0; m < mt; ++m) if (excl + m < MAXT) { tileE[excl + m] = F.tid; tileRow[excl + m] = (excl + m) * 256; }
            if (F.tid == 31) ntp[0] = incl < MAXT ? incl : MAXT;
        }
    }
    __syncthreads();
}

template <bool GATH>
struct MoeOrderT {
    static constexpr bool GATHER = GATH;
    int NT, nN, G, c; const LAS int* tileE; const LAS int* tileRow; const LAS int* cntL; const LAS int* prow0; const int* rowslot;
    const char* Abase; const char* Bbase; size_t bExp, bTile; int aPitch;
    __device__ __forceinline__ bool next(int i, pg8::Unit& u) const {
        int T, pn; if (!pg8::tile_order(i, G, c, NT, nN, T, pn)) return false;
        const int e = tileE[T], row0 = tileRow[T];
        u.a = GATH ? Abase : Abase + (size_t)row0 * aPitch; u.b = Bbase + (size_t)e * bExp + (size_t)pn * bTile; u.i0 = T; u.i1 = pn; u.i2 = e; u.i3 = row0; return true;
    }
    __device__ __forceinline__ int row_src(const pg8::Unit& u, int r) const {
        const int e = u.i2, cn = cntL[e]; int pos = u.i3 - prow0[e] + r; pos = pos < cn ? pos : cn - 1;
        return rowslot[e * CAP + pos] >> 2;
    }
};
struct EpiGU {
    typedef v4i ACC; static constexpr int MODE = 1;
    static __host__ __device__ __forceinline__ int brow(int R) { return (R & ~31) + pg8::perm32(R & 31); }
    bf16* ACT; const float* bgu; const float* wsc; const float* rowhs; const LAS int* prow0;
    __device__ __forceinline__ void operator()(const v4i (&acc)[2][2][4][2], const pg8::Unit& u, int wr, int wc, int fr, int fq) const {
        const int e = u.i2, f0 = u.i1 * 128 + wc * 32 + 8 * fq;
        const float* bg = bgu + (size_t)e * 2048 + f0; const float* sp = wsc + (size_t)e * 2048 + f0;
        const f32x4 bg0 = *(const f32x4*)(bg), bg1 = *(const f32x4*)(bg + 4), bu0 = *(const f32x4*)(bg + 1024), bu1 = *(const f32x4*)(bg + 1028);
        const f32x4 sg0 = *(const f32x4*)(sp), sg1 = *(const f32x4*)(sp + 4), su0 = *(const f32x4*)(sp + 1024), su1 = *(const f32x4*)(sp + 1028);
        const int pbase = u.i3 - prow0[e];
        float rsv[2][4];
#pragma unroll
        for (int ai = 0; ai < 2; ++ai)
#pragma unroll
            for (int m = 0; m < 4; ++m) rsv[ai][m] = rowhs[e * CAP + pbase + ai * 128 + wr * 64 + m * 16 + fr];
#pragma unroll
        for (int ai = 0; ai < 2; ++ai)
#pragma unroll
            for (int m = 0; m < 4; ++m) {
                const int prow = u.i3 + ai * 128 + wr * 64 + m * 16 + fr; const float rs = rsv[ai][m];
                const f32x4 g0 = __builtin_convertvector(acc[ai][0][m][0], f32x4) * (sg0 * rs) + bg0, g1 = __builtin_convertvector(acc[ai][0][m][1], f32x4) * (sg1 * rs) + bg1;
                const f32x4 u0 = __builtin_convertvector(acc[ai][1][m][0], f32x4) * (su0 * rs) + bu0, u1 = __builtin_convertvector(acc[ai][1][m][1], f32x4) * (su1 * rs) + bu1;
                float o[8];
#pragma unroll
                for (int j = 0; j < 8; ++j) {
                    const float g = fminf(j < 4 ? g0[j & 3] : g1[j & 3], 7.f);
                    const float up = fminf(fmaxf(j < 4 ? u0[j & 3] : u1[j & 3], -7.f), 7.f);
                    const float sg = __builtin_amdgcn_rcpf(1.f + __builtin_amdgcn_exp2f(-1.702f * 1.4426950408889634f * g));
                    o[j] = (up + 1.f) * (g * sg);
                }
                u32x4 w; w.x = cvt_pk_bf16(o[0], o[1]); w.y = cvt_pk_bf16(o[2], o[3]); w.z = cvt_pk_bf16(o[4], o[5]); w.w = cvt_pk_bf16(o[6], o[7]);
                *(GAS u32x4*)(ACT + (size_t)prow * 1024 + f0) = w;
            }
    }
};
struct EpiDN {
    typedef f32x4 ACC; static constexpr int MODE = 0;
    static __host__ __device__ __forceinline__ int brow(int R) { return (R & ~31) + pg8::perm32(R & 31); }
    bf16* Y; const float* bdn; const float* wsc; const int* rowslot; const float* rowgate; const LAS int* cntL; const LAS int* prow0;
    __device__ __forceinline__ void operator()(const f32x4 (&acc)[2][2][4][2], const pg8::Unit& u, int wr, int wc, int fr, int fq) const {
        const int e = u.i2, col0 = u.i1 * 256 + wc * 32 + 8 * fq;
        const float* bp = bdn + (size_t)e * 1024 + col0;
        f32x4 bv[2][2];
#pragma unroll
        for (int bj = 0; bj < 2; ++bj)
#pragma unroll
            for (int n = 0; n < 2; ++n) bv[bj][n] = *(const f32x4*)(bp + bj * 128 + 4 * n);
        const int pbase = u.i3 - prow0[e], cn = cntL[e];
        int slotv[2][4]; float gtv[2][4];
#pragma unroll
        for (int ai = 0; ai < 2; ++ai)
#pragma unroll
            for (int m = 0; m < 4; ++m) { const int pos = pbase + ai * 128 + wr * 64 + m * 16 + fr; const int pc = pos < cn ? pos : 0;
                slotv[ai][m] = rowslot[e * CAP + pc]; gtv[ai][m] = rowgate[e * CAP + pc]; }
#pragma unroll
        for (int ai = 0; ai < 2; ++ai)
#pragma unroll
            for (int m = 0; m < 4; ++m) {
                const int pos = pbase + ai * 128 + wr * 64 + m * 16 + fr;
                if (pos < cn) {
                    const float gt = gtv[ai][m];
                    bf16* rowp = Y + (size_t)slotv[ai][m] * 1024 + col0;
#pragma unroll
                    for (int bj = 0; bj < 2; ++bj) {
                        const f32x4 v0 = (acc[ai][bj][m][0] + bv[bj][0]) * gt, v1 = (acc[ai][bj][m][1] + bv[bj][1]) * gt;
                        u32x4 w; w.x = cvt_pk_bf16(v0[0], v0[1]); w.y = cvt_pk_bf16(v0[2], v0[3]); w.z = cvt_pk_bf16(v1[0], v1[1]); w.w = cvt_pk_bf16(v1[2], v1[3]);
                        *(GAS u32x4*)(rowp + bj * 128) = w;
                    }
                }
            }
    }
};
__device__ __forceinline__ void phase_moe_gu(Frame& F, int layer) {
    moe_tables(F, layer);
    typedef MoeOrderT<true> Ord;
    Ord S; S.NT = *(const LAS int*)(F.lds + L_NT); S.nN = 8; S.G = F.G; S.c = blockIdx.x; S.tileE = (const LAS int*)(F.lds + L_TILEE); S.tileRow = (const LAS int*)(F.lds + L_TILEROW);
    S.cntL = (const LAS int*)(F.lds + L_CNT); S.prow0 = (const LAS int*)(F.lds + L_PROW0); S.rowslot = (const int*)(F.ws + WS_ROWSLOT);
    S.Abase = (const char*)(F.ws + WS_H2); S.Bbase = (const char*)(F.ws + WS_WGU) + (size_t)layer * 32 * 2048 * 1024; S.bExp = (size_t)2048 * 1024; S.bTile = (size_t)128 * 1024; S.aPitch = 1024;
    EpiGU E; E.ACT = (bf16*)(F.ws + WS_ACT); E.bgu = F.b_gu + (size_t)layer * 32 * 2048; E.wsc = (const float*)(F.ws + WS_SC_GU) + (size_t)layer * 32 * 2048; E.rowhs = (const float*)(F.ws + WS_ROWHS);
    E.prow0 = (const LAS int*)(F.lds + L_PROW0);
    pg8::gemm_phase<EpiGU, Ord, true, true>(F.lds, (size_t)1024 * 1024, S, E);
}
__device__ __forceinline__ void phase_moe_dn(Frame& F, int layer) {
    moe_tables(F, layer);
    typedef MoeOrderT<false> Ord;
    Ord S; S.NT = *(const LAS int*)(F.lds + L_NT); S.nN = 4; S.G = F.G; S.c = blockIdx.x; S.tileE = (const LAS int*)(F.lds + L_TILEE); S.tileRow = (const LAS int*)(F.lds + L_TILEROW);
    S.cntL = (const LAS int*)(F.lds + L_CNT); S.prow0 = (const LAS int*)(F.lds + L_PROW0); S.rowslot = (const int*)(F.ws + WS_ROWSLOT);
    S.Abase = (const char*)(F.ws + WS_ACT); S.Bbase = (const char*)(F.ws + WS_WDN) + (size_t)layer * 32 * 1024 * 1024 * 2; S.bExp = (size_t)1024 * 1024 * 2; S.bTile = (size_t)256 * 1024 * 2; S.aPitch = 2048;
    EpiDN E; E.Y = (bf16*)(F.ws + WS_Y); E.bdn = F.b_dn + (size_t)layer * 32 * 1024; E.wsc = (const float*)(F.ws + WS_SC_DN) + (size_t)layer * 32 * 1024;
    E.rowslot = (const int*)(F.ws + WS_ROWSLOT); E.rowgate = (const float*)(F.ws + WS_ROWGATE);
    E.cntL = (const LAS int*)(F.lds + L_CNT); E.prow0 = (const LAS int*)(F.lds + L_PROW0);
    pg8::gemm_phase<EpiDN, Ord, true, true>(F.lds, (size_t)128 * 1024 * 2, S, E);
}

__device__ __forceinline__ void phase_combine(Frame& F, int layer, bool dry) {
    float* xout = dry ? (float*)(F.ws + WS_BIG + 144 * MiB) : F.out;
    const int gw = blockIdx.x * NWAVES + F.wave, NGW = F.G * NWAVES, lane = F.lane;
    const bf16* Y = (const bf16*)(F.ws + WS_Y); unsigned char* H2 = F.ws + WS_H2; float* HS = (float*)(F.ws + WS_HS);
    f32x4 gv[4];
#pragma unroll
    for (int j = 0; j < 4; ++j) gv[j] = *(const f32x4*)(F.norm_mix_g + 1024 + lane * 4 + 256 * j);
    for (int tok = gw; tok < NTOK; tok += NGW) {
        GAS f32x4* xr = (GAS f32x4*)(F.out + (size_t)tok * 1024) + lane;
        f32x4 v[4];
#pragma unroll
        for (int j = 0; j < 4; ++j) v[j] = xr[64 * j];
#pragma unroll
        for (int k = 0; k < 4; ++k) {
            const GAS u32x2* yr = (const GAS u32x2*)(Y + (size_t)(tok * 4 + k) * 1024) + lane;
#pragma unroll
            for (int j = 0; j < 4; ++j) { const u32x2 w = yr[64 * j]; v[j].x += bflo(w.x); v[j].y += bfhi(w.x); v[j].z += bflo(w.y); v[j].w += bfhi(w.y); }
        }
        float ss = 0.f;
#pragma unroll
        for (int j = 0; j < 4; ++j) { ((GAS f32x4*)(xout + (size_t)tok * 1024) + lane)[64 * j] = v[j]; ss += (v[j].x * v[j].x + v[j].y * v[j].y) + (v[j].z * v[j].z + v[j].w * v[j].w); }
        if (layer == 0 && !dry) {
            const float rstd = rsqrtf(wave_sum(ss) * (1.f / 1024.f) + EPS);
            f32x4 h[4];
#pragma unroll
            for (int j = 0; j < 4; ++j) h[j] = v[j] * rstd * gv[j];
            unsigned qw[4]; float inv; quant_row_i8(h, qw, inv);
            GAS unsigned* o4 = (GAS unsigned*)(H2 + (size_t)tok * 1024) + lane;
#pragma unroll
            for (int j = 0; j < 4; ++j) o4[64 * j] = qw[j];
            if (lane == 0) HS[tok] = inv;
        }
    }
}

struct DenseOrder {
    static constexpr bool GATHER = false;
    __device__ __forceinline__ int row_src(const pg8::Unit&, int) const { return 0; }
    int nM, nN, G, c; const char* Abase; const char* Bbase; int pitch;
    __device__ __forceinline__ bool next(int i, pg8::Unit& u) const {
        int pm, pn; if (!pg8::tile_order(i, G, c, nM, nN, pm, pn)) return false;
        u.a = Abase + (size_t)pm * 256 * pitch; u.b = Bbase + (size_t)pn * 256 * pitch; u.i0 = pm; u.i1 = pn; u.i2 = 0; u.i3 = 0; return true;
    }
};
struct EpiQKV {
    typedef v4i ACC; static constexpr int MODE = 1;
    static __host__ __device__ __forceinline__ int brow(int R) { return 2 * (R & ~31) + pg8::perm32(R & 31); }
    bf16* O; const float* qg; const float* kg; const float* wsc; const float* hs;
    __device__ __forceinline__ void operator()(const v4i (&acc)[2][2][4][2], const pg8::Unit& u, int wr, int wc, int fr, int fq) const {
        const int pn = u.i1, which = pn / 12;
        const int colh = pn * 256 + wc * 64;
        f32x4 gn[2][2], sc[2][2];
#pragma unroll
        for (int bj = 0; bj < 2; ++bj)
#pragma unroll
            for (int n = 0; n < 2; ++n) {
                const int hd = bj * 32 + 8 * fq + 4 * n;
                gn[bj][n] = which == 0 ? *(const f32x4*)(qg + hd) * (0.125f * 1.4426950408889634f) : which == 1 ? *(const f32x4*)(kg + hd) : (f32x4){1.f, 1.f, 1.f, 1.f};
                sc[bj][n] = *(const f32x4*)(wsc + colh + hd);
            }
#pragma unroll
        for (int ai = 0; ai < 2; ++ai)
#pragma unroll
            for (int m = 0; m < 4; ++m) {
                const int row = u.i0 * 256 + ai * 128 + wr * 64 + m * 16 + fr; const float rsc = hs[row];
                f32x4 v[2][2]; float ss = 0.f;
#pragma unroll
                for (int bj = 0; bj < 2; ++bj)
#pragma unroll
                    for (int n = 0; n < 2; ++n) { v[bj][n] = __builtin_convertvector(acc[ai][bj][m][n], f32x4) * (sc[bj][n] * rsc); const f32x4 t = v[bj][n]; ss += (t[0] * t[0] + t[1] * t[1]) + (t[2] * t[2] + t[3] * t[3]); }
                ss += __shfl_xor(ss, 16); ss += __shfl_xor(ss, 32);
                const float rs = which == 2 ? 1.f : rsqrtf(ss * (1.f / 64.f) + EPS);
                bf16* rowp = O + (size_t)row * NQKV + colh + 8 * fq;
#pragma unroll
                for (int bj = 0; bj < 2; ++bj) {
                    const f32x4 v0 = v[bj][0] * rs * gn[bj][0], v1 = v[bj][1] * rs * gn[bj][1];
                    u32x4 w; w.x = cvt_pk_bf16(v0[0], v0[1]); w.y = cvt_pk_bf16(v0[2], v0[3]); w.z = cvt_pk_bf16(v1[0], v1[1]); w.w = cvt_pk_bf16(v1[2], v1[3]);
                    *(GAS u32x4*)(rowp + bj * 32) = w;
                }
            }
    }
};
__device__ __forceinline__ void phase_qkv(Frame& F) {
    DenseOrder S; S.nM = NTOK / 256; S.nN = NQKV / 256; S.G = F.G; S.c = blockIdx.x; S.Abase = (const char*)(F.ws + WS_H2); S.Bbase = (const char*)(F.ws + WS_WQKV); S.pitch = 1024;
    EpiQKV E; E.O = (bf16*)(F.ws + WS_QKV); E.qg = F.q_gain; E.kg = F.k_gain; E.wsc = (const float*)(F.ws + WS_SC_QKV); E.hs = (const float*)(F.ws + WS_HS);
    pg8::gemm_phase<EpiQKV, DenseOrder, true, true>(F.lds, (size_t)32 * 1024, S, E);
}

struct EpiWo {
    typedef f32x4 ACC; static constexpr int MODE = 0;
    static __host__ __device__ __forceinline__ int brow(int R) { return R; }
    float* X; float* XO;
    __device__ __forceinline__ void operator()(const f32x4 (&acc)[2][2][4][2], const pg8::Unit& u, int wr, int wc, int fr, int fq) const {
        const int row0 = u.i0 * 256 + wr * 64 + fr, col0 = u.i1 * 256 + wc * 32 + 4 * fq; const size_t dlt = XO - X;
#pragma unroll
        for (int ai = 0; ai < 2; ++ai)
#pragma unroll
            for (int m = 0; m < 4; ++m) { float* rowp = X + (size_t)(row0 + ai * 128 + m * 16) * 1024 + col0;
#pragma unroll
                for (int bj = 0; bj < 2; ++bj)
#pragma unroll
                    for (int n = 0; n < 2; ++n) { GAS f32x4* p = (GAS f32x4*)(rowp + bj * 128 + n * 16); *(p + dlt / 4) = *p + acc[ai][bj][m][n]; } }
    }
};
__device__ __forceinline__ void phase_wo(Frame& F, bool dry) {
    DenseOrder S; S.nM = NTOK / 256; S.nN = 4; S.G = F.G; S.c = blockIdx.x; S.Abase = (const char*)(F.ws + WS_OB); S.Bbase = (const char*)(F.ws + WS_WO); S.pitch = 2048;
    EpiWo E; E.X = F.out; E.XO = dry ? (float*)(F.ws + WS_BIG + 144 * MiB) : F.out;
    pg8::gemm_phase<EpiWo, DenseOrder, false, true>(F.lds, (size_t)128 * 1024 * 2, S, E);
}

typedef short v4i16_t __attribute__((ext_vector_type(4)));
__device__ __forceinline__ s16x4 vtr(const LAS unsigned char* p) { return __builtin_bit_cast(s16x4, __builtin_amdgcn_ds_read_tr16_b64_v4i16((LAS v4i16_t*)p)); }
struct AttnItem { int g, dil, i, head, needprev; size_t rowbase; };
__device__ __forceinline__ AttnItem attn_item(int sup, int it, int hg) {
    AttnItem a; int z, hp;
    if (it < 4) { const int c0 = sup >> 2; a.g = 0; a.dil = 1; z = c0 >> 3; hp = c0 & 7; a.i = 4 * (sup & 3) + it; a.needprev = (it == 0 && a.i > 0); }
    else if (it < 8) { a.g = 1; a.dil = 4; z = sup >> 3; hp = sup & 7; a.i = it - 4; a.needprev = 0; }
    else { const int idx = 4 * sup + (it - 8); a.g = 2; a.dil = 16; z = idx >> 3; hp = idx & 7; a.i = 0; a.needprev = 0; }
    a.head = hp * 2 + hg;
    a.rowbase = (size_t)(z / a.dil) * SEQ + (z % a.dil);
    return a;
}
__device__ __forceinline__ void attn_issue(const bf16* QKV, const AttnItem& a, int blk, int t2, u32x4 (&kv)[4], u32x4 (&vv)[4]) {
#pragma unroll
    for (int it = 0; it < 4; ++it) {
        const int cidx = t2 + 256 * it, row = cidx >> 3, ch = cidx & 7;
        const bf16* src = QKV + (a.rowbase + (size_t)a.dil * ((size_t)blk * 128 + row)) * NQKV + a.g * 1024 + a.head * 64 + ch * 8;
        kv[it] = *(const GAS u32x4*)(src + 3072); vv[it] = *(const GAS u32x4*)(src + 6144);
    }
}
__device__ __forceinline__ void attn_commit(LAS unsigned char* Kb, LAS unsigned char* Vb, int slot, int t2, const u32x4 (&kv)[4], const u32x4 (&vv)[4]) {
#pragma unroll
    for (int it = 0; it < 4; ++it) {
        const int cidx = t2 + 256 * it, row = cidx >> 3, ch = cidx & 7;
        const int off = slot * 16384 + row * 128 + ((ch ^ (row & 7)) << 4);
        *(LAS u32x4*)(Kb + off) = kv[it]; *(LAS u32x4*)(Vb + off) = vv[it];
    }
}
__device__ __forceinline__ void attn_loadq(const bf16* QKV, const AttnItem& a, int w, int q, int hh, bf16x8 (&qf)[4]) {
    const size_t qrow = a.rowbase + (size_t)a.dil * ((size_t)a.i * 128 + 32 * w + q);
    const bf16* qp = QKV + qrow * NQKV + a.g * 1024 + a.head * 64 + 8 * hh;
#pragma unroll
    for (int ks = 0; ks < 4; ++ks) qf[ks] = *(const GAS bf16x8*)(qp + 16 * ks);
}
__device__ __forceinline__ void phase_attn(Frame& F) {
    LAS unsigned char* lds = F.lds;
    LAS float* btab = (LAS float*)(lds + L_BTAB); LAS int* bucketL = (LAS int*)(lds + L_BUCKET);
    const int tid = F.tid, lane = F.lane, wave = F.wave;
    for (int i = tid; i < 3 * 129; i += NTHREADS) {
        const int g = i / 129, d = i % 129; const int n = d * (g == 0 ? 1 : g == 1 ? 4 : 16);
        int bk;
        if (n < 16) bk = n;
        else { const float nf = (float)n; int lg = 16 + (int)(logf(nf / 16.f) / 4.852030263919617f * 16.f); bk = lg < 31 ? lg : 31; }
        bucketL[g * 132 + d] = bk;
    }
    __syncthreads();
    const int hg = wave >> 2, w = wave & 3, t2 = tid & 255;
    const int q = lane & 31, hh = lane >> 5;
    const bf16* QKV = (const bf16*)(F.ws + WS_QKV);
    LAS unsigned char* Kb = lds + hg * 32768;
    LAS unsigned char* Vb = lds + 65536 + hg * 32768;
    const int g16 = lane >> 4, i16 = lane & 15, qsel = i16 >> 2, psel = i16 & 3;
    int kcon[4];
#pragma unroll
    for (int ks = 0; ks < 4; ++ks) kcon[ks] = q * 128 + (((2 * ks + hh) ^ (q & 7)) << 4);
    const int c7 = (4 * hh + qsel) & 7, cb = 2 * (g16 & 1) + (psel >> 1);
    const int vcon0 = (4 * hh + qsel) * 128 + ((cb ^ c7) << 4) + (psel & 1) * 8;
    const int vcon1 = (4 * hh + qsel) * 128 + (((cb + 4) ^ c7) << 4) + (psel & 1) * 8;
    const LAS float* bt = btab + hg * 192 + 32 + 4 * hh - q;
    const int bj_ = t2 - 32; const bool bval = (t2 < 192) && bj_ >= 0 && bj_ <= 128; const int bdel = bval ? 128 - bj_ : 0;
    for (int sup = blockIdx.x; sup < 256; sup += F.G) {
        AttnItem cur = attn_item(sup, 0, hg);
        u32x4 kv[4], vv[4]; bf16x8 qf[4], qn[4]; float bnx;
        if (cur.needprev) { attn_issue(QKV, cur, cur.i - 1, t2, kv, vv); attn_commit(Kb, Vb, (cur.i - 1) & 1, t2, kv, vv); }
        attn_issue(QKV, cur, cur.i, t2, kv, vv); attn_loadq(QKV, cur, w, q, hh, qf);
        bnx = F.rel_bias[bucketL[cur.g * 132 + bdel] * 48 + cur.g * 16 + cur.head];
        attn_commit(Kb, Vb, cur.i & 1, t2, kv, vv);
        if (t2 < 192) btab[hg * 192 + t2] = bval ? bnx * 1.4426950408889634f : -1e30f;
        asm volatile("" : "+v"(qf[0]), "+v"(qf[1]), "+v"(qf[2]), "+v"(qf[3]) :: "memory");
        __syncthreads();
#pragma unroll 1
        for (int it = 0; it < 12; ++it) {
            const bool hn = it + 1 < 12;
            AttnItem nxt = cur;
            if (hn) { nxt = attn_item(sup, it + 1, hg); attn_issue(QKV, nxt, nxt.i, t2, kv, vv); attn_loadq(QKV, nxt, w, q, hh, qn);
                      bnx = F.rel_bias[bucketL[nxt.g * 132 + bdel] * 48 + nxt.g * 16 + nxt.head]; }
            const int i = cur.i;
            const int kt_lo = (i == 0) ? 4 : w;
            f32x16 S[5];
            float mx = -1e30f;
#pragma unroll
            for (int t = 0; t < 5; ++t) {
                const int kt = w + t;
                if (kt >= kt_lo) {
                    const LAS unsigned char* kp = Kb + (((kt < 4 ? i - 1 : i) & 1) * 16384 + (kt & 3) * 4096);
                    bf16x8 kf[4];
#pragma unroll
                    for (int ks = 0; ks < 4; ++ks) kf[ks] = *(const LAS bf16x8*)(kp + kcon[ks]);
                    f32x16 acc;
#pragma unroll
                    for (int rg = 0; rg < 16; ++rg) acc[rg] = bt[32 * t + 8 * (rg >> 2) + (rg & 3)];
#pragma unroll
                    for (int ks = 0; ks < 4; ++ks) acc = __builtin_amdgcn_mfma_f32_32x32x16_bf16(kf[ks], qf[ks], acc, 0, 0, 0);
                    S[t] = acc;
#pragma unroll
                    for (int rg = 0; rg < 16; ++rg) mx = fmaxf(mx, acc[rg]);
                } else {
#pragma unroll
                    for (int rg = 0; rg < 16; ++rg) S[t][rg] = -1e30f;
                }
            }
            mx = fmaxf(mx, __shfl_xor(mx, 32));
            float lsum = 0.f;
#pragma unroll
            for (int t = 0; t < 5; ++t)
#pragma unroll
                for (int rg = 0; rg < 16; ++rg) { const float p = __builtin_amdgcn_exp2f(S[t][rg] - mx); S[t][rg] = p; lsum += p; }
            lsum += __shfl_xor(lsum, 32);
            f32x16 O[2];
#pragma unroll
            for (int dt = 0; dt < 2; ++dt)
#pragma unroll
                for (int rg = 0; rg < 16; ++rg) O[dt][rg] = 0.f;
#pragma unroll
            for (int t = 0; t < 5; ++t) {
                const int kt = w + t;
                if (kt >= kt_lo) {
                    const LAS unsigned char* vp = Vb + (((kt < 4 ? i - 1 : i) & 1) * 16384 + (kt & 3) * 4096);
#pragma unroll
                    for (int s2 = 0; s2 < 2; ++s2) {
                        bf16x8 pf;
                        { const unsigned w0 = cvt_pk_bf16(S[t][8 * s2 + 0], S[t][8 * s2 + 1]), w1 = cvt_pk_bf16(S[t][8 * s2 + 2], S[t][8 * s2 + 3]),
                                         w2 = cvt_pk_bf16(S[t][8 * s2 + 4], S[t][8 * s2 + 5]), w3 = cvt_pk_bf16(S[t][8 * s2 + 6], S[t][8 * s2 + 7]);
                          const u32x4 pw = (u32x4){w0, w1, w2, w3}; pf = __builtin_bit_cast(bf16x8, pw); }
                        const s16x4 lo0 = vtr(vp + s2 * 2048 + vcon0), hi0 = vtr(vp + s2 * 2048 + 1024 + vcon0);
                        const s16x4 lo1 = vtr(vp + s2 * 2048 + vcon1), hi1 = vtr(vp + s2 * 2048 + 1024 + vcon1);
                        const bf16x8 vf0 = (bf16x8){lo0[0], lo0[1], lo0[2], lo0[3], hi0[0], hi0[1], hi0[2], hi0[3]};
                        const bf16x8 vf1 = (bf16x8){lo1[0], lo1[1], lo1[2], lo1[3], hi1[0], hi1[1], hi1[2], hi1[3]};
                        O[0] = __builtin_amdgcn_mfma_f32_32x32x16_bf16(vf0, pf, O[0], 0, 0, 0);
                        O[1] = __builtin_amdgcn_mfma_f32_32x32x16_bf16(vf1, pf, O[1], 0, 0, 0);
                    }
                }
            }
            {
                const size_t qrow = cur.rowbase + (size_t)cur.dil * ((size_t)i * 128 + 32 * w + q);
                const float inv = 1.f / lsum;
                bf16* op = (bf16*)(F.ws + WS_OG) + ((size_t)cur.g * NTOK + qrow) * 1024 + cur.head * 64;
#pragma unroll
                for (int dt = 0; dt < 2; ++dt)
#pragma unroll
                    for (int r4 = 0; r4 < 4; ++r4) {
                        u32x2 wv; wv.x = cvt_pk_bf16(O[dt][4 * r4 + 0] * inv, O[dt][4 * r4 + 1] * inv); wv.y = cvt_pk_bf16(O[dt][4 * r4 + 2] * inv, O[dt][4 * r4 + 3] * inv);
                        *(GAS u32x2*)(op + dt * 32 + 8 * r4 + 4 * hh) = wv;
                    }
                if (hh == 0) ((float*)(F.ws + WS_LSE))[((size_t)cur.g * NTOK + qrow) * 16 + cur.head] = (mx + __builtin_amdgcn_logf(lsum)) * 0.6931471805599453f;
            }
            __syncthreads();
            if (hn) {
                asm volatile("" : "+v"(qn[0]), "+v"(qn[1]), "+v"(qn[2]), "+v"(qn[3]), "+v"(bnx) :: "memory");
                attn_commit(Kb, Vb, nxt.i & 1, t2, kv, vv);
                if (t2 < 192) btab[hg * 192 + t2] = bval ? bnx * 1.4426950408889634f : -1e30f;
#pragma unroll
                for (int ks = 0; ks < 4; ++ks) qf[ks] = qn[ks];
                cur = nxt;
            }
            __syncthreads();
        }
    }
}
__device__ __forceinline__ void phase_attn_combine(Frame& F) {
    const int gw = blockIdx.x * NWAVES + F.wave, NGW = F.G * NWAVES, lane = F.lane;
    const float* LSE = (const float*)(F.ws + WS_LSE); const bf16* OG = (const bf16*)(F.ws + WS_OG); bf16* OB = (bf16*)(F.ws + WS_OB);
    for (int tok = gw; tok < NTOK; tok += NGW) {
        const int head = lane >> 2;
        const float l0 = LSE[((size_t)0 * NTOK + tok) * 16 + head], l1 = LSE[((size_t)1 * NTOK + tok) * 16 + head], l2 = LSE[((size_t)2 * NTOK + tok) * 16 + head];
        const float m = fmaxf(l0, fmaxf(l1, l2));
        float a0 = __expf(l0 - m), a1 = __expf(l1 - m), a2 = __expf(l2 - m); const float inv = 1.f / (a0 + a1 + a2); a0 *= inv; a1 *= inv; a2 *= inv;
        const GAS u32x4* p0 = (const GAS u32x4*)(OG + ((size_t)0 * NTOK + tok) * 1024) + 2 * lane;
        const GAS u32x4* p1 = (const GAS u32x4*)(OG + ((size_t)1 * NTOK + tok) * 1024) + 2 * lane;
        const GAS u32x4* p2 = (const GAS u32x4*)(OG + ((size_t)2 * NTOK + tok) * 1024) + 2 * lane;
        GAS u32x4* po = (GAS u32x4*)(OB + (size_t)tok * 1024) + 2 * lane;
#pragma unroll
        for (int c = 0; c < 2; ++c) {
            const u32x4 v0 = p0[c], v1 = p1[c], v2 = p2[c]; u32x4 o;
#pragma unroll
            for (int k = 0; k < 4; ++k) {
                const float lo = a0 * bflo(v0[k]) + a1 * bflo(v1[k]) + a2 * bflo(v2[k]);
                const float hi = a0 * bfhi(v0[k]) + a1 * bfhi(v1[k]) + a2 * bfhi(v2[k]);
                o[k] = pk2(lo, hi);
            }
            po[c] = o;
        }
    }
}

constexpr int NPHASE = 13;
__global__ void __launch_bounds__(NTHREADS, 2) fwd_kernel(Args args) {
    extern __shared__ __attribute__((aligned(16))) unsigned char lds_raw[];
    Frame F;
    F.lds = (LAS unsigned char*)lds_raw;
    F.tid = threadIdx.x; F.lane = F.tid & 63; F.wave = __builtin_amdgcn_readfirstlane(F.tid >> 6); F.G = gridDim.x;
    F.ws = args.ws; F.out = args.out; F.ctl = (gu32*)(args.ws + WS_CTL);
    F.x = args.in[0]; F.norm_mix_g = args.in[1]; F.norm_ffn_g = args.in[2]; F.pool_w = args.in[3]; F.pool_scale = args.in[4]; F.w_qkv = args.in[5];
    F.q_gain = args.in[6]; F.k_gain = args.in[7]; F.w_o = args.in[8]; F.rel_bias = args.in[9]; F.w_router = args.in[10]; F.b_router = args.in[11];
    F.w_gu = args.in[12]; F.b_gu = args.in[13]; F.w_dn = args.in[14]; F.b_dn = args.in[15];
    if (F.tid < 16) ((LAS unsigned*)(F.lds + L_BARST))[F.tid] = 0u;
    __syncthreads();
    if (args.never) cg::this_grid().sync();
#if MK_MULTI
#define GRID_BAR() do { } while (0)
#else
    XcdBarrier bar = xcd_barrier_post((unsigned*)(F.ctl + CW_BAR), (volatile LAS unsigned*)(F.lds + L_BARST));
#define GRID_BAR() xcd_barrier(bar)
#endif
    const int lo = args.ph_lo, hi = args.ph_hi;
#define IN(k) (lo <= (k) && (k) < hi)
#define SEAM(k) do { if (IN(k) && IN((k) + 1)) GRID_BAR(); } while (0)
#define RUN(k, call) do { if (IN(k)) { if ((DUP_MASK >> (k)) & 1) { call; GRID_BAR(); } call; } } while (0)
#define DRY(k) (((DUP_MASK >> (k)) & 1) != 0)
    RUN(0, phase_convert(F));          SEAM(0);
    if (IN(1)) { if (DRY(1)) { phase_pool(F, true); GRID_BAR(); } phase_pool(F, false); }  SEAM(1);
    RUN(2, phase_moe_gu(F, 0));        SEAM(2);
    RUN(3, phase_moe_dn(F, 0));        SEAM(3);
    if (IN(4)) { if (DRY(4)) { phase_combine(F, 0, true); GRID_BAR(); } phase_combine(F, 0, false); }  SEAM(4);
    RUN(5, phase_qkv(F));              SEAM(5);
    RUN(6, phase_attn(F));             SEAM(6);
    RUN(7, phase_attn_combine(F));     SEAM(7);
    if (IN(8)) { if (DRY(8)) { phase_wo(F, true); GRID_BAR(); } phase_wo(F, false); }  SEAM(8);
    if (IN(9)) { if (DRY(9)) { phase_router(F, 1, true); GRID_BAR(); } phase_router(F, 1, false); }  SEAM(9);
    RUN(10, phase_moe_gu(F, 1));       SEAM(10);
    RUN(11, phase_moe_dn(F, 1));       SEAM(11);
    if (IN(12)) { if (DRY(12)) { phase_combine(F, 1, true); GRID_BAR(); } phase_combine(F, 1, false); }
#undef RUN
#undef DRY
#undef IN
#undef SEAM
}

extern "C" void kernel_launch(void* const* d_in, const int* in_sizes, int n_in, void* d_out, int out_size, void* d_ws, size_t ws_size, hipStream_t stream) {
    static int grid = 0;
    if (grid == 0) {
        if (n_in != 16 || in_sizes[0] != NTOK * DM || out_size != NTOK * DM || ws_size < WS_END) {
            fprintf(stderr, "kernel_launch: unexpected shapes (n_in %d, in0 %d, out %d, ws %zu < %zu); nothing launched\n", n_in, n_in > 0 ? in_sizes[0] : -1, out_size, ws_size, (size_t)WS_END); grid = -1; return; }
        int dev = 0, cus = 0, per_cu = 0;
        if (hipGetDevice(&dev) != hipSuccess || hipDeviceGetAttribute(&cus, hipDeviceAttributeMultiprocessorCount, dev) != hipSuccess) { grid = -1; return; }
        if (hipFuncSetAttribute((const void*)fwd_kernel, hipFuncAttributeMaxDynamicSharedMemorySize, LDS_BYTES) != hipSuccess) { fprintf(stderr, "kernel_launch: hipFuncSetAttribute failed\n"); grid = -1; return; }
        if (hipOccupancyMaxActiveBlocksPerMultiprocessor(&per_cu, (const void*)fwd_kernel, NTHREADS, LDS_BYTES) != hipSuccess || per_cu < 1) { fprintf(stderr, "kernel_launch: occupancy query says %d blocks/CU\n", per_cu); (void)hipGetLastError(); grid = -1; return; }
        grid = cus;
    }
    if (grid < 0) return;
    if (hipMemsetAsync((char*)d_ws + WS_CTL, 0, CTL_BYTES, stream) != hipSuccess) { fprintf(stderr, "kernel_launch: memset failed\n"); return; }
    Args a{};
    for (int i = 0; i < 16; ++i) a.in[i] = (const float*)d_in[i];
    a.out = (float*)d_out; a.ws = (unsigned char*)d_ws; a.never = 0; a.pad = 0;
#if MK_MULTI
    for (int p = 0; p < NPHASE; ++p) { a.ph_lo = p; a.ph_hi = p + 1; hipLaunchKernelGGL(fwd_kernel, dim3(grid), dim3(NTHREADS), LDS_BYTES, stream, a); }
#else
    a.ph_lo = 0; a.ph_hi = NPHASE;
    void* kargs[] = {&a};
    hipError_t e = hipLaunchCooperativeKernel((const void*)fwd_kernel, dim3(grid), dim3(NTHREADS), kargs, LDS_BYTES, stream);
    if (e != hipSuccess) fprintf(stderr, "kernel_launch: cooperative launch failed: %s (grid %d)\n", hipGetErrorString(e), grid);
#endif
}
```

```cpp
#include <hip/hip_runtime.h>
#include <hip/hip_cooperative_groups.h>
#include <cstdio>
#include <cstdint>
namespace cg = cooperative_groups;

#ifndef DUP_MASK
#define DUP_MASK 0
#endif
#ifndef MK_MULTI
#define MK_MULTI 0
#endif

#define LAS __attribute__((address_space(3)))
#define GAS __attribute__((address_space(1)))
typedef unsigned short bf16;
typedef short bf16x8 __attribute__((ext_vector_type(8)));
typedef short s16x4 __attribute__((ext_vector_type(4)));
typedef float f32x2 __attribute__((ext_vector_type(2)));
typedef float f32x4 __attribute__((ext_vector_type(4)));
typedef float f32x16 __attribute__((ext_vector_type(16)));
typedef int v4i __attribute__((ext_vector_type(4)));
typedef int v8i __attribute__((ext_vector_type(8)));
typedef unsigned u32x4 __attribute__((ext_vector_type(4)));
typedef unsigned u32x2 __attribute__((ext_vector_type(2)));
typedef GAS unsigned gu32;

constexpr int NTOK = 16384, DM = 1024, SEQ = 2048, NEXP = 32, TOPK = 4, FF = 1024, NQKV = 9216;
constexpr int QKVB = 12288;
constexpr int CAP = 16384;
constexpr int MAXT = 288;
constexpr int PMAX = MAXT * 256;
constexpr float EPS = 1e-6f;
constexpr int NWAVES = 8, NTHREADS = 512;

constexpr size_t MiB = 1u << 20;
constexpr size_t WS_CTL = 0, CTL_BYTES = 1 * MiB;
constexpr size_t WS_WRT = 1 * MiB;
constexpr size_t WS_WPOOL = WS_WRT + 512 * 1024;
constexpr size_t WS_WO = 2 * MiB;
constexpr size_t WS_SC_GU = 4 * MiB;
constexpr size_t WS_SC_QKV = 4 * MiB + 512 * 1024;
constexpr size_t WS_SC_DN = 5 * MiB;
constexpr size_t WS_HS = 6 * MiB;
constexpr size_t WS_WQKV = 8 * MiB;
constexpr size_t WS_WGU = 18 * MiB;
constexpr size_t WS_WDN = WS_WGU + 128 * MiB;
constexpr size_t WS_ROWSLOT = WS_WDN + 128 * MiB;
constexpr size_t WS_ROWGATE = WS_ROWSLOT + 2 * MiB;
constexpr size_t WS_ROWHS = WS_ROWGATE + 2 * MiB;
constexpr size_t WS_LSE = WS_ROWHS + 2 * MiB;
constexpr size_t WS_H2 = WS_LSE + 3 * MiB;
constexpr size_t WS_BIG = WS_H2 + 16 * MiB;
constexpr size_t WS_ACT = WS_BIG, WS_QKV = WS_BIG;
constexpr size_t WS_Y = WS_BIG + 288 * MiB;
constexpr size_t WS_OG = WS_Y, WS_OB = WS_Y + 96 * MiB;
constexpr size_t WS_END = WS_Y + 128 * MiB;
static_assert(WS_END <= 874 * MiB, "workspace map must fit the guaranteed d_ws size");
constexpr int CW_CNT = 64;
constexpr int CW_BAR = 4096;

constexpr int RING_BYTES = 131072;
constexpr int MISC_OFF = RING_BYTES;
constexpr int L_BARST = MISC_OFF + 0;
constexpr int L_CNT = MISC_OFF + 64;
constexpr int L_PROW0 = MISC_OFF + 192;
constexpr int L_NT = MISC_OFF + 320;
constexpr int L_TILEE = MISC_OFF + 336;
constexpr int L_TILEROW = MISC_OFF + 1488;
constexpr int L_HIST = MISC_OFF + 2640;
constexpr int L_BASE = MISC_OFF + 2768;
constexpr int L_SLOTE = MISC_OFF + 2896;
constexpr int L_SLOTP = MISC_OFF + 3920;
constexpr int L_SLOTG = MISC_OFF + 4944;
constexpr int L_RSTD = MISC_OFF + 5968;
constexpr int L_BIAS = MISC_OFF + 6288;
constexpr int L_BUCKET = MISC_OFF + 7344;
constexpr int L_BTAB = MISC_OFF + 8960;
constexpr int LDS_BYTES = 147456;
static_assert(L_BTAB + 2 * 192 * 4 <= LDS_BYTES, "LDS map");

#define RLX_AGENT __ATOMIC_RELAXED, __HIP_MEMORY_SCOPE_AGENT
#define LDS_WAIT() asm volatile("s_waitcnt lgkmcnt(0)" ::: "memory")
#define VM_WAIT() asm volatile("s_waitcnt vmcnt(0)" ::: "memory")
__device__ __forceinline__ unsigned f2bf(float f) { unsigned u = __builtin_bit_cast(unsigned, f); return (u + 0x7fffu + ((u >> 16) & 1u)) >> 16; }
__device__ __forceinline__ unsigned pk2(float lo, float hi) { return f2bf(lo) | (f2bf(hi) << 16); }
__device__ __forceinline__ float bf2f(unsigned short b) { return __builtin_bit_cast(float, ((unsigned)b) << 16); }
__device__ __forceinline__ float bflo(unsigned w) { return __builtin_bit_cast(float, w << 16); }
__device__ __forceinline__ float bfhi(unsigned w) { return __builtin_bit_cast(float, w & 0xffff0000u); }
__device__ __forceinline__ unsigned cvt_pk_bf16(float lo, float hi) { unsigned r; asm volatile("v_cvt_pk_bf16_f32 %0, %1, %2" : "=v"(r) : "v"(lo), "v"(hi)); return r; }
__device__ __forceinline__ float wave_sum(float v) {
#pragma unroll
    for (int o = 1; o < 64; o <<= 1) v += __shfl_xor(v, o);
    return v;
}

#define XB_TMO      128
#define XB_XCNT(j)  (256  + 64 * (j))
#define XB_XSUB(j)  (1280 + 64 * (j))
#define XB_XGEN(j)  (2304 + 64 * (j))
#define XB_TOP      3328
#define XB_TOPGEN   3392
#define XCD_BAR_WORDS 3456
#define XB_SPIN_CAP (1u << 20)
__device__ __forceinline__ unsigned xb_ld(unsigned* p)              { return __hip_atomic_load(p, __ATOMIC_RELAXED, __HIP_MEMORY_SCOPE_AGENT); }
__device__ __forceinline__ unsigned xb_add(unsigned* p, unsigned v) { return __hip_atomic_fetch_add(p, v, __ATOMIC_RELAXED, __HIP_MEMORY_SCOPE_AGENT); }
__device__ __forceinline__ unsigned xb_xcc_id() { return (unsigned)__builtin_amdgcn_s_getreg((3 << 11) | 20) & 0xFu; }
#define XB_SPIN(cond, bar) do { unsigned _sp = 0; while (cond) { __builtin_amdgcn_s_sleep(1); \
    if ((++_sp & 255u) == 0u) { if (xb_ld(&(bar)[XB_TMO])) break; if (_sp > XB_SPIN_CAP) { atomicAdd(&(bar)[XB_TMO], 1u); break; } } } } while (0)
struct XcdBarrier { unsigned* bar; unsigned x; volatile LAS unsigned* st; };
__device__ __forceinline__ XcdBarrier xcd_barrier_post(unsigned* bar, volatile LAS unsigned* st) {
    XcdBarrier b; b.bar = bar; b.x = xb_xcc_id(); b.st = st;
    if (threadIdx.x == 0) (void)xb_add(&bar[XB_XCNT(b.x)], 1u);
    return b;
}
__device__ __forceinline__ void xcd_barrier_complete(unsigned* bar, unsigned x, unsigned& nloc, unsigned& nx) {
    const unsigned G = gridDim.x * gridDim.y * gridDim.z;
    unsigned sum, cnt, mine, sp = 0u;
    for (;;) {
        sum = 0u; cnt = 0u; mine = 0u;
#pragma unroll
        for (unsigned j = 0; j < 16; ++j) { const unsigned c = xb_ld(&bar[XB_XCNT(j)]); sum += c; cnt += (c > 0u) ? 1u : 0u; mine = (j == x) ? c : mine; }
        if (sum == G) break;
        __builtin_amdgcn_s_sleep(1);
        if ((++sp & 255u) == 0u) { if (xb_ld(&bar[XB_TMO])) break; if (sp > XB_SPIN_CAP) { atomicAdd(&bar[XB_TMO], 1u); break; } }
    }
    nloc = mine > 0u ? mine : 1u; nx = cnt > 0u ? cnt : 1u;
}
__device__ __forceinline__ void xcd_barrier(const XcdBarrier& b) {
    asm volatile("s_waitcnt vmcnt(0)" ::: "memory");
    __syncthreads();
    if (threadIdx.x == 0) {
        unsigned* bar = b.bar;
        __builtin_amdgcn_s_waitcnt(0);
        unsigned nloc = b.st[0], nx = b.st[1];
        if (nloc == 0u) { xcd_barrier_complete(bar, b.x, nloc, nx); b.st[0] = nloc; b.st[1] = nx; }
        const unsigned old = xb_add(&bar[XB_XSUB(b.x)], 1u);
        const unsigned gen = old / nloc;
        if (old + 1u == (gen + 1u) * nloc) {
            __builtin_amdgcn_fence(__ATOMIC_RELEASE, "agent");
            asm volatile("s_waitcnt vmcnt(0)" ::: "memory");
            const unsigned og = xb_add(&bar[XB_TOP], 1u);
            const unsigned tg = og / nx;
            if (og + 1u == (tg + 1u) * nx) xb_add(&bar[XB_TOPGEN], 1u);
            else XB_SPIN(xb_ld(&bar[XB_TOPGEN]) == tg, bar);
            __builtin_amdgcn_fence(__ATOMIC_ACQUIRE, "agent");
            xb_add(&bar[XB_XGEN(b.x)], 1u);
            asm volatile("s_waitcnt vmcnt(0)" ::: "memory");
        } else {
            XB_SPIN(xb_ld(&bar[XB_XGEN(b.x)]) == gen, bar);
            __builtin_amdgcn_fence(__ATOMIC_ACQUIRE, "agent");
            asm volatile("s_waitcnt vmcnt(0)" ::: "memory");
        }
    }
    __syncthreads();
}

namespace pg8 {
constexpr int BM = 256, BK = 64, HALF = 128, HTB = HALF * BK * 2, STAGE_BYTES = 8 * HTB, NXCD = 8, WGM = 8, KD = 1024;
__host__ __device__ __forceinline__ int lds_byte(int r, int c) { const int st = (r >> 4) * 2 + (c >> 5), rr = r & 15, cc = c & 31, ob = rr * 64 + cc * 2; return st * 1024 + (ob ^ (((ob >> 9) & 1) << 5)); }
__host__ __device__ __forceinline__ void stage_rc(int b, int& R, int& C) { const int st = b / 1024, sb = b % 1024, swz = sb ^ (((sb >> 9) & 1) << 5); R = (st >> 1) * 16 + swz / 64; C = (st & 1) * 32 + (swz % 64) / 2; }
__host__ __device__ __forceinline__ int perm32(int rho) { const int n = rho >> 4, i = rho & 15; return 8 * (i >> 2) + 4 * n + (i & 3); }

struct Unit { const char* a; const char* b; int i0, i1, i2, i3; };
template <int M> struct Frag { bf16x8 v[2]; };
template <> struct Frag<2> { v8i w; };

__device__ __forceinline__ bool tile_order(int i, int G, int c, int nM, int nN, int& pm, int& pn) {
    const int nwg = nM * nN; const long L = (long)i * G + c; if (L >= nwg) return false;
    int wgid = (int)L; { const int q = nwg / NXCD, r = nwg % NXCD, xcd = wgid % NXCD, off = wgid / NXCD; wgid = (xcd < r ? xcd * (q + 1) : r * (q + 1) + (xcd - r) * q) + off; }
    const int nig = WGM * nN, gid = wgid / nig, fm = gid * WGM, gsz = (nM - fm) < WGM ? (nM - fm) : WGM;
    pm = fm + ((wgid % nig) % gsz); pn = (wgid % nig) / gsz; return true;
}

template <class Epi, class Sched, bool ALIGN_EPI, bool SP2>
__device__ __forceinline__ void gemm_phase(LAS unsigned char* lds, const size_t hstepB, const Sched& S, const Epi& E) {
    typedef typename Epi::ACC ACC; constexpr int MODE = Epi::MODE;
    const int tid = threadIdx.x, wid = __builtin_amdgcn_readfirstlane(tid >> 6), lane = tid & 63, wr = wid >> 2, wc = wid & 3, fr = lane & 15, fq = lane >> 4;
    constexpr int ROWB = (MODE == 0) ? KD * 2 : KD;
    constexpr int nt = ROWB / 128;
    constexpr bool GATHER = Sched::GATHER;
    unsigned voffA[2], voffB[2]; int Rst[2], Cst[2];
#pragma unroll
    for (int i = 0; i < 2; ++i) { int R, C; stage_rc(tid * 16 + i * 8192, R, C); const int Rb = Epi::brow(R); Rst[i] = R; Cst[i] = C;
        voffA[i] = (unsigned)(R * ROWB + C * 2); voffB[i] = (unsigned)(Rb * ROWB + C * 2); }
    unsigned gc[4] = {0u, 0u, 0u, 0u}, gn[4] = {0u, 0u, 0u, 0u};
    const size_t kstep = (size_t)(BK * 2);
    const size_t hstepA = (size_t)HALF * ROWB;
    const unsigned ldsw = (unsigned)wid * 1024u;
    const int aoff = lds_byte(wr * 64 + fr, fq * 8), boff = lds_byte(wc * 32 + fr, fq * 8);
#define PG8_SA(b, h) (((b) * 2 + (h)) * HTB)
#define PG8_SB(b, h) ((4 + (b) * 2 + (h)) * HTB)
#define PG8_STAGE(bufoff, gbase, voff) do { _Pragma("unroll") for (int _i = 0; _i < 2; ++_i) \
        __builtin_amdgcn_global_load_lds((const unsigned*)((const char*)(gbase) + (voff)[_i]), (LAS unsigned*)(lds + (bufoff) + ldsw + _i * 8192), 16, 0, 0); } while (0)
#define PG8_STAGE4(bufoff, gbase, o0, o1) do { \
        __builtin_amdgcn_global_load_lds((const unsigned*)((const char*)(gbase) + (o0)), (LAS unsigned*)(lds + (bufoff) + ldsw), 16, 0, 0); \
        __builtin_amdgcn_global_load_lds((const unsigned*)((const char*)(gbase) + (o1)), (LAS unsigned*)(lds + (bufoff) + ldsw + 8192), 16, 0, 0); } while (0)
#define PG8_STAGEA(bufoff, p, h, g) do { if constexpr (GATHER) PG8_STAGE4(bufoff, p, (g)[2 * (h)], (g)[2 * (h) + 1]); else PG8_STAGE4(bufoff, (p) + (h) * hstepA, voffA[0], voffA[1]); } while (0)
#define PG8_LDA(dst, b, h) do { _Pragma("unroll") for (int m = 0; m < 4; ++m) { if constexpr (MODE == 2) { dst[m].w.lo = *(const LAS v4i*)(lds + PG8_SA(b, h) + aoff + m * 2048); dst[m].w.hi = *(const LAS v4i*)(lds + PG8_SA(b, h) + aoff + m * 2048 + 1024); } \
        else { dst[m].v[0] = *(const LAS bf16x8*)(lds + PG8_SA(b, h) + aoff + m * 2048); dst[m].v[1] = *(const LAS bf16x8*)(lds + PG8_SA(b, h) + aoff + m * 2048 + 1024); } } } while (0)
#define PG8_LDB(dst, b, h) do { _Pragma("unroll") for (int n = 0; n < 2; ++n) { if constexpr (MODE == 2) { dst[n].w.lo = *(const LAS v4i*)(lds + PG8_SB(b, h) + boff + n * 2048); dst[n].w.hi = *(const LAS v4i*)(lds + PG8_SB(b, h) + boff + n * 2048 + 1024); } \
        else { dst[n].v[0] = *(const LAS bf16x8*)(lds + PG8_SB(b, h) + boff + n * 2048); dst[n].v[1] = *(const LAS bf16x8*)(lds + PG8_SB(b, h) + boff + n * 2048 + 1024); } } } while (0)
#define PG8_MMA(ai, bj, At, Bt) do { __builtin_amdgcn_s_setprio(1); _Pragma("unroll") for (int m = 0; m < 4; ++m) _Pragma("unroll") for (int n = 0; n < 2; ++n) { \
        if constexpr (MODE == 0) { _Pragma("unroll") for (int k = 0; k < 2; ++k) acc[ai][bj][m][n] = __builtin_amdgcn_mfma_f32_16x16x32_bf16(Bt[n].v[k], At[m].v[k], acc[ai][bj][m][n], 0, 0, 0); } \
        else if constexpr (MODE == 1) { _Pragma("unroll") for (int k = 0; k < 2; ++k) acc[ai][bj][m][n] = __builtin_amdgcn_mfma_i32_16x16x64_i8(__builtin_bit_cast(v4i, Bt[n].v[k]), __builtin_bit_cast(v4i, At[m].v[k]), acc[ai][bj][m][n], 0, 0, 0); } \
        else { acc[ai][bj][m][n] = __builtin_amdgcn_mfma_scale_f32_16x16x128_f8f6f4(Bt[n].w, At[m].w, acc[ai][bj][m][n], 0, 0, 0, 0x7f7f7f7f, 0, 0x7f7f7f7f); } \
        } __builtin_amdgcn_s_setprio(0); } while (0)
#define PG8_WAIT_V(n) asm volatile("s_waitcnt vmcnt(" #n ")" ::: "memory")
#define PG8_WAIT_L(n) asm volatile("s_waitcnt lgkmcnt(" #n ")" ::: "memory")
#define PG8_BAR __builtin_amdgcn_s_barrier()
#define PG8_SCHED __builtin_amdgcn_sched_barrier(0)
    Unit cur, nxt, nn; int ui = 0;
    if (!S.next(0, cur)) return;
    bool has_next = S.next(1, nxt);
    if constexpr (GATHER) {
#pragma unroll
        for (int h = 0; h < 2; ++h)
#pragma unroll
            for (int i = 0; i < 2; ++i) { gc[2 * h + i] = (unsigned)S.row_src(cur, h * HALF + Rst[i]) * (unsigned)ROWB + (unsigned)(Cst[i] * 2);
                                          gn[2 * h + i] = has_next ? (unsigned)S.row_src(nxt, h * HALF + Rst[i]) * (unsigned)ROWB + (unsigned)(Cst[i] * 2) : 0u; }
    }
    ACC acc[2][2][4][2];
#pragma unroll
    for (int a = 0; a < 2; ++a)
#pragma unroll
        for (int b = 0; b < 2; ++b)
#pragma unroll
            for (int m = 0; m < 4; ++m)
#pragma unroll
                for (int n = 0; n < 2; ++n) acc[a][b][m][n] = (ACC){0, 0, 0, 0};
    Frag<MODE> At[4], B0[2], B1[2];
    const char* cA = cur.a; const char* cB = cur.b;
    if constexpr (SP2) {
        PG8_STAGE(PG8_SB(0, 0), cB, voffB); PG8_STAGE(PG8_SB(0, 1), cB + hstepB, voffB); PG8_STAGEA(PG8_SA(0, 0), cA, 0, gc); PG8_STAGEA(PG8_SA(0, 1), cA, 1, gc);
        if (wr == 1) PG8_BAR;
        PG8_WAIT_V(2); PG8_BAR;
        PG8_STAGE(PG8_SB(1, 0), cB + kstep, voffB); PG8_STAGEA(PG8_SA(1, 0), cA + kstep, 0, gc); PG8_STAGE(PG8_SB(1, 1), cB + hstepB + kstep, voffB);
        PG8_WAIT_V(6); PG8_BAR;
    } else {
        PG8_STAGE(PG8_SB(0, 0), cB, voffB); PG8_STAGEA(PG8_SA(0, 0), cA, 0, gc); PG8_STAGE(PG8_SB(0, 1), cB + hstepB, voffB); PG8_STAGEA(PG8_SA(0, 1), cA, 1, gc);
        if (wr == 1) PG8_BAR;
        PG8_WAIT_V(4); PG8_BAR;
        PG8_STAGE(PG8_SB(1, 0), cB + kstep, voffB); PG8_STAGEA(PG8_SA(1, 0), cA + kstep, 0, gc); PG8_STAGE(PG8_SB(1, 1), cB + hstepB + kstep, voffB);
        PG8_WAIT_V(6); PG8_BAR;
    }
    for (;;) {
        const char* nA = has_next ? nxt.a : cA; const char* nB = has_next ? nxt.b : cB;
        for (int t = 0; t < nt; t += 2) {
            const bool last = (t == nt - 2);
            const char* a1 = cA + (size_t)(t + 1) * kstep;
            const char* a2 = last ? nA : cA + (size_t)(t + 2) * kstep; const char* b2 = last ? nB : cB + (size_t)(t + 2) * kstep;
            const char* a3 = a2 + kstep; const char* b3 = b2 + kstep;
            unsigned g2[4];
#pragma unroll
            for (int i = 0; i < 4; ++i) g2[i] = (last && has_next) ? gn[i] : gc[i];
            if constexpr (SP2) {
            PG8_LDB(B0, 0, 0); PG8_LDB(B1, 0, 1); PG8_SCHED; PG8_LDA(At, 0, 0); PG8_STAGEA(PG8_SA(1, 1), a1, 1, gc);
            PG8_WAIT_V(8); PG8_WAIT_L(0); PG8_BAR; PG8_MMA(0, 0, At, B0); PG8_MMA(0, 1, At, B1); PG8_BAR; PG8_SCHED;
            PG8_LDA(At, 0, 1); PG8_STAGE(PG8_SB(0, 0), b2, voffB); PG8_STAGE(PG8_SB(0, 1), b2 + hstepB, voffB); PG8_STAGEA(PG8_SA(0, 0), a2, 0, g2);
            PG8_WAIT_V(8); PG8_WAIT_L(0); PG8_BAR; PG8_MMA(1, 0, At, B0); PG8_MMA(1, 1, At, B1); PG8_BAR; PG8_SCHED;
            PG8_LDB(B0, 1, 0); PG8_LDB(B1, 1, 1); PG8_SCHED; PG8_LDA(At, 1, 0); PG8_STAGEA(PG8_SA(0, 1), a2, 1, g2);
            PG8_WAIT_V(8); PG8_WAIT_L(0); PG8_BAR; PG8_MMA(0, 0, At, B0); PG8_MMA(0, 1, At, B1); PG8_BAR; PG8_SCHED;
            PG8_LDA(At, 1, 1); PG8_STAGE(PG8_SB(1, 0), b3, voffB); PG8_STAGE(PG8_SB(1, 1), b3 + hstepB, voffB); PG8_STAGEA(PG8_SA(1, 0), a3, 0, g2);
            PG8_WAIT_V(8); PG8_WAIT_L(0); PG8_BAR; PG8_MMA(1, 0, At, B0); PG8_MMA(1, 1, At, B1); PG8_BAR; PG8_SCHED;
            } else {
            PG8_LDB(B0, 0, 0); PG8_SCHED; PG8_LDA(At, 0, 0); PG8_STAGEA(PG8_SA(1, 1), a1, 1, gc);
            PG8_WAIT_L(8); PG8_BAR; PG8_WAIT_L(0); PG8_MMA(0, 0, At, B0); PG8_BAR; PG8_SCHED;
            PG8_LDB(B1, 0, 1); PG8_STAGE(PG8_SB(0, 0), b2, voffB);
            PG8_BAR; PG8_WAIT_L(0); PG8_MMA(0, 1, At, B1); PG8_BAR;
            PG8_LDA(At, 0, 1); PG8_STAGEA(PG8_SA(0, 0), a2, 0, g2);
            PG8_BAR; PG8_WAIT_L(0); PG8_MMA(1, 0, At, B0); PG8_BAR; PG8_SCHED;
            PG8_STAGE(PG8_SB(0, 1), b2 + hstepB, voffB);
            PG8_WAIT_V(6); PG8_BAR; PG8_MMA(1, 1, At, B1); PG8_BAR;
            PG8_LDB(B0, 1, 0); PG8_SCHED; PG8_LDA(At, 1, 0); PG8_STAGEA(PG8_SA(0, 1), a2, 1, g2);
            PG8_WAIT_L(8); PG8_BAR; PG8_WAIT_L(0); PG8_MMA(0, 0, At, B0); PG8_BAR; PG8_SCHED;
            PG8_LDB(B1, 1, 1); PG8_STAGE(PG8_SB(1, 0), b3, voffB);
            PG8_BAR; PG8_WAIT_L(0); PG8_MMA(0, 1, At, B1); PG8_BAR;
            PG8_LDA(At, 1, 1); PG8_STAGEA(PG8_SA(1, 0), a3, 0, g2);
            PG8_BAR; PG8_WAIT_L(0); PG8_MMA(1, 0, At, B0); PG8_BAR; PG8_SCHED;
            PG8_STAGE(PG8_SB(1, 1), b3 + hstepB, voffB);
            PG8_WAIT_V(6); PG8_BAR; PG8_MMA(1, 1, At, B1); PG8_BAR;
            }
        }
        if constexpr (ALIGN_EPI) { if (wr == 0) PG8_BAR; }
        const bool has_nn = has_next && S.next(ui + 2, nn);
        unsigned g3[4] = {0u, 0u, 0u, 0u};
        if constexpr (GATHER) { if (has_nn) {
#pragma unroll
            for (int h = 0; h < 2; ++h)
#pragma unroll
                for (int i = 0; i < 2; ++i) g3[2 * h + i] = (unsigned)S.row_src(nn, h * HALF + Rst[i]) * (unsigned)ROWB + (unsigned)(Cst[i] * 2); } }
        E(acc, cur, wr, wc, fr, fq);
        if constexpr (GATHER) asm volatile("" : "+v"(g3[0]), "+v"(g3[1]), "+v"(g3[2]), "+v"(g3[3]));
        if (!has_next) break;
#pragma unroll
        for (int a = 0; a < 2; ++a)
#pragma unroll
            for (int b = 0; b < 2; ++b)
#pragma unroll
                for (int m = 0; m < 4; ++m)
#pragma unroll
                    for (int n = 0; n < 2; ++n) acc[a][b][m][n] = (ACC){0, 0, 0, 0};
#pragma unroll
        for (int i = 0; i < 4; ++i) { gc[i] = gn[i]; gn[i] = g3[i]; }
        cur = nxt; cA = nA; cB = nB; ++ui; nxt = nn; has_next = has_nn;
        if constexpr (ALIGN_EPI) { if (wr == 1) PG8_BAR; }
    }
    PG8_WAIT_V(0);
    if constexpr (!ALIGN_EPI) { if (wr == 0) PG8_BAR; }
    PG8_BAR;
#undef PG8_SA
#undef PG8_SB
#undef PG8_STAGE
#undef PG8_STAGE4
#undef PG8_STAGEA
#undef PG8_LDA
#undef PG8_LDB
#undef PG8_MMA
#undef PG8_WAIT_V
#undef PG8_WAIT_L
#undef PG8_BAR
#undef PG8_SCHED
}
}

struct Args { const float* in[16]; float* out; unsigned char* ws; int ph_lo, ph_hi; int never, pad; };
struct Frame {
    LAS unsigned char* lds;
    gu32* ctl;
    int tid, lane, wave, G;
    const float *x, *norm_mix_g, *norm_ffn_g, *pool_w, *pool_scale, *w_qkv, *q_gain, *k_gain, *w_o, *rel_bias, *w_router, *b_router, *w_gu, *b_gu, *w_dn, *b_dn;
    float* out; unsigned char* ws;
};

__device__ __forceinline__ void transpose_item(const float* W, int K, int N, bf16* WT, LAS float* scr, int item, int lane) {
    const int nblk = N / 32, kb = item / nblk, nb = item % nblk, k0 = 64 * kb, n0 = 32 * nb;
#pragma unroll 8
    for (int i = 0; i < 32; ++i) { const int kk = 2 * i + (lane >> 5); scr[kk * 33 + (lane & 31)] = W[(size_t)(k0 + kk) * N + n0 + (lane & 31)]; }
    LDS_WAIT(); asm volatile("" ::: "memory");
    const int c = lane & 7;
#pragma unroll
    for (int j = 0; j < 4; ++j) { const int n = (lane >> 3) + 8 * j; const LAS float* s = scr + (8 * c) * 33 + n;
        u32x4 o; o.x = pk2(s[0 * 33], s[1 * 33]); o.y = pk2(s[2 * 33], s[3 * 33]); o.z = pk2(s[4 * 33], s[5 * 33]); o.w = pk2(s[6 * 33], s[7 * 33]);
        *(GAS u32x4*)(WT + (size_t)(n0 + n) * K + k0 + 8 * c) = o; }
    LDS_WAIT(); asm volatile("" ::: "memory");
}
__device__ __forceinline__ int slab_pos(int k, int n) { return k * 32 + ((n + (k >> 4) + (k & 3)) & 31); }
__device__ __forceinline__ void slab_load(const float* W, int N, int n0, int tid, f32x4 (&v)[16]) {
#pragma unroll
    for (int j = 0; j < 16; ++j) { const int i = tid + j * NTHREADS, k = i >> 3, c4 = i & 7; v[j] = __builtin_nontemporal_load((const GAS f32x4*)(W + (size_t)k * N + n0 + c4 * 4)); }
}
template <int FMT>
__device__ __forceinline__ void slab_store_lds(Frame& F, const f32x4 (&v)[16]) {
    LAS float* S = (LAS float*)F.lds;
#pragma unroll
    for (int j = 0; j < 16; ++j) { const int i = F.tid + j * NTHREADS, k = i >> 3, c4 = i & 7;
        S[slab_pos(k, c4 * 4 + 0)] = v[j].x; S[slab_pos(k, c4 * 4 + 1)] = v[j].y; S[slab_pos(k, c4 * 4 + 2)] = v[j].z; S[slab_pos(k, c4 * 4 + 3)] = v[j].w; }
}
template <int FMT>
__device__ __forceinline__ void slab_process(Frame& F, int n0, unsigned char* Q, float* SC) {
    LAS float* S = (LAS float*)F.lds;
    LAS float* red = (LAS float*)(F.lds + L_SLOTE);
    LAS float* scl = (LAS float*)(F.lds + L_HIST);
    const int tid = F.tid;
    { const int n = tid & 31, part = tid >> 5; float am = 0.f;
#pragma unroll 8
      for (int kk = 0; kk < 64; ++kk) am = fmaxf(am, fabsf(S[slab_pos(part * 64 + kk, n)]));
      am = fmaxf(am, __shfl_xor(am, 32));
      if (F.lane < 32) red[F.wave * 32 + n] = am; }
    __syncthreads();
    if (tid < 32) { float am = 0.f;
#pragma unroll
        for (int w = 0; w < 8; ++w) am = fmaxf(am, red[w * 32 + tid]);
        float qs, inv;
        if (FMT == 1) { qs = am > 0.f ? 127.f / am : 0.f; inv = am * (1.f / 127.f); }
        else { int ex = 0; (void)frexpf(am > 0.f ? am : 1.f, &ex); qs = ldexpf(1.f, 7 - ex); inv = ldexpf(1.f, ex - 7); }
        scl[tid] = qs; SC[n0 + tid] = inv; }
    __syncthreads();
#pragma unroll
    for (int it = 0; it < 4; ++it) {
        const int n = (tid >> 6) + 8 * it, c = tid & 63; const float qs = scl[n];
        float v[16];
#pragma unroll
        for (int i = 0; i < 16; ++i) v[i] = S[slab_pos(16 * c + i, n)] * qs;
        u32x4 o;
        if (FMT == 1) {
#pragma unroll
            for (int d = 0; d < 4; ++d) { const int q0 = (int)rintf(v[4 * d]), q1 = (int)rintf(v[4 * d + 1]), q2 = (int)rintf(v[4 * d + 2]), q3 = (int)rintf(v[4 * d + 3]);
                o[d] = (unsigned)(q0 & 255) | ((unsigned)(q1 & 255) << 8) | ((unsigned)(q2 & 255) << 16) | ((unsigned)q3 << 24); }
        } else {
#pragma unroll
            for (int d = 0; d < 4; ++d) { int w = __builtin_amdgcn_cvt_pk_fp8_f32(v[4 * d], v[4 * d + 1], 0, false); w = __builtin_amdgcn_cvt_pk_fp8_f32(v[4 * d + 2], v[4 * d + 3], w, true); o[d] = (unsigned)w; }
        }
        *(GAS u32x4*)(Q + (size_t)(n0 + n) * 1024 + 16 * c) = o;
    }
    __syncthreads();
}
struct SlabDesc { const float* W; int N, n0; unsigned char* Q; float* SC; };
__device__ __forceinline__ SlabDesc slab_desc(Frame& F, int sl) {
    constexpr int S_GU = 64 * 64;
    SlabDesc d;
    if (sl < S_GU) { const int mat = sl >> 6; d.W = F.w_gu + (size_t)mat * 1024 * 2048; d.N = 2048; d.n0 = (sl & 63) * 32; d.Q = F.ws + WS_WGU + (size_t)mat * 2048 * 1024; d.SC = (float*)(F.ws + WS_SC_GU) + mat * 2048; }
    else { d.W = F.w_qkv; d.N = NQKV; d.n0 = (sl - S_GU) * 32; d.Q = F.ws + WS_WQKV; d.SC = (float*)(F.ws + WS_SC_QKV); }
    return d;
}
__device__ __forceinline__ void phase_convert(Frame& F) {
    constexpr int NSLAB = 64 * 64 + 288;
    {
        f32x4 v[16];
        int sl = blockIdx.x;
        if (sl < NSLAB) { const SlabDesc d = slab_desc(F, sl); slab_load(d.W, d.N, d.n0, F.tid, v); }
        for (; sl < NSLAB; sl += F.G) {
            const SlabDesc d = slab_desc(F, sl);
            slab_store_lds<1>(F, v);
            __syncthreads();
            if (sl + F.G < NSLAB) { const SlabDesc dn = slab_desc(F, sl + F.G); slab_load(dn.W, dn.N, dn.n0, F.tid, v); }
            slab_process<1>(F, d.n0, d.Q, d.SC);
        }
    }
    LAS float* scr = (LAS float*)(F.lds + F.wave * 16384);
    const int gw = blockIdx.x * NWAVES + F.wave, NGW = F.G * NWAVES;
    constexpr int I_DN = 64 * 512, I_WO = 512, I_POOL = 4 * 32;
    constexpr int NITEMS = I_DN + I_WO + I_POOL;
    for (int it = gw; it < NITEMS; it += NGW) {
        int r = it;
        if (r < I_DN) { const int mat = r >> 9; transpose_item(F.w_dn + (size_t)mat * 1024 * 1024, 1024, 1024, (bf16*)(F.ws + WS_WDN) + (size_t)mat * 1024 * 1024, scr, r & 511, F.lane); continue; } r -= I_DN;
        if (r < I_WO) { transpose_item(F.w_o, 1024, 1024, (bf16*)(F.ws + WS_WO), scr, r, F.lane); continue; } r -= I_WO;
        { const int mat = r >> 5; transpose_item(F.pool_w + (size_t)mat * 65536, 256, 256, (bf16*)(F.ws + WS_WPOOL) + (size_t)mat * 65536, scr, r & 31, F.lane); }
    }
    float* wrt = (float*)(F.ws + WS_WRT);
    for (int i = blockIdx.x * NTHREADS + F.tid; i < 2 * 32 * 1024; i += F.G * NTHREADS) wrt[i] = F.w_router[i] * F.norm_ffn_g[i >> 5];
}

__device__ __forceinline__ void quant_row_i8(const f32x4 (&h)[4], unsigned (&w)[4], float& inv) {
    float am = 0.f;
#pragma unroll
    for (int j = 0; j < 4; ++j) am = fmaxf(fmaxf(am, fmaxf(fabsf(h[j].x), fabsf(h[j].y))), fmaxf(fabsf(h[j].z), fabsf(h[j].w)));
#pragma unroll
    for (int o = 1; o < 64; o <<= 1) am = fmaxf(am, __shfl_xor(am, o));
    const float qs = am > 0.f ? 127.f / am : 0.f; inv = am * (1.f / 127.f);
#pragma unroll
    for (int j = 0; j < 4; ++j) { const int q0 = (int)rintf(h[j].x * qs), q1 = (int)rintf(h[j].y * qs), q2 = (int)rintf(h[j].z * qs), q3 = (int)rintf(h[j].w * qs);
        w[j] = (unsigned)(q0 & 255) | ((unsigned)(q1 & 255) << 8) | ((unsigned)(q2 & 255) << 16) | ((unsigned)q3 << 24); }
}

__device__ __forceinline__ void router_tile(Frame& F, int layer, int tok0, bool dry) {
    LAS int* hist = (LAS int*)(F.lds + L_HIST); LAS int* base = (LAS int*)(F.lds + L_BASE);
    LAS int* slot_e = (LAS int*)(F.lds + L_SLOTE); LAS int* slot_p = (LAS int*)(F.lds + L_SLOTP); LAS float* slot_g = (LAS float*)(F.lds + L_SLOTG);
    LAS float* rstdL = (LAS float*)(F.lds + L_RSTD);
    LAS float* part = (LAS float*)F.lds;
    const int lane = F.lane, wave = F.wave;
    if (F.tid < 32) hist[F.tid] = 0;
    const float* g2 = F.norm_ffn_g + layer * 1024;
    unsigned char* H2 = F.ws + WS_H2; float* HS = (float*)(F.ws + WS_HS);
    {
        f32x4 gv[4];
#pragma unroll
        for (int j = 0; j < 4; ++j) gv[j] = *(const f32x4*)(g2 + lane * 4 + 256 * j);
#pragma unroll 1
        for (int half = 0; half < 2; ++half) {
            f32x4 h[4][4];
#pragma unroll
            for (int r = 0; r < 4; ++r) { const GAS f32x4* xr = (const GAS f32x4*)(F.out + (size_t)(tok0 + wave * 8 + half * 4 + r) * 1024) + lane;
#pragma unroll
                for (int j = 0; j < 4; ++j) h[r][j] = xr[64 * j]; }
#pragma unroll
            for (int r = 0; r < 4; ++r) {
                const int row = wave * 8 + half * 4 + r, tok = tok0 + row;
                float ss = 0.f;
#pragma unroll
                for (int j = 0; j < 4; ++j) ss += (h[r][j].x * h[r][j].x + h[r][j].y * h[r][j].y) + (h[r][j].z * h[r][j].z + h[r][j].w * h[r][j].w);
                const float rstd = rsqrtf(wave_sum(ss) * (1.f / 1024.f) + EPS);
#pragma unroll
                for (int j = 0; j < 4; ++j) h[r][j] = h[r][j] * rstd * gv[j];
                unsigned qw[4]; float inv; quant_row_i8(h[r], qw, inv);
                GAS unsigned* o4 = (GAS unsigned*)(H2 + (size_t)tok * 1024) + lane;
#pragma unroll
                for (int j = 0; j < 4; ++j) o4[64 * j] = qw[j];
                if (lane == 0) { HS[tok] = inv; rstdL[row] = rstd; }
            }
        }
    }
    {
        __syncthreads();
        const float* wrg = (const float*)(F.ws + WS_WRT) + (size_t)layer * 32 * 1024;
        LAS float* img = (LAS float*)(F.lds) + wave * (32 * 128);
        const int r = lane & 31, kh = lane >> 5;
        const GAS float* wb = (const GAS float*)(wrg + (size_t)(128 * wave + kh) * 32 + r);
        f32x16 acc0, acc1;
#pragma unroll
        for (int i = 0; i < 16; ++i) { acc0[i] = 0.f; acc1[i] = 0.f; }
#define ROUTER_HALF(half, ACC_) do { \
            f32x4 ld[16]; \
            _Pragma("unroll") for (int j = 0; j < 16; ++j) ld[j] = *((const GAS f32x4*)(F.out + (size_t)(tok0 + (half) * 32 + 2 * j + kh) * 1024 + 128 * wave) + r); \
            _Pragma("unroll") for (int j = 0; j < 16; ++j) *(LAS f32x4*)(img + (2 * j + kh) * 128 + 4 * ((r + 2 * j + kh) & 31)) = ld[j]; \
            _Pragma("unroll 4") for (int s4 = 0; s4 < 32; ++s4) { \
                const LAS float* ap = img + r * 128 + 4 * ((s4 + r) & 31); \
                const f32x2 a01 = *(const LAS f32x2*)(ap), a23 = *(const LAS f32x2*)(ap + 2); \
                const float b0 = wb[(2 * s4) * 64], b1 = wb[(2 * s4 + 1) * 64]; \
                ACC_ = __builtin_amdgcn_mfma_f32_32x32x2f32(kh ? a01.y : a01.x, b0, ACC_, 0, 0, 0); ACC_ = __builtin_amdgcn_mfma_f32_32x32x2f32(kh ? a23.y : a23.x, b1, ACC_, 0, 0, 0); } } while (0)
        ROUTER_HALF(0, acc0);
        ROUTER_HALF(1, acc1);
#undef ROUTER_HALF
        __syncthreads();
#pragma unroll
        for (int rg = 0; rg < 16; ++rg) { const int row = (rg & 3) + 8 * (rg >> 2) + 4 * kh;
            part[(wave * 64 + row) * 32 + r] = acc0[rg]; part[(wave * 64 + 32 + row) * 32 + r] = acc1[rg]; }
    }
    __syncthreads();
    {
        const int e = lane & 31, kh = lane >> 5;
        const float brl = F.b_router[layer * 32 + e];
#pragma unroll 1
        for (int rr = 0; rr < 4; ++rr) {
            const int row = wave * 8 + rr + 4 * kh;
            float v = 0.f;
#pragma unroll
            for (int w = 0; w < 8; ++w) v += part[(w * 64 + row) * 32 + e];
            v = v * rstdL[row] + brl;
            float tv[4]; int ti[4];
#pragma unroll
            for (int k = 0; k < 4; ++k) {
                float bv = v; int bi = e;
#pragma unroll
                for (int off = 16; off >= 1; off >>= 1) { const float ov = __shfl_xor(bv, off); const int oi = __shfl_xor(bi, off); if (ov > bv || (ov == bv && oi < bi)) { bv = ov; bi = oi; } }
                tv[k] = bv; ti[k] = bi; if (e == bi) v = -INFINITY;
            }
            const float e1 = __expf(tv[1] - tv[0]), e2 = __expf(tv[2] - tv[0]), e3 = __expf(tv[3] - tv[0]);
            const float inv = 1.f / (1.f + e1 + e2 + e3);
            if (e < 4) {
                const int ex = e == 0 ? ti[0] : e == 1 ? ti[1] : e == 2 ? ti[2] : ti[3];
                const float gt = (e == 0 ? 1.f : e == 1 ? e1 : e == 2 ? e2 : e3) * inv;
                const int lp = atomicAdd((int*)(hist + ex), 1);
                const int sl = row * 4 + e;
                slot_e[sl] = ex; slot_p[sl] = lp; slot_g[sl] = gt;
            }
        }
    }
    __syncthreads();
    if (dry) return;
    if (F.tid < 32) base[F.tid] = (int)__hip_atomic_fetch_add((unsigned*)(F.ctl + CW_CNT + layer * 32 + F.tid), (unsigned)hist[F.tid], RLX_AGENT);
    __syncthreads();
    if (F.tid < 256) {
        const int e = slot_e[F.tid]; const int pos = base[e] + slot_p[F.tid];
        ((int*)(F.ws + WS_ROWSLOT))[e * CAP + pos] = (tok0 + (F.tid >> 2)) * 4 + (F.tid & 3);
        ((float*)(F.ws + WS_ROWGATE))[e * CAP + pos] = slot_g[F.tid];
        ((float*)(F.ws + WS_ROWHS))[e * CAP + pos] = ((const float*)(F.ws + WS_HS))[tok0 + (F.tid >> 2)];
    }
    __syncthreads();
}

__device__ __forceinline__ int pswz(int r, int c) { return r * 2048 + ((((c >> 3) ^ (r & 7)) << 4) | ((c & 7) << 1)); }
template <int W>
__device__ __forceinline__ void pool_chunk(const f32x2 (&v)[8], int sc, int s0, const LAS float* rstd1, float gx, float gy, float (&rx)[W], float (&ry)[W], LAS unsigned char* P, int tid) {
#pragma unroll
    for (int j = 0; j < 8; ++j) {
        const int tl = sc * 8 + j; const float r = rstd1[16 + tl];
        const float hx = v[j].x * r * gx, hy = v[j].y * r * gy;
        constexpr int WM = W < 8 ? W : 8;
        if (W <= 8) { rx[j % WM] = hx; ry[j % WM] = hy; }
        else { if (sc & 1) { rx[(8 + j) % W] = hx; ry[(8 + j) % W] = hy; } else { rx[j % W] = hx; ry[j % W] = hy; } }
        float sx = 0.f, sy = 0.f;
#pragma unroll
        for (int q = 0; q < W; ++q) { sx += rx[q]; sy += ry[q]; }
        const int s = s0 + tl; const int cn = (s + 1 < W) ? (s + 1) : W; const float inv = 1.f / (float)cn;
        *(LAS unsigned*)(P + pswz(tl, 2 * tid)) = pk2(sx * inv - hx, sy * inv - hy);
    }
}
template <int W>
__device__ __forceinline__ void pool_window(const float* __restrict__ x, int tok0, int s0, const LAS float* rstd1, float gx, float gy, LAS unsigned char* P, int tid) {
    float rx[W], ry[W];
    const GAS f32x2* xp = (const GAS f32x2*)x + tid;
    const bool hist = s0 > 0;
    {
        const GAS f32x2* pw = xp + (size_t)(hist ? tok0 - W : tok0) * 512;
#pragma unroll
        for (int j = 0; j < W; ++j) { const f32x2 v = pw[(size_t)j * 512]; const float r = hist ? rstd1[16 - W + j] : 0.f; rx[j] = v.x * r * gx; ry[j] = v.y * r * gy; }
    }
    f32x2 va[8];
    { const GAS f32x2* p0 = xp + (size_t)tok0 * 512;
#pragma unroll
      for (int j = 0; j < 8; ++j) va[j] = p0[(size_t)j * 512]; }
#pragma unroll 2
    for (int sc = 0; sc < 8; ++sc) {
        f32x2 vb[8];
        const GAS f32x2* pn = xp + (size_t)(tok0 + 8 * (sc < 7 ? sc + 1 : 7)) * 512;
#pragma unroll
        for (int j = 0; j < 8; ++j) vb[j] = pn[(size_t)j * 512];
        pool_chunk<W>(va, sc, s0, rstd1, gx, gy, rx, ry, P, tid);
#pragma unroll
        for (int j = 0; j < 8; ++j) va[j] = vb[j];
    }
}
__device__ __forceinline__ void phase_pool(Frame& F, bool dry) {
    LAS unsigned char* P = F.lds;
    LAS float* rstd1 = (LAS float*)(F.lds + L_RSTD);
    const int lane = F.lane, wave = F.wave, tid = F.tid;
    const int fr = lane & 15, fq = lane >> 4;
    const float* __restrict__ xin = F.x; float* __restrict__ xo = F.out;
    for (int tile = blockIdx.x; tile < NTOK / 64; tile += F.G) {
        const int tok0 = tile * 64, s0 = tok0 & (SEQ - 1);
#pragma unroll 1
        for (int hb = 0; hb < 2; ++hb) {
            f32x4 v[5][4];
#pragma unroll
            for (int k = 0; k < 5; ++k) { const int rr = wave + 8 * (5 * hb + k); const bool ok = (s0 - 16 + rr) >= 0;
                const GAS f32x4* xr = (const GAS f32x4*)(xin + (size_t)(ok ? tok0 - 16 + rr : tok0) * 1024) + lane;
#pragma unroll
                for (int j = 0; j < 4; ++j) v[k][j] = xr[64 * j]; }
#pragma unroll
            for (int k = 0; k < 5; ++k) { const int rr = wave + 8 * (5 * hb + k); const bool ok = (s0 - 16 + rr) >= 0; float ss = 0.f;
#pragma unroll
                for (int j = 0; j < 4; ++j) ss += (v[k][j].x * v[k][j].x + v[k][j].y * v[k][j].y) + (v[k][j].z * v[k][j].z + v[k][j].w * v[k][j].w);
                const float r = rsqrtf(wave_sum(ss) * (1.f / 1024.f) + EPS);
                if (lane == 0) rstd1[rr] = ok ? r : 0.f; }
        }
        __syncthreads();
        { const float gx = F.norm_mix_g[2 * tid], gy = F.norm_mix_g[2 * tid + 1];
          const int grp = wave >> 1;
          if (grp == 0) pool_window<2>(xin, tok0, s0, rstd1, gx, gy, P, tid);
          else if (grp == 1) pool_window<4>(xin, tok0, s0, rstd1, gx, gy, P, tid);
          else if (grp == 2) pool_window<8>(xin, tok0, s0, rstd1, gx, gy, P, tid);
          else pool_window<16>(xin, tok0, s0, rstd1, gx, gy, P, tid); }
        __syncthreads();
        { const int gi = wave >> 1, nh = wave & 1;
#pragma unroll 1
          for (int np = 0; np < 2; ++np) {
              const bf16* Wt = (const bf16*)(F.ws + WS_WPOOL) + (size_t)gi * 65536 + (size_t)(nh * 128 + np * 64) * 256;
              f32x4 acc[4][4];
#pragma unroll
              for (int m = 0; m < 4; ++m)
#pragma unroll
                  for (int n = 0; n < 4; ++n) acc[m][n] = (f32x4){0.f, 0.f, 0.f, 0.f};
#pragma unroll 4
              for (int ks = 0; ks < 8; ++ks) {
                  bf16x8 a[4];
#pragma unroll
                  for (int m = 0; m < 4; ++m) a[m] = *(const LAS bf16x8*)(P + pswz(m * 16 + fr, gi * 256 + ks * 32 + fq * 8));
#pragma unroll
                  for (int n = 0; n < 4; ++n) {
                      const bf16x8 b = *(const GAS bf16x8*)(Wt + (size_t)(n * 16 + fr) * 256 + ks * 32 + fq * 8);
#pragma unroll
                      for (int m = 0; m < 4; ++m) acc[m][n] = __builtin_amdgcn_mfma_f32_16x16x32_bf16(b, a[m], acc[m][n], 0, 0, 0);
                  }
              }
              const int colb = gi * 256 + nh * 128 + np * 64 + fq * 4;
              f32x4 xv[4][4], sc[4];
#pragma unroll
              for (int n = 0; n < 4; ++n) { sc[n] = *(const f32x4*)(F.pool_scale + colb + n * 16);
#pragma unroll
                  for (int m = 0; m < 4; ++m) xv[n][m] = *(const GAS f32x4*)(xin + (size_t)(tok0 + m * 16 + fr) * 1024 + colb + n * 16); }
#pragma unroll
              for (int n = 0; n < 4; ++n)
#pragma unroll
                  for (int m = 0; m < 4; ++m) *(GAS f32x4*)(xo + (size_t)(tok0 + m * 16 + fr) * 1024 + colb + n * 16) = xv[n][m] + acc[m][n] * sc[n];
          }
        }
    }
    VM_WAIT();
    __syncthreads();
    for (int tile = blockIdx.x; tile < NTOK / 64; tile += F.G) router_tile(F, 0, tile * 64, dry);
}
__device__ __forceinline__ void phase_router(Frame& F, int layer, bool dry) {
    for (int tile = blockIdx.x; tile < NTOK / 64; tile += F.G) router_tile(F, layer, tile * 64, dry);
}

__device__ __forceinline__ void moe_tables(Frame& F, int layer) {
    LAS int* cntL = (LAS int*)(F.lds + L_CNT); LAS int* prow0 = (LAS int*)(F.lds + L_PROW0); LAS int* ntp = (LAS int*)(F.lds + L_NT);
    LAS int* tileE = (LAS int*)(F.lds + L_TILEE); LAS int* tileRow = (LAS int*)(F.lds + L_TILEROW);
    __syncthreads();
    if (F.tid < 64) {
        int c = 0;
        if (F.tid < 32) { c = (int)__hip_atomic_load((unsigned*)(F.ctl + CW_CNT + layer * 32 + F.tid), RLX_AGENT); if (c > CAP) c = CAP; }
        const int mt = (c + 255) >> 8;
        int incl = mt;
#pragma unroll
        for (int o = 1; o < 32; o <<= 1) { const int v = __shfl_up(incl, o); if ((F.tid & 63) >= o) incl += v; }
        const int excl = incl - mt;
        if (F.tid < 32) {
            cntL[F.tid] = c; prow0[F.tid] = excl * 256;
            for (int m = 0; m < mt; ++m) if (excl + m < MAXT) { tileE[excl + m] = F.tid; tileRow[excl + m] = (excl + m) * 256; }
            if (F.tid == 31) ntp[0] = incl < MAXT ? incl : MAXT;
        }
    }
    __syncthreads();
}

template <bool GATH>
struct MoeOrderT {
    static constexpr bool GATHER = GATH;
    int NT, nN, G, c; const LAS int* tileE; const LAS int* tileRow; const LAS int* cntL; const LAS int* prow0; const int* rowslot;
    const char* Abase; const char* Bbase; size_t bExp, bTile; int aPitch;
    __device__ __forceinline__ bool next(int i, pg8::Unit& u) const {
        int T, pn; if (!pg8::tile_order(i, G, c, NT, nN, T, pn)) return false;
        const int e = tileE[T], row0 = tileRow[T];
        u.a = GATH ? Abase : Abase + (size_t)row0 * aPitch; u.b = Bbase + (size_t)e * bExp + (size_t)pn * bTile; u.i0 = T; u.i1 = pn; u.i2 = e; u.i3 = row0; return true;
    }
    __device__ __forceinline__ int row_src(const pg8::Unit& u, int r) const {
        const int e = u.i2, cn = cntL[e]; int pos = u.i3 - prow0[e] + r; pos = pos < cn ? pos : cn - 1;
        return rowslot[e * CAP + pos] >> 2;
    }
};
struct EpiGU {
    typedef v4i ACC; static constexpr int MODE = 1;
    static __host__ __device__ __forceinline__ int brow(int R) { return (R & ~31) + pg8::perm32(R & 31); }
    bf16* ACT; const float* bgu; const float* wsc; const float* rowhs; const LAS int* prow0;
    __device__ __forceinline__ void operator()(const v4i (&acc)[2][2][4][2], const pg8::Unit& u, int wr, int wc, int fr, int fq) const {
        const int e = u.i2, f0 = u.i1 * 128 + wc * 32 + 8 * fq;
        const float* bg = bgu + (size_t)e * 2048 + f0; const float* sp = wsc + (size_t)e * 2048 + f0;
        const f32x4 bg0 = *(const f32x4*)(bg), bg1 = *(const f32x4*)(bg + 4), bu0 = *(const f32x4*)(bg + 1024), bu1 = *(const f32x4*)(bg + 1028);
        const f32x4 sg0 = *(const f32x4*)(sp), sg1 = *(const f32x4*)(sp + 4), su0 = *(const f32x4*)(sp + 1024), su1 = *(const f32x4*)(sp + 1028);
        const int pbase = u.i3 - prow0[e];
        float rsv[2][4];
#pragma unroll
        for (int ai = 0; ai < 2; ++ai)
#pragma unroll
            for (int m = 0; m < 4; ++m) rsv[ai][m] = rowhs[e * CAP + pbase + ai * 128 + wr * 64 + m * 16 + fr];
#pragma unroll
        for (int ai = 0; ai < 2; ++ai)
#pragma unroll
            for (int m = 0; m < 4; ++m) {
                const int prow = u.i3 + ai * 128 + wr * 64 + m * 16 + fr; const float rs = rsv[ai][m];
                const f32x4 g0 = __builtin_convertvector(acc[ai][0][m][0], f32x4) * (sg0 * rs) + bg0, g1 = __builtin_convertvector(acc[ai][0][m][1], f32x4) * (sg1 * rs) + bg1;
                const f32x4 u0 = __builtin_convertvector(acc[ai][1][m][0], f32x4) * (su0 * rs) + bu0, u1 = __builtin_convertvector(acc[ai][1][m][1], f32x4) * (su1 * rs) + bu1;
                float o[8];
#pragma unroll
                for (int j = 0; j < 8; ++j) {
                    const float g = fminf(j < 4 ? g0[j & 3] : g1[j & 3], 7.f);
                    const float up = fminf(fmaxf(j < 4 ? u0[j & 3] : u1[j & 3], -7.f), 7.f);
                    const float sg = __builtin_amdgcn_rcpf(1.f + __builtin_amdgcn_exp2f(-1.702f * 1.4426950408889634f * g));
                    o[j] = (up + 1.f) * (g * sg);
                }
                u32x4 w; w.x = cvt_pk_bf16(o[0], o[1]); w.y = cvt_pk_bf16(o[2], o[3]); w.z = cvt_pk_bf16(o[4], o[5]); w.w = cvt_pk_bf16(o[6], o[7]);
                *(GAS u32x4*)(ACT + (size_t)prow * 1024 + f0) = w;
            }
    }
};
struct EpiDN {
    typedef f32x4 ACC; static constexpr int MODE = 0;
    static __host__ __device__ __forceinline__ int brow(int R) { return (R & ~31) + pg8::perm32(R & 31); }
    bf16* Y; const float* bdn; const float* wsc; const int* rowslot; const float* rowgate; const LAS int* cntL; const LAS int* prow0;
    __device__ __forceinline__ void operator()(const f32x4 (&acc)[2][2][4][2], const pg8::Unit& u, int wr, int wc, int fr, int fq) const {
        const int e = u.i2, col0 = u.i1 * 256 + wc * 32 + 8 * fq;
        const float* bp = bdn + (size_t)e * 1024 + col0;
        f32x4 bv[2][2];
#pragma unroll
        for (int bj = 0; bj < 2; ++bj)
#pragma unroll
            for (int n = 0; n < 2; ++n) bv[bj][n] = *(const f32x4*)(bp + bj * 128 + 4 * n);
        const int pbase = u.i3 - prow0[e], cn = cntL[e];
        int slotv[2][4]; float gtv[2][4];
#pragma unroll
        for (int ai = 0; ai < 2; ++ai)
#pragma unroll
            for (int m = 0; m < 4; ++m) { const int pos = pbase + ai * 128 + wr * 64 + m * 16 + fr; const int pc = pos < cn ? pos : 0;
                slotv[ai][m] = rowslot[e * CAP + pc]; gtv[ai][m] = rowgate[e * CAP + pc]; }
#pragma unroll
        for (int ai = 0; ai < 2; ++ai)
#pragma unroll
            for (int m = 0; m < 4; ++m) {
                const int pos = pbase + ai * 128 + wr * 64 + m * 16 + fr;
                if (pos < cn) {
                    const float gt = gtv[ai][m];
                    bf16* rowp = Y + (size_t)slotv[ai][m] * 1024 + col0;
#pragma unroll
                    for (int bj = 0; bj < 2; ++bj) {
                        const f32x4 v0 = (acc[ai][bj][m][0] + bv[bj][0]) * gt, v1 = (acc[ai][bj][m][1] + bv[bj][1]) * gt;
                        u32x4 w; w.x = cvt_pk_bf16(v0[0], v0[1]); w.y = cvt_pk_bf16(v0[2], v0[3]); w.z = cvt_pk_bf16(v1[0], v1[1]); w.w = cvt_pk_bf16(v1[2], v1[3]);
                        *(GAS u32x4*)(rowp + bj * 128) = w;
                    }
                }
            }
    }
};
__device__ __forceinline__ void phase_moe_gu(Frame& F, int layer) {
    moe_tables(F, layer);
    typedef MoeOrderT<true> Ord;
    Ord S; S.NT = *(const LAS int*)(F.lds + L_NT); S.nN = 8; S.G = F.G; S.c = blockIdx.x; S.tileE = (const LAS int*)(F.lds + L_TILEE); S.tileRow = (const LAS int*)(F.lds + L_TILEROW);
    S.cntL = (const LAS int*)(F.lds + L_CNT); S.prow0 = (const LAS int*)(F.lds + L_PROW0); S.rowslot = (const int*)(F.ws + WS_ROWSLOT);
    S.Abase = (const char*)(F.ws + WS_H2); S.Bbase = (const char*)(F.ws + WS_WGU) + (size_t)layer * 32 * 2048 * 1024; S.bExp = (size_t)2048 * 1024; S.bTile = (size_t)128 * 1024; S.aPitch = 1024;
    EpiGU E; E.ACT = (bf16*)(F.ws + WS_ACT); E.bgu = F.b_gu + (size_t)layer * 32 * 2048; E.wsc = (const float*)(F.ws + WS_SC_GU) + (size_t)layer * 32 * 2048; E.rowhs = (const float*)(F.ws + WS_ROWHS);
    E.prow0 = (const LAS int*)(F.lds + L_PROW0);
    pg8::gemm_phase<EpiGU, Ord, true, true>(F.lds, (size_t)1024 * 1024, S, E);
}
__device__ __forceinline__ void phase_moe_dn(Frame& F, int layer) {
    moe_tables(F, layer);
    typedef MoeOrderT<false> Ord;
    Ord S; S.NT = *(const LAS int*)(F.lds + L_NT); S.nN = 4; S.G = F.G; S.c = blockIdx.x; S.tileE = (const LAS int*)(F.lds + L_TILEE); S.tileRow = (const LAS int*)(F.lds + L_TILEROW);
    S.cntL = (const LAS int*)(F.lds + L_CNT); S.prow0 = (const LAS int*)(F.lds + L_PROW0); S.rowslot = (const int*)(F.ws + WS_ROWSLOT);
    S.Abase = (const char*)(F.ws + WS_ACT); S.Bbase = (const char*)(F.ws + WS_WDN) + (size_t)layer * 32 * 1024 * 1024 * 2; S.bExp = (size_t)1024 * 1024 * 2; S.bTile = (size_t)256 * 1024 * 2; S.aPitch = 2048;
    EpiDN E; E.Y = (bf16*)(F.ws + WS_Y); E.bdn = F.b_dn + (size_t)layer * 32 * 1024; E.wsc = (const float*)(F.ws + WS_SC_DN) + (size_t)layer * 32 * 1024;
    E.rowslot = (const int*)(F.ws + WS_ROWSLOT); E.rowgate = (const float*)(F.ws + WS_ROWGATE);
    E.cntL = (const LAS int*)(F.lds + L_CNT); E.prow0 = (const LAS int*)(F.lds + L_PROW0);
    pg8::gemm_phase<EpiDN, Ord, true, true>(F.lds, (size_t)128 * 1024 * 2, S, E);
}

__device__ __forceinline__ void phase_combine(Frame& F, int layer, bool dry) {
    float* xout = dry ? (float*)(F.ws + WS_BIG + 144 * MiB) : F.out;
    const int gw = blockIdx.x * NWAVES + F.wave, NGW = F.G * NWAVES, lane = F.lane;
    const bf16* Y = (const bf16*)(F.ws + WS_Y); unsigned char* H2 = F.ws + WS_H2; float* HS = (float*)(F.ws + WS_HS);
    f32x4 gv[4];
#pragma unroll
    for (int j = 0; j < 4; ++j) gv[j] = *(const f32x4*)(F.norm_mix_g + 1024 + lane * 4 + 256 * j);
    for (int tok = gw; tok < NTOK; tok += NGW) {
        GAS f32x4* xr = (GAS f32x4*)(F.out + (size_t)tok * 1024) + lane;
        f32x4 v[4];
#pragma unroll
        for (int j = 0; j < 4; ++j) v[j] = xr[64 * j];
#pragma unroll
        for (int k = 0; k < 4; ++k) {
            const GAS u32x2* yr = (const GAS u32x2*)(Y + (size_t)(tok * 4 + k) * 1024) + lane;
#pragma unroll
            for (int j = 0; j < 4; ++j) { const u32x2 w = yr[64 * j]; v[j].x += bflo(w.x); v[j].y += bfhi(w.x); v[j].z += bflo(w.y); v[j].w += bfhi(w.y); }
        }
        float ss = 0.f;
#pragma unroll
        for (int j = 0; j < 4; ++j) { ((GAS f32x4*)(xout + (size_t)tok * 1024) + lane)[64 * j] = v[j]; ss += (v[j].x * v[j].x + v[j].y * v[j].y) + (v[j].z * v[j].z + v[j].w * v[j].w); }
        if (layer == 0 && !dry) {
            const float rstd = rsqrtf(wave_sum(ss) * (1.f / 1024.f) + EPS);
            f32x4 h[4];
#pragma unroll
            for (int j = 0; j < 4; ++j) h[j] = v[j] * rstd * gv[j];
            unsigned qw[4]; float inv; quant_row_i8(h, qw, inv);
            GAS unsigned* o4 = (GAS unsigned*)(H2 + (size_t)tok * 1024) + lane;
#pragma unroll
            for (int j = 0; j < 4; ++j) o4[64 * j] = qw[j];
            if (lane == 0) HS[tok] = inv;
        }
    }
}

struct DenseOrder {
    static constexpr bool GATHER = false;
    __device__ __forceinline__ int row_src(const pg8::Unit&, int) const { return 0; }
    int nM, nN, G, c; const char* Abase; const char* Bbase; int pitch;
    __device__ __forceinline__ bool next(int i, pg8::Unit& u) const {
        int pm, pn; if (!pg8::tile_order(i, G, c, nM, nN, pm, pn)) return false;
        u.a = Abase + (size_t)pm * 256 * pitch; u.b = Bbase + (size_t)pn * 256 * pitch; u.i0 = pm; u.i1 = pn; u.i2 = 0; u.i3 = 0; return true;
    }
};
struct EpiQKV {
    typedef v4i ACC; static constexpr int MODE = 1;
    static __host__ __device__ __forceinline__ int brow(int R) { return 2 * (R & ~31) + pg8::perm32(R & 31); }
    bf16* O; const float* qg; const float* kg; const float* wsc; const float* hs;
    __device__ __forceinline__ void operator()(const v4i (&acc)[2][2][4][2], const pg8::Unit& u, int wr, int wc, int fr, int fq) const {
        const int pn = u.i1, which = pn / 12;
        const int colh = pn * 256 + wc * 64;
        f32x4 gn[2][2], sc[2][2];
#pragma unroll
        for (int bj = 0; bj < 2; ++bj)
#pragma unroll
            for (int n = 0; n < 2; ++n) {
                const int hd = bj * 32 + 8 * fq + 4 * n;
                gn[bj][n] = which == 0 ? *(const f32x4*)(qg + hd) * (0.125f * 1.4426950408889634f * 64.f) : which == 1 ? *(const f32x4*)(kg + hd) * 16.f : (f32x4){1.f, 1.f, 1.f, 1.f};
                sc[bj][n] = *(const f32x4*)(wsc + colh + hd);
            }
#pragma unroll
        for (int ai = 0; ai < 2; ++ai)
#pragma unroll
            for (int m = 0; m < 4; ++m) {
                const int row = u.i0 * 256 + ai * 128 + wr * 64 + m * 16 + fr; const float rsc = hs[row];
                f32x4 v[2][2]; float ss = 0.f;
#pragma unroll
                for (int bj = 0; bj < 2; ++bj)
#pragma unroll
                    for (int n = 0; n < 2; ++n) { v[bj][n] = __builtin_convertvector(acc[ai][bj][m][n], f32x4) * (sc[bj][n] * rsc); const f32x4 t = v[bj][n]; ss += (t[0] * t[0] + t[1] * t[1]) + (t[2] * t[2] + t[3] * t[3]); }
                ss += __shfl_xor(ss, 16); ss += __shfl_xor(ss, 32);
                const float rs = which == 2 ? 1.f : rsqrtf(ss * (1.f / 64.f) + EPS);
                const int cwh = (pn % 12) * 256 + wc * 64;
                if (which < 2) {
                    unsigned h0[2], h1[2];
                    { const f32x4 a0 = v[0][0] * rs * gn[0][0], a1 = v[0][1] * rs * gn[0][1], b0 = v[1][0] * rs * gn[1][0], b1 = v[1][1] * rs * gn[1][1];
                      int w = __builtin_amdgcn_cvt_pk_fp8_f32(a0[0], a0[1], 0, false); h0[0] = (unsigned)__builtin_amdgcn_cvt_pk_fp8_f32(a0[2], a0[3], w, true);
                      w = __builtin_amdgcn_cvt_pk_fp8_f32(a1[0], a1[1], 0, false); h0[1] = (unsigned)__builtin_amdgcn_cvt_pk_fp8_f32(a1[2], a1[3], w, true);
                      w = __builtin_amdgcn_cvt_pk_fp8_f32(b0[0], b0[1], 0, false); h1[0] = (unsigned)__builtin_amdgcn_cvt_pk_fp8_f32(b0[2], b0[3], w, true);
                      w = __builtin_amdgcn_cvt_pk_fp8_f32(b1[0], b1[1], 0, false); h1[1] = (unsigned)__builtin_amdgcn_cvt_pk_fp8_f32(b1[2], b1[3], w, true); }
                    const auto r0 = __builtin_amdgcn_permlane16_swap(h0[0], h1[0], false, false), r1 = __builtin_amdgcn_permlane16_swap(h0[1], h1[1], false, false);
                    const int boff = (fq & 1) ? 32 + 8 * (fq - 1) : 8 * fq;
                    const u32x4 wv = (fq & 1) ? (u32x4){r0[0], r1[0], r0[1], r1[1]} : (u32x4){r0[0], r1[0], r0[1], r1[1]};
                    *(GAS u32x4*)((unsigned char*)O + (size_t)row * QKVB + which * 3072 + cwh + boff) = wv;
                } else {
                    u32x4 w0, w1;
                    { const f32x4 a0 = v[0][0], a1 = v[0][1], b0 = v[1][0], b1 = v[1][1];
                      w0.x = cvt_pk_bf16(a0[0], a0[1]); w0.y = cvt_pk_bf16(a0[2], a0[3]); w0.z = cvt_pk_bf16(a1[0], a1[1]); w0.w = cvt_pk_bf16(a1[2], a1[3]);
                      w1.x = cvt_pk_bf16(b0[0], b0[1]); w1.y = cvt_pk_bf16(b0[2], b0[3]); w1.z = cvt_pk_bf16(b1[0], b1[1]); w1.w = cvt_pk_bf16(b1[2], b1[3]); }
                    u32x4 t0, t1;
#pragma unroll
                    for (int d = 0; d < 4; ++d) { t0[d] = (unsigned)__builtin_amdgcn_update_dpp(0, (int)w0[d], 0x128, 0xf, 0xf, false); t1[d] = (unsigned)__builtin_amdgcn_update_dpp(0, (int)w1[d], 0x128, 0xf, 0xf, false); }
                    const bool lo = fr < 8;
                    const int rbase = u.i0 * 256 + ai * 128 + wr * 64 + m * 16 + (fr & 7);
                    const int bofs = 6144 + (cwh + 8 * fq) * 2 + (lo ? 0 : 64);
                    *(GAS u32x4*)((unsigned char*)O + (size_t)rbase * QKVB + bofs) = lo ? w0 : t1;
                    *(GAS u32x4*)((unsigned char*)O + (size_t)(rbase + 8) * QKVB + bofs) = lo ? t0 : w1;
                }
            }
    }
};
__device__ __forceinline__ void phase_qkv(Frame& F) {
    DenseOrder S; S.nM = NTOK / 256; S.nN = NQKV / 256; S.G = F.G; S.c = blockIdx.x; S.Abase = (const char*)(F.ws + WS_H2); S.Bbase = (const char*)(F.ws + WS_WQKV); S.pitch = 1024;
    EpiQKV E; E.O = (bf16*)(F.ws + WS_QKV); E.qg = F.q_gain; E.kg = F.k_gain; E.wsc = (const float*)(F.ws + WS_SC_QKV); E.hs = (const float*)(F.ws + WS_HS);
    pg8::gemm_phase<EpiQKV, DenseOrder, true, true>(F.lds, (size_t)32 * 1024, S, E);
}

struct EpiWo {
    typedef f32x4 ACC; static constexpr int MODE = 0;
    static __host__ __device__ __forceinline__ int brow(int R) { return R; }
    float* X; float* XO;
    __device__ __forceinline__ void operator()(const f32x4 (&acc)[2][2][4][2], const pg8::Unit& u, int wr, int wc, int fr, int fq) const {
        const int row0 = u.i0 * 256 + wr * 64 + fr, col0 = u.i1 * 256 + wc * 32 + 4 * fq; const size_t dlt = XO - X;
#pragma unroll
        for (int ai = 0; ai < 2; ++ai)
#pragma unroll
            for (int m = 0; m < 4; ++m) { float* rowp = X + (size_t)(row0 + ai * 128 + m * 16) * 1024 + col0;
#pragma unroll
                for (int bj = 0; bj < 2; ++bj)
#pragma unroll
                    for (int n = 0; n < 2; ++n) { GAS f32x4* p = (GAS f32x4*)(rowp + bj * 128 + n * 16); *(p + dlt / 4) = *p + acc[ai][bj][m][n]; } }
    }
};
__device__ __forceinline__ void phase_wo(Frame& F, bool dry) {
    DenseOrder S; S.nM = NTOK / 256; S.nN = 4; S.G = F.G; S.c = blockIdx.x; S.Abase = (const char*)(F.ws + WS_OB); S.Bbase = (const char*)(F.ws + WS_WO); S.pitch = 2048;
    EpiWo E; E.X = F.out; E.XO = dry ? (float*)(F.ws + WS_BIG + 144 * MiB) : F.out;
    pg8::gemm_phase<EpiWo, DenseOrder, false, true>(F.lds, (size_t)128 * 1024 * 2, S, E);
}

typedef short v4i16_t __attribute__((ext_vector_type(4)));
__device__ __forceinline__ s16x4 vtr(const LAS unsigned char* p) { return __builtin_bit_cast(s16x4, __builtin_amdgcn_ds_read_tr16_b64_v4i16((LAS v4i16_t*)p)); }
struct AttnItem { int g, dil, i, head, needprev; size_t rowbase; };
__device__ __forceinline__ AttnItem attn_item(int sup, int it, int hg) {
    AttnItem a; int z, hp;
    if (it < 4) { const int c0 = sup >> 2; a.g = 0; a.dil = 1; z = c0 >> 3; hp = c0 & 7; a.i = 4 * (sup & 3) + it; a.needprev = (it == 0 && a.i > 0); }
    else if (it < 8) { a.g = 1; a.dil = 4; z = sup >> 3; hp = sup & 7; a.i = it - 4; a.needprev = 0; }
    else { const int idx = 4 * sup + (it - 8); a.g = 2; a.dil = 16; z = idx >> 3; hp = idx & 7; a.i = 0; a.needprev = 0; }
    a.head = hp * 2 + hg;
    a.rowbase = (size_t)(z / a.dil) * SEQ + (z % a.dil);
    return a;
}
__device__ __forceinline__ void attn_issue(const unsigned char* QKV, const AttnItem& a, int blk, int t2, u32x4 (&kv)[2], u32x4 (&vv)[4]) {
#pragma unroll
    for (int it = 0; it < 4; ++it) {
        const int cidx = t2 + 256 * it, row = cidx >> 3, ch = cidx & 7;
        const unsigned char* src = QKV + (a.rowbase + (size_t)a.dil * ((size_t)blk * 128 + row)) * QKVB + 6144 + (a.g * 1024 + a.head * 64 + ch * 8) * 2;
        vv[it] = *(const GAS u32x4*)src;
    }
#pragma unroll
    for (int it = 0; it < 2; ++it) {
        const int cidx = t2 + 256 * it, row = cidx >> 2, ch = cidx & 3;
        const unsigned char* src = QKV + (a.rowbase + (size_t)a.dil * ((size_t)blk * 128 + row)) * QKVB + 3072 + a.g * 1024 + a.head * 64 + ch * 16;
        kv[it] = *(const GAS u32x4*)src;
    }
}
__device__ __forceinline__ void attn_commit(LAS unsigned char* Kb, LAS unsigned char* Vb, int slot, int t2, const u32x4 (&kv)[2], const u32x4 (&vv)[4]) {
#pragma unroll
    for (int it = 0; it < 4; ++it) {
        const int cidx = t2 + 256 * it, row = cidx >> 3, ch = cidx & 7;
        *(LAS u32x4*)(Vb + slot * 16384 + row * 128 + ((ch ^ (row & 7)) << 4)) = vv[it];
    }
#pragma unroll
    for (int it = 0; it < 2; ++it) {
        const int cidx = t2 + 256 * it, row = cidx >> 2, ch = cidx & 3, x = (row >> 2) & 7;
        LAS unsigned char* rp = Kb + slot * 8192 + row * 64;
        *(LAS u32x2*)(rp + (((2 * ch) ^ x) << 3)) = (u32x2){kv[it].x, kv[it].y};
        *(LAS u32x2*)(rp + (((2 * ch + 1) ^ x) << 3)) = (u32x2){kv[it].z, kv[it].w};
    }
}
__device__ __forceinline__ void attn_loadq(const unsigned char* QKV, const AttnItem& a, int w, int q, int hh, long (&qf)[4]) {
    const size_t qrow = a.rowbase + (size_t)a.dil * ((size_t)a.i * 128 + 32 * w + q);
    const unsigned char* qp = QKV + qrow * QKVB + a.g * 1024 + a.head * 64 + 8 * hh;
#pragma unroll
    for (int ks = 0; ks < 4; ++ks) qf[ks] = *(const GAS long*)(qp + 16 * ks);
}
__device__ __forceinline__ void phase_attn(Frame& F) {
    LAS unsigned char* lds = F.lds;
    LAS float* btab = (LAS float*)(lds + L_BTAB); LAS int* bucketL = (LAS int*)(lds + L_BUCKET);
    const int tid = F.tid, lane = F.lane, wave = F.wave;
    for (int i = tid; i < 3 * 129; i += NTHREADS) {
        const int g = i / 129, d = i % 129; const int n = d * (g == 0 ? 1 : g == 1 ? 4 : 16);
        int bk;
        if (n < 16) bk = n;
        else { const float nf = (float)n; int lg = 16 + (int)(logf(nf / 16.f) / 4.852030263919617f * 16.f); bk = lg < 31 ? lg : 31; }
        bucketL[g * 132 + d] = bk;
    }
    __syncthreads();
    const int hg = wave >> 2, w = wave & 3, t2 = tid & 255;
    const int q = lane & 31, hh = lane >> 5;
    const unsigned char* QKV = F.ws + WS_QKV;
    LAS unsigned char* Kb = lds + hg * 16384;
    LAS unsigned char* Vb = lds + 65536 + hg * 32768;
    const int g16 = lane >> 4, i16 = lane & 15, qsel = i16 >> 2, psel = i16 & 3;
    int kcon[4];
#pragma unroll
    for (int ks = 0; ks < 4; ++ks) kcon[ks] = q * 64 + (((2 * ks + hh) ^ ((q >> 2) & 7)) << 3);
    const int c7 = (4 * hh + qsel) & 7, cb = 2 * (g16 & 1) + (psel >> 1);
    const int vcon0 = (4 * hh + qsel) * 128 + ((cb ^ c7) << 4) + (psel & 1) * 8;
    const int vcon1 = (4 * hh + qsel) * 128 + (((cb + 4) ^ c7) << 4) + (psel & 1) * 8;
    const LAS float* bt = btab + hg * 192 + 32 + 4 * hh - q;
    const int bj_ = t2 - 32; const bool bval = (t2 < 192) && bj_ >= 0 && bj_ <= 128; const int bdel = bval ? 128 - bj_ : 0;
    for (int sup = blockIdx.x; sup < 256; sup += F.G) {
        AttnItem cur = attn_item(sup, 0, hg);
        u32x4 kv[2], vv[4]; long qf[4], qn[4]; float bnx;
        if (cur.needprev) { attn_issue(QKV, cur, cur.i - 1, t2, kv, vv); attn_commit(Kb, Vb, (cur.i - 1) & 1, t2, kv, vv); }
        attn_issue(QKV, cur, cur.i, t2, kv, vv); attn_loadq(QKV, cur, w, q, hh, qf);
        bnx = F.rel_bias[bucketL[cur.g * 132 + bdel] * 48 + cur.g * 16 + cur.head];
        attn_commit(Kb, Vb, cur.i & 1, t2, kv, vv);
        if (t2 < 192) btab[hg * 192 + t2] = bval ? bnx * (1.4426950408889634f * 1024.f) : -1e30f;
        asm volatile("" : "+v"(qf[0]), "+v"(qf[1]), "+v"(qf[2]), "+v"(qf[3]) :: "memory");
        __syncthreads();
#pragma unroll 1
        for (int it = 0; it < 12; ++it) {
            const bool hn = it + 1 < 12;
            AttnItem nxt = cur;
            if (hn) { nxt = attn_item(sup, it + 1, hg); attn_issue(QKV, nxt, nxt.i, t2, kv, vv); attn_loadq(QKV, nxt, w, q, hh, qn);
                      bnx = F.rel_bias[bucketL[nxt.g * 132 + bdel] * 48 + nxt.g * 16 + nxt.head]; }
            const int i = cur.i;
            const int kt_lo = (i == 0) ? 4 : w;
            f32x16 S[5];
            float mx = -1e30f;
#pragma unroll
            for (int t = 0; t < 5; ++t) {
                const int kt = w + t;
                if (kt >= kt_lo) {
                    const LAS unsigned char* kp = Kb + (((kt < 4 ? i - 1 : i) & 1) * 8192 + (kt & 3) * 2048);
                    long kf[4];
#pragma unroll
                    for (int ks = 0; ks < 4; ++ks) kf[ks] = *(const LAS long*)(kp + kcon[ks]);
                    f32x16 acc;
#pragma unroll
                    for (int rg = 0; rg < 16; ++rg) acc[rg] = bt[32 * t + 8 * (rg >> 2) + (rg & 3)];
#pragma unroll
                    for (int ks = 0; ks < 4; ++ks) acc = __builtin_amdgcn_mfma_f32_32x32x16_fp8_fp8(kf[ks], qf[ks], acc, 0, 0, 0);
                    S[t] = acc;
#pragma unroll
                    for (int rg = 0; rg < 16; ++rg) mx = fmaxf(mx, acc[rg]);
                } else {
#pragma unroll
                    for (int rg = 0; rg < 16; ++rg) S[t][rg] = -1e30f;
                }
            }
            mx = fmaxf(mx, __shfl_xor(mx, 32)) * (1.f / 1024.f);
            float lsum = 0.f;
#pragma unroll
            for (int t = 0; t < 5; ++t)
#pragma unroll
                for (int rg = 0; rg < 16; ++rg) { const float p = __builtin_amdgcn_exp2f(__builtin_fmaf(S[t][rg], 1.f / 1024.f, -mx)); S[t][rg] = p; lsum += p; }
            lsum += __shfl_xor(lsum, 32);
            f32x16 O[2];
#pragma unroll
            for (int dt = 0; dt < 2; ++dt)
#pragma unroll
                for (int rg = 0; rg < 16; ++rg) O[dt][rg] = 0.f;
#pragma unroll
            for (int t = 0; t < 5; ++t) {
                const int kt = w + t;
                if (kt >= kt_lo) {
                    const LAS unsigned char* vp = Vb + (((kt < 4 ? i - 1 : i) & 1) * 16384 + (kt & 3) * 4096);
#pragma unroll
                    for (int s2 = 0; s2 < 2; ++s2) {
                        bf16x8 pf;
                        { const unsigned w0 = cvt_pk_bf16(S[t][8 * s2 + 0], S[t][8 * s2 + 1]), w1 = cvt_pk_bf16(S[t][8 * s2 + 2], S[t][8 * s2 + 3]),
                                         w2 = cvt_pk_bf16(S[t][8 * s2 + 4], S[t][8 * s2 + 5]), w3 = cvt_pk_bf16(S[t][8 * s2 + 6], S[t][8 * s2 + 7]);
                          const u32x4 pw = (u32x4){w0, w1, w2, w3}; pf = __builtin_bit_cast(bf16x8, pw); }
                        const s16x4 lo0 = vtr(vp + s2 * 2048 + vcon0), hi0 = vtr(vp + s2 * 2048 + 1024 + vcon0);
                        const s16x4 lo1 = vtr(vp + s2 * 2048 + vcon1), hi1 = vtr(vp + s2 * 2048 + 1024 + vcon1);
                        const bf16x8 vf0 = (bf16x8){lo0[0], lo0[1], lo0[2], lo0[3], hi0[0], hi0[1], hi0[2], hi0[3]};
                        const bf16x8 vf1 = (bf16x8){lo1[0], lo1[1], lo1[2], lo1[3], hi1[0], hi1[1], hi1[2], hi1[3]};
                        O[0] = __builtin_amdgcn_mfma_f32_32x32x16_bf16(vf0, pf, O[0], 0, 0, 0);
                        O[1] = __builtin_amdgcn_mfma_f32_32x32x16_bf16(vf1, pf, O[1], 0, 0, 0);
                    }
                }
            }
            {
                const size_t qrow = cur.rowbase + (size_t)cur.dil * ((size_t)i * 128 + 32 * w + q);
                const float inv = 1.f / lsum;
                bf16* op = (bf16*)(F.ws + WS_OG) + ((size_t)cur.g * NTOK + qrow) * 1024 + cur.head * 64;
#pragma unroll
                for (int dt = 0; dt < 2; ++dt)
#pragma unroll
                    for (int r4 = 0; r4 < 4; ++r4) {
                        u32x2 wv; wv.x = cvt_pk_bf16(O[dt][4 * r4 + 0] * inv, O[dt][4 * r4 + 1] * inv); wv.y = cvt_pk_bf16(O[dt][4 * r4 + 2] * inv, O[dt][4 * r4 + 3] * inv);
                        *(GAS u32x2*)(op + dt * 32 + 8 * r4 + 4 * hh) = wv;
                    }
                if (hh == 0) ((float*)(F.ws + WS_LSE))[((size_t)cur.g * NTOK + qrow) * 16 + cur.head] = (mx + __builtin_amdgcn_logf(lsum)) * 0.6931471805599453f;
            }
            __syncthreads();
            if (hn) {
                asm volatile("" : "+v"(qn[0]), "+v"(qn[1]), "+v"(qn[2]), "+v"(qn[3]), "+v"(bnx) :: "memory");
                attn_commit(Kb, Vb, nxt.i & 1, t2, kv, vv);
                if (t2 < 192) btab[hg * 192 + t2] = bval ? bnx * (1.4426950408889634f * 1024.f) : -1e30f;
#pragma unroll
                for (int ks = 0; ks < 4; ++ks) qf[ks] = qn[ks];
                cur = nxt;
            }
            __syncthreads();
        }
    }
}
__device__ __forceinline__ void phase_attn_combine(Frame& F) {
    const int gw = blockIdx.x * NWAVES + F.wave, NGW = F.G * NWAVES, lane = F.lane;
    const float* LSE = (const float*)(F.ws + WS_LSE); const bf16* OG = (const bf16*)(F.ws + WS_OG); bf16* OB = (bf16*)(F.ws + WS_OB);
    for (int tok = gw; tok < NTOK; tok += NGW) {
        const int head = lane >> 2;
        const float l0 = LSE[((size_t)0 * NTOK + tok) * 16 + head], l1 = LSE[((size_t)1 * NTOK + tok) * 16 + head], l2 = LSE[((size_t)2 * NTOK + tok) * 16 + head];
        const float m = fmaxf(l0, fmaxf(l1, l2));
        float a0 = __expf(l0 - m), a1 = __expf(l1 - m), a2 = __expf(l2 - m); const float inv = 1.f / (a0 + a1 + a2); a0 *= inv; a1 *= inv; a2 *= inv;
        const GAS u32x4* p0 = (const GAS u32x4*)(OG + ((size_t)0 * NTOK + tok) * 1024) + 2 * lane;
        const GAS u32x4* p1 = (const GAS u32x4*)(OG + ((size_t)1 * NTOK + tok) * 1024) + 2 * lane;
        const GAS u32x4* p2 = (const GAS u32x4*)(OG + ((size_t)2 * NTOK + tok) * 1024) + 2 * lane;
        GAS u32x4* po = (GAS u32x4*)(OB + (size_t)tok * 1024) + 2 * lane;
#pragma unroll
        for (int c = 0; c < 2; ++c) {
            const u32x4 v0 = p0[c], v1 = p1[c], v2 = p2[c]; u32x4 o;
#pragma unroll
            for (int k = 0; k < 4; ++k) {
                const float lo = a0 * bflo(v0[k]) + a1 * bflo(v1[k]) + a2 * bflo(v2[k]);
                const float hi = a0 * bfhi(v0[k]) + a1 * bfhi(v1[k]) + a2 * bfhi(v2[k]);
                o[k] = pk2(lo, hi);
            }
            po[c] = o;
        }
    }
}

constexpr int NPHASE = 13;
__global__ void __launch_bounds__(NTHREADS, 2) fwd_kernel(Args args) {
    extern __shared__ __attribute__((aligned(16))) unsigned char lds_raw[];
    Frame F;
    F.lds = (LAS unsigned char*)lds_raw;
    F.tid = threadIdx.x; F.lane = F.tid & 63; F.wave = __builtin_amdgcn_readfirstlane(F.tid >> 6); F.G = gridDim.x;
    F.ws = args.ws; F.out = args.out; F.ctl = (gu32*)(args.ws + WS_CTL);
    F.x = args.in[0]; F.norm_mix_g = args.in[1]; F.norm_ffn_g = args.in[2]; F.pool_w = args.in[3]; F.pool_scale = args.in[4]; F.w_qkv = args.in[5];
    F.q_gain = args.in[6]; F.k_gain = args.in[7]; F.w_o = args.in[8]; F.rel_bias = args.in[9]; F.w_router = args.in[10]; F.b_router = args.in[11];
    F.w_gu = args.in[12]; F.b_gu = args.in[13]; F.w_dn = args.in[14]; F.b_dn = args.in[15];
    if (F.tid < 16) ((LAS unsigned*)(F.lds + L_BARST))[F.tid] = 0u;
    __syncthreads();
    if (args.never) cg::this_grid().sync();
#if MK_MULTI
#define GRID_BAR() do { } while (0)
#else
    XcdBarrier bar = xcd_barrier_post((unsigned*)(F.ctl + CW_BAR), (volatile LAS unsigned*)(F.lds + L_BARST));
#define GRID_BAR() xcd_barrier(bar)
#endif
    const int lo = args.ph_lo, hi = args.ph_hi;
#define IN(k) (lo <= (k) && (k) < hi)
#define SEAM(k) do { if (IN(k) && IN((k) + 1)) GRID_BAR(); } while (0)
#define RUN(k, call) do { if (IN(k)) { if ((DUP_MASK >> (k)) & 1) { call; GRID_BAR(); } call; } } while (0)
#define DRY(k) (((DUP_MASK >> (k)) & 1) != 0)
    RUN(0, phase_convert(F));          SEAM(0);
    if (IN(1)) { if (DRY(1)) { phase_pool(F, true); GRID_BAR(); } phase_pool(F, false); }  SEAM(1);
    RUN(2, phase_moe_gu(F, 0));        SEAM(2);
    RUN(3, phase_moe_dn(F, 0));        SEAM(3);
    if (IN(4)) { if (DRY(4)) { phase_combine(F, 0, true); GRID_BAR(); } phase_combine(F, 0, false); }  SEAM(4);
    RUN(5, phase_qkv(F));              SEAM(5);
    RUN(6, phase_attn(F));             SEAM(6);
    RUN(7, phase_attn_combine(F));     SEAM(7);
    if (IN(8)) { if (DRY(8)) { phase_wo(F, true); GRID_BAR(); } phase_wo(F, false); }  SEAM(8);
    if (IN(9)) { if (DRY(9)) { phase_router(F, 1, true); GRID_BAR(); } phase_router(F, 1, false); }  SEAM(9);
    RUN(10, phase_moe_gu(F, 1));       SEAM(10);
    RUN(11, phase_moe_dn(F, 1));       SEAM(11);
    if (IN(12)) { if (DRY(12)) { phase_combine(F, 1, true); GRID_BAR(); } phase_combine(F, 1, false); }
#undef RUN
#undef DRY
#undef IN
#undef SEAM
}

extern "C" void kernel_launch(void* const* d_in, const int* in_sizes, int n_in, void* d_out, int out_size, void* d_ws, size_t ws_size, hipStream_t stream) {
    static int grid = 0;
    if (grid == 0) {
        if (n_in != 16 || in_sizes[0] != NTOK * DM || out_size != NTOK * DM || ws_size < WS_END) {
            fprintf(stderr, "kernel_launch: unexpected shapes (n_in %d, in0 %d, out %d, ws %zu < %zu); nothing launched\n", n_in, n_in > 0 ? in_sizes[0] : -1, out_size, ws_size, (size_t)WS_END); grid = -1; return; }
        int dev = 0, cus = 0, per_cu = 0;
        if (hipGetDevice(&dev) != hipSuccess || hipDeviceGetAttribute(&cus, hipDeviceAttributeMultiprocessorCount, dev) != hipSuccess) { grid = -1; return; }
        if (hipFuncSetAttribute((const void*)fwd_kernel, hipFuncAttributeMaxDynamicSharedMemorySize, LDS_BYTES) != hipSuccess) { fprintf(stderr, "kernel_launch: hipFuncSetAttribute failed\n"); grid = -1; return; }
        if (hipOccupancyMaxActiveBlocksPerMultiprocessor(&per_cu, (const void*)fwd_kernel, NTHREADS, LDS_BYTES) != hipSuccess || per_cu < 1) { fprintf(stderr, "kernel_launch: occupancy query says %d blocks/CU\n", per_cu); (void)hipGetLastError(); grid = -1; return; }
        grid = cus;
    }
    if (grid < 0) return;
    if (hipMemsetAsync((char*)d_ws + WS_CTL, 0, CTL_BYTES, stream) != hipSuccess) { fprintf(stderr, "kernel_launch: memset failed\n"); return; }
    Args a{};
    for (int i = 0; i < 16; ++i) a.in[i] = (const float*)d_in[i];
    a.out = (float*)d_out; a.ws = (unsigned char*)d_ws; a.never = 0; a.pad = 0;
#if MK_MULTI
    for (int p = 0; p < NPHASE; ++p) { a.ph_lo = p; a.ph_hi = p + 1; hipLaunchKernelGGL(fwd_kernel, dim3(grid), dim3(NTHREADS), LDS_BYTES, stream, a); }
#else
    a.ph_lo = 0; a.ph_hi = NPHASE;
    void* kargs[] = {&a};
    hipError_t e = hipLaunchCooperativeKernel((const void*)fwd_kernel, dim3(grid), dim3(NTHREADS), kargs, LDS_BYTES, stream);
    if (e != hipSuccess) fprintf(stderr, "kernel_launch: cooperative launch failed: %s (grid %d)\n", hipGetErrorString(e), grid);
#endif
}
```

```cpp
#include <hip/hip_runtime.h>
#include <hip/hip_cooperative_groups.h>
#include <cstdio>
#include <cstdint>
namespace cg = cooperative_groups;

#ifndef DUP_MASK
#define DUP_MASK 0
#endif
#ifndef MK_MULTI
#define MK_MULTI 0
#endif

#define LAS __attribute__((address_space(3)))
#define GAS __attribute__((address_space(1)))
typedef unsigned short bf16;
typedef short bf16x8 __attribute__((ext_vector_type(8)));
typedef short s16x4 __attribute__((ext_vector_type(4)));
typedef float f32x2 __attribute__((ext_vector_type(2)));
typedef float f32x4 __attribute__((ext_vector_type(4)));
typedef float f32x16 __attribute__((ext_vector_type(16)));
typedef int v4i __attribute__((ext_vector_type(4)));
typedef int v8i __attribute__((ext_vector_type(8)));
typedef unsigned u32x4 __attribute__((ext_vector_type(4)));
typedef unsigned u32x2 __attribute__((ext_vector_type(2)));
typedef GAS unsigned gu32;

constexpr int NTOK = 16384, DM = 1024, SEQ = 2048, NEXP = 32, TOPK = 4, FF = 1024, NQKV = 9216;
constexpr int QKVB = 12288;
constexpr int CAP = 16384;
constexpr int MAXT = 288;
constexpr int PMAX = MAXT * 256;
constexpr float EPS = 1e-6f;
constexpr int NWAVES = 8, NTHREADS = 512;

constexpr size_t MiB = 1u << 20;
constexpr size_t WS_CTL = 0, CTL_BYTES = 1 * MiB;
constexpr size_t WS_WRT = 1 * MiB;
constexpr size_t WS_WPOOL = WS_WRT + 512 * 1024;
constexpr size_t WS_WO = 2 * MiB;
constexpr size_t WS_SC_GU = 4 * MiB;
constexpr size_t WS_SC_QKV = 4 * MiB + 512 * 1024;
constexpr size_t WS_SC_DN = 5 * MiB;
constexpr size_t WS_HS = 6 * MiB;
constexpr size_t WS_WQKV = 8 * MiB;
constexpr size_t WS_WGU = 18 * MiB;
constexpr size_t WS_WDN = WS_WGU + 128 * MiB;
constexpr size_t WS_ROWSLOT = WS_WDN + 128 * MiB;
constexpr size_t WS_ROWGATE = WS_ROWSLOT + 2 * MiB;
constexpr size_t WS_ROWHS = WS_ROWGATE + 2 * MiB;
constexpr size_t WS_LSE = WS_ROWHS + 2 * MiB;
constexpr size_t WS_H2 = WS_LSE + 3 * MiB;
constexpr size_t WS_BIG = WS_H2 + 16 * MiB;
constexpr size_t WS_ACT = WS_BIG, WS_QKV = WS_BIG;
constexpr size_t WS_Y = WS_BIG + 288 * MiB;
constexpr size_t WS_OG = WS_Y, WS_OB = WS_Y + 96 * MiB;
constexpr size_t WS_END = WS_Y + 128 * MiB;
static_assert(WS_END <= 874 * MiB, "workspace map must fit the guaranteed d_ws size");
constexpr int CW_CNT = 64;
constexpr int CW_BAR = 4096;

constexpr int RING_BYTES = 131072;
constexpr int MISC_OFF = RING_BYTES;
constexpr int L_BARST = MISC_OFF + 0;
constexpr int L_CNT = MISC_OFF + 64;
constexpr int L_PROW0 = MISC_OFF + 192;
constexpr int L_NT = MISC_OFF + 320;
constexpr int L_TILEE = MISC_OFF + 336;
constexpr int L_TILEROW = MISC_OFF + 1488;
constexpr int L_HIST = MISC_OFF + 2640;
constexpr int L_BASE = MISC_OFF + 2768;
constexpr int L_SLOTE = MISC_OFF + 2896;
constexpr int L_SLOTP = MISC_OFF + 3920;
constexpr int L_SLOTG = MISC_OFF + 4944;
constexpr int L_RSTD = MISC_OFF + 5968;
constexpr int L_BIAS = MISC_OFF + 6288;
constexpr int L_BUCKET = MISC_OFF + 7344;
constexpr int L_BTAB = MISC_OFF + 8960;
constexpr int LDS_BYTES = 147456;
static_assert(L_BTAB + 2 * 192 * 4 <= LDS_BYTES, "LDS map");

#define RLX_AGENT __ATOMIC_RELAXED, __HIP_MEMORY_SCOPE_AGENT
#define LDS_WAIT() asm volatile("s_waitcnt lgkmcnt(0)" ::: "memory")
#define VM_WAIT() asm volatile("s_waitcnt vmcnt(0)" ::: "memory")
__device__ __forceinline__ unsigned f2bf(float f) { unsigned u = __builtin_bit_cast(unsigned, f); return (u + 0x7fffu + ((u >> 16) & 1u)) >> 16; }
__device__ __forceinline__ unsigned pk2(float lo, float hi) { return f2bf(lo) | (f2bf(hi) << 16); }
__device__ __forceinline__ float bf2f(unsigned short b) { return __builtin_bit_cast(float, ((unsigned)b) << 16); }
__device__ __forceinline__ float bflo(unsigned w) { return __builtin_bit_cast(float, w << 16); }
__device__ __forceinline__ float bfhi(unsigned w) { return __builtin_bit_cast(float, w & 0xffff0000u); }
typedef __bf16 bf16x2_t __attribute__((ext_vector_type(2)));
__device__ __forceinline__ unsigned cvt_pk_bf16(float lo, float hi) { const f32x2 v = {lo, hi}; const bf16x2_t b = __builtin_convertvector(v, bf16x2_t); return __builtin_bit_cast(unsigned, b); }
__device__ __forceinline__ float wave_sum(float v) {
#pragma unroll
    for (int o = 1; o < 64; o <<= 1) v += __shfl_xor(v, o);
    return v;
}

#define XB_TMO      128
#define XB_XCNT(j)  (256  + 64 * (j))
#define XB_XSUB(j)  (1280 + 64 * (j))
#define XB_XGEN(j)  (2304 + 64 * (j))
#define XB_TOP      3328
#define XB_TOPGEN   3392
#define XCD_BAR_WORDS 3456
#define XB_SPIN_CAP (1u << 20)
__device__ __forceinline__ unsigned xb_ld(unsigned* p)              { return __hip_atomic_load(p, __ATOMIC_RELAXED, __HIP_MEMORY_SCOPE_AGENT); }
__device__ __forceinline__ unsigned xb_add(unsigned* p, unsigned v) { return __hip_atomic_fetch_add(p, v, __ATOMIC_RELAXED, __HIP_MEMORY_SCOPE_AGENT); }
__device__ __forceinline__ unsigned xb_xcc_id() { return (unsigned)__builtin_amdgcn_s_getreg((3 << 11) | 20) & 0xFu; }
#define XB_SPIN(cond, bar) do { unsigned _sp = 0; while (cond) { __builtin_amdgcn_s_sleep(1); \
    if ((++_sp & 255u) == 0u) { if (xb_ld(&(bar)[XB_TMO])) break; if (_sp > XB_SPIN_CAP) { atomicAdd(&(bar)[XB_TMO], 1u); break; } } } } while (0)
struct XcdBarrier { unsigned* bar; unsigned x; volatile LAS unsigned* st; };
__device__ __forceinline__ XcdBarrier xcd_barrier_post(unsigned* bar, volatile LAS unsigned* st) {
    XcdBarrier b; b.bar = bar; b.x = xb_xcc_id(); b.st = st;
    if (threadIdx.x == 0) (void)xb_add(&bar[XB_XCNT(b.x)], 1u);
    return b;
}
__device__ __forceinline__ void xcd_barrier_complete(unsigned* bar, unsigned x, unsigned& nloc, unsigned& nx) {
    const unsigned G = gridDim.x * gridDim.y * gridDim.z;
    unsigned sum, cnt, mine, sp = 0u;
    for (;;) {
        sum = 0u; cnt = 0u; mine = 0u;
#pragma unroll
        for (unsigned j = 0; j < 16; ++j) { const unsigned c = xb_ld(&bar[XB_XCNT(j)]); sum += c; cnt += (c > 0u) ? 1u : 0u; mine = (j == x) ? c : mine; }
        if (sum == G) break;
        __builtin_amdgcn_s_sleep(1);
        if ((++sp & 255u) == 0u) { if (xb_ld(&bar[XB_TMO])) break; if (sp > XB_SPIN_CAP) { atomicAdd(&bar[XB_TMO], 1u); break; } }
    }
    nloc = mine > 0u ? mine : 1u; nx = cnt > 0u ? cnt : 1u;
}
__device__ __forceinline__ void xcd_barrier(const XcdBarrier& b) {
    asm volatile("s_waitcnt vmcnt(0)" ::: "memory");
    __syncthreads();
    if (threadIdx.x == 0) {
        unsigned* bar = b.bar;
        __builtin_amdgcn_s_waitcnt(0);
        unsigned nloc = b.st[0], nx = b.st[1];
        if (nloc == 0u) { xcd_barrier_complete(bar, b.x, nloc, nx); b.st[0] = nloc; b.st[1] = nx; }
        const unsigned old = xb_add(&bar[XB_XSUB(b.x)], 1u);
        const unsigned gen = old / nloc;
        if (old + 1u == (gen + 1u) * nloc) {
            __builtin_amdgcn_fence(__ATOMIC_RELEASE, "agent");
            asm volatile("s_waitcnt vmcnt(0)" ::: "memory");
            const unsigned og = xb_add(&bar[XB_TOP], 1u);
            const unsigned tg = og / nx;
            if (og + 1u == (tg + 1u) * nx) xb_add(&bar[XB_TOPGEN], 1u);
            else XB_SPIN(xb_ld(&bar[XB_TOPGEN]) == tg, bar);
            __builtin_amdgcn_fence(__ATOMIC_ACQUIRE, "agent");
            xb_add(&bar[XB_XGEN(b.x)], 1u);
            asm volatile("s_waitcnt vmcnt(0)" ::: "memory");
        } else {
            XB_SPIN(xb_ld(&bar[XB_XGEN(b.x)]) == gen, bar);
            __builtin_amdgcn_fence(__ATOMIC_ACQUIRE, "agent");
            asm volatile("s_waitcnt vmcnt(0)" ::: "memory");
        }
    }
    __syncthreads();
}

namespace pg8 {
constexpr int BM = 256, BK = 64, HALF = 128, HTB = HALF * BK * 2, STAGE_BYTES = 8 * HTB, NXCD = 8, WGM = 8, KD = 1024;
__host__ __device__ __forceinline__ int lds_byte(int r, int c) { const int st = (r >> 4) * 2 + (c >> 5), rr = r & 15, cc = c & 31, ob = rr * 64 + cc * 2; return st * 1024 + (ob ^ (((ob >> 9) & 1) << 5)); }
__host__ __device__ __forceinline__ void stage_rc(int b, int& R, int& C) { const int st = b / 1024, sb = b % 1024, swz = sb ^ (((sb >> 9) & 1) << 5); R = (st >> 1) * 16 + swz / 64; C = (st & 1) * 32 + (swz % 64) / 2; }
__host__ __device__ __forceinline__ int perm32(int rho) { const int n = rho >> 4, i = rho & 15; return 8 * (i >> 2) + 4 * n + (i & 3); }

struct Unit { const char* a; const char* b; int i0, i1, i2, i3; };
template <int M> struct Frag { bf16x8 v[2]; };
template <> struct Frag<2> { v8i w; };

__device__ __forceinline__ bool tile_order(int i, int G, int c, int nM, int nN, int& pm, int& pn) {
    const int nwg = nM * nN; const long L = (long)i * G + c; if (L >= nwg) return false;
    int wgid = (int)L; { const int q = nwg / NXCD, r = nwg % NXCD, xcd = wgid % NXCD, off = wgid / NXCD; wgid = (xcd < r ? xcd * (q + 1) : r * (q + 1) + (xcd - r) * q) + off; }
    const int nig = WGM * nN, gid = wgid / nig, fm = gid * WGM, gsz = (nM - fm) < WGM ? (nM - fm) : WGM;
    pm = fm + ((wgid % nig) % gsz); pn = (wgid % nig) / gsz; return true;
}

template <class Epi, class Sched, bool ALIGN_EPI, bool SP2>
__device__ __forceinline__ void gemm_phase(LAS unsigned char* lds, const size_t hstepB, const Sched& S, const Epi& E) {
    typedef typename Epi::ACC ACC; constexpr int MODE = Epi::MODE;
    const int tid = threadIdx.x, wid = __builtin_amdgcn_readfirstlane(tid >> 6), lane = tid & 63, wr = wid >> 2, wc = wid & 3, fr = lane & 15, fq = lane >> 4;
    constexpr int ROWB = (MODE == 0) ? KD * 2 : KD;
    constexpr int nt = ROWB / 128;
    constexpr bool GATHER = Sched::GATHER;
    unsigned voffA[2], voffB[2]; int Rst[2], Cst[2];
#pragma unroll
    for (int i = 0; i < 2; ++i) { int R, C; stage_rc(tid * 16 + i * 8192, R, C); const int Rb = Epi::brow(R); Rst[i] = R; Cst[i] = C;
        voffA[i] = (unsigned)(R * ROWB + C * 2); voffB[i] = (unsigned)(Rb * ROWB + C * 2); }
    unsigned gc[4] = {0u, 0u, 0u, 0u}, gn[4] = {0u, 0u, 0u, 0u};
    const size_t kstep = (size_t)(BK * 2);
    const size_t hstepA = (size_t)HALF * ROWB;
    const unsigned ldsw = (unsigned)wid * 1024u;
    const int aoff = lds_byte(wr * 64 + fr, fq * 8), boff = lds_byte(wc * 32 + fr, fq * 8);
#define PG8_SA(b, h) (((b) * 2 + (h)) * HTB)
#define PG8_SB(b, h) ((4 + (b) * 2 + (h)) * HTB)
#define PG8_STAGE(bufoff, gbase, voff) do { _Pragma("unroll") for (int _i = 0; _i < 2; ++_i) \
        __builtin_amdgcn_global_load_lds((const unsigned*)((const char*)(gbase) + (voff)[_i]), (LAS unsigned*)(lds + (bufoff) + ldsw + _i * 8192), 16, 0, 0); } while (0)
#define PG8_STAGE4(bufoff, gbase, o0, o1) do { \
        __builtin_amdgcn_global_load_lds((const unsigned*)((const char*)(gbase) + (o0)), (LAS unsigned*)(lds + (bufoff) + ldsw), 16, 0, 0); \
        __builtin_amdgcn_global_load_lds((const unsigned*)((const char*)(gbase) + (o1)), (LAS unsigned*)(lds + (bufoff) + ldsw + 8192), 16, 0, 0); } while (0)
#define PG8_STAGEA(bufoff, p, h, g) do { if constexpr (GATHER) PG8_STAGE4(bufoff, p, (g)[2 * (h)], (g)[2 * (h) + 1]); else PG8_STAGE4(bufoff, (p) + (h) * hstepA, voffA[0], voffA[1]); } while (0)
#define PG8_LDA(dst, b, h) do { _Pragma("unroll") for (int m = 0; m < 4; ++m) { if constexpr (MODE == 2) { dst[m].w.lo = *(const LAS v4i*)(lds + PG8_SA(b, h) + aoff + m * 2048); dst[m].w.hi = *(const LAS v4i*)(lds + PG8_SA(b, h) + aoff + m * 2048 + 1024); } \
        else { dst[m].v[0] = *(const LAS bf16x8*)(lds + PG8_SA(b, h) + aoff + m * 2048); dst[m].v[1] = *(const LAS bf16x8*)(lds + PG8_SA(b, h) + aoff + m * 2048 + 1024); } } } while (0)
#define PG8_LDB(dst, b, h) do { _Pragma("unroll") for (int n = 0; n < 2; ++n) { if constexpr (MODE == 2) { dst[n].w.lo = *(const LAS v4i*)(lds + PG8_SB(b, h) + boff + n * 2048); dst[n].w.hi = *(const LAS v4i*)(lds + PG8_SB(b, h) + boff + n * 2048 + 1024); } \
        else { dst[n].v[0] = *(const LAS bf16x8*)(lds + PG8_SB(b, h) + boff + n * 2048); dst[n].v[1] = *(const LAS bf16x8*)(lds + PG8_SB(b, h) + boff + n * 2048 + 1024); } } } while (0)
#define PG8_MMA(ai, bj, At, Bt) do { __builtin_amdgcn_s_setprio(1); _Pragma("unroll") for (int m = 0; m < 4; ++m) _Pragma("unroll") for (int n = 0; n < 2; ++n) { \
        if constexpr (MODE == 0) { _Pragma("unroll") for (int k = 0; k < 2; ++k) acc[ai][bj][m][n] = __builtin_amdgcn_mfma_f32_16x16x32_bf16(Bt[n].v[k], At[m].v[k], acc[ai][bj][m][n], 0, 0, 0); } \
        else if constexpr (MODE == 1) { _Pragma("unroll") for (int k = 0; k < 2; ++k) acc[ai][bj][m][n] = __builtin_amdgcn_mfma_i32_16x16x64_i8(__builtin_bit_cast(v4i, Bt[n].v[k]), __builtin_bit_cast(v4i, At[m].v[k]), acc[ai][bj][m][n], 0, 0, 0); } \
        else { acc[ai][bj][m][n] = __builtin_amdgcn_mfma_scale_f32_16x16x128_f8f6f4(Bt[n].w, At[m].w, acc[ai][bj][m][n], 0, 0, 0, 0x7f7f7f7f, 0, 0x7f7f7f7f); } \
        } __builtin_amdgcn_s_setprio(0); } while (0)
#define PG8_WAIT_V(n) asm volatile("s_waitcnt vmcnt(" #n ")" ::: "memory")
#define PG8_WAIT_L(n) asm volatile("s_waitcnt lgkmcnt(" #n ")" ::: "memory")
#define PG8_BAR __builtin_amdgcn_s_barrier()
#define PG8_SCHED __builtin_amdgcn_sched_barrier(0)
    Unit cur, nxt, nn; int ui = 0;
    if (!S.next(0, cur)) return;
    bool has_next = S.next(1, nxt);
    if constexpr (GATHER) {
#pragma unroll
        for (int h = 0; h < 2; ++h)
#pragma unroll
            for (int i = 0; i < 2; ++i) { gc[2 * h + i] = (unsigned)S.row_src(cur, h * HALF + Rst[i]) * (unsigned)ROWB + (unsigned)(Cst[i] * 2);
                                          gn[2 * h + i] = has_next ? (unsigned)S.row_src(nxt, h * HALF + Rst[i]) * (unsigned)ROWB + (unsigned)(Cst[i] * 2) : 0u; }
    }
    ACC acc[2][2][4][2];
#pragma unroll
    for (int a = 0; a < 2; ++a)
#pragma unroll
        for (int b = 0; b < 2; ++b)
#pragma unroll
            for (int m = 0; m < 4; ++m)
#pragma unroll
                for (int n = 0; n < 2; ++n) acc[a][b][m][n] = (ACC){0, 0, 0, 0};
    Frag<MODE> At[4], B0[2], B1[2];
    const char* cA = cur.a; const char* cB = cur.b;
    if constexpr (SP2) {
        PG8_STAGE(PG8_SB(0, 0), cB, voffB); PG8_STAGE(PG8_SB(0, 1), cB + hstepB, voffB); PG8_STAGEA(PG8_SA(0, 0), cA, 0, gc); PG8_STAGEA(PG8_SA(0, 1), cA, 1, gc);
        if (wr == 1) PG8_BAR;
        PG8_WAIT_V(2); PG8_BAR;
        PG8_STAGE(PG8_SB(1, 0), cB + kstep, voffB); PG8_STAGEA(PG8_SA(1, 0), cA + kstep, 0, gc); PG8_STAGE(PG8_SB(1, 1), cB + hstepB + kstep, voffB);
        PG8_WAIT_V(6); PG8_BAR;
    } else {
        PG8_STAGE(PG8_SB(0, 0), cB, voffB); PG8_STAGEA(PG8_SA(0, 0), cA, 0, gc); PG8_STAGE(PG8_SB(0, 1), cB + hstepB, voffB); PG8_STAGEA(PG8_SA(0, 1), cA, 1, gc);
        if (wr == 1) PG8_BAR;
        PG8_WAIT_V(4); PG8_BAR;
        PG8_STAGE(PG8_SB(1, 0), cB + kstep, voffB); PG8_STAGEA(PG8_SA(1, 0), cA + kstep, 0, gc); PG8_STAGE(PG8_SB(1, 1), cB + hstepB + kstep, voffB);
        PG8_WAIT_V(6); PG8_BAR;
    }
    for (;;) {
        const char* nA = has_next ? nxt.a : cA; const char* nB = has_next ? nxt.b : cB;
        for (int t = 0; t < nt; t += 2) {
            const bool last = (t == nt - 2);
            const char* a1 = cA + (size_t)(t + 1) * kstep;
            const char* a2 = last ? nA : cA + (size_t)(t + 2) * kstep; const char* b2 = last ? nB : cB + (size_t)(t + 2) * kstep;
            const char* a3 = a2 + kstep; const char* b3 = b2 + kstep;
            unsigned g2[4];
#pragma unroll
            for (int i = 0; i < 4; ++i) g2[i] = (last && has_next) ? gn[i] : gc[i];
            if constexpr (SP2) {
            PG8_LDB(B0, 0, 0); PG8_LDB(B1, 0, 1); PG8_SCHED; PG8_LDA(At, 0, 0); PG8_STAGEA(PG8_SA(1, 1), a1, 1, gc);
            PG8_WAIT_V(8); PG8_WAIT_L(0); PG8_BAR; PG8_MMA(0, 0, At, B0); PG8_MMA(0, 1, At, B1); PG8_BAR; PG8_SCHED;
            PG8_LDA(At, 0, 1); PG8_STAGE(PG8_SB(0, 0), b2, voffB); PG8_STAGE(PG8_SB(0, 1), b2 + hstepB, voffB); PG8_STAGEA(PG8_SA(0, 0), a2, 0, g2);
            PG8_WAIT_V(8); PG8_WAIT_L(0); PG8_BAR; PG8_MMA(1, 0, At, B0); PG8_MMA(1, 1, At, B1); PG8_BAR; PG8_SCHED;
            PG8_LDB(B0, 1, 0); PG8_LDB(B1, 1, 1); PG8_SCHED; PG8_LDA(At, 1, 0); PG8_STAGEA(PG8_SA(0, 1), a2, 1, g2);
            PG8_WAIT_V(8); PG8_WAIT_L(0); PG8_BAR; PG8_MMA(0, 0, At, B0); PG8_MMA(0, 1, At, B1); PG8_BAR; PG8_SCHED;
            PG8_LDA(At, 1, 1); PG8_STAGE(PG8_SB(1, 0), b3, voffB); PG8_STAGE(PG8_SB(1, 1), b3 + hstepB, voffB); PG8_STAGEA(PG8_SA(1, 0), a3, 0, g2);
            PG8_WAIT_V(8); PG8_WAIT_L(0); PG8_BAR; PG8_MMA(1, 0, At, B0); PG8_MMA(1, 1, At, B1); PG8_BAR; PG8_SCHED;
            } else {
            PG8_LDB(B0, 0, 0); PG8_SCHED; PG8_LDA(At, 0, 0); PG8_STAGEA(PG8_SA(1, 1), a1, 1, gc);
            PG8_WAIT_L(8); PG8_BAR; PG8_WAIT_L(0); PG8_MMA(0, 0, At, B0); PG8_BAR; PG8_SCHED;
            PG8_LDB(B1, 0, 1); PG8_STAGE(PG8_SB(0, 0), b2, voffB);
            PG8_BAR; PG8_WAIT_L(0); PG8_MMA(0, 1, At, B1); PG8_BAR;
            PG8_LDA(At, 0, 1); PG8_STAGEA(PG8_SA(0, 0), a2, 0, g2);
            PG8_BAR; PG8_WAIT_L(0); PG8_MMA(1, 0, At, B0); PG8_BAR; PG8_SCHED;
            PG8_STAGE(PG8_SB(0, 1), b2 + hstepB, voffB);
            PG8_WAIT_V(6); PG8_BAR; PG8_MMA(1, 1, At, B1); PG8_BAR;
            PG8_LDB(B0, 1, 0); PG8_SCHED; PG8_LDA(At, 1, 0); PG8_STAGEA(PG8_SA(0, 1), a2, 1, g2);
            PG8_WAIT_L(8); PG8_BAR; PG8_WAIT_L(0); PG8_MMA(0, 0, At, B0); PG8_BAR; PG8_SCHED;
            PG8_LDB(B1, 1, 1); PG8_STAGE(PG8_SB(1, 0), b3, voffB);
            PG8_BAR; PG8_WAIT_L(0); PG8_MMA(0, 1, At, B1); PG8_BAR;
            PG8_LDA(At, 1, 1); PG8_STAGEA(PG8_SA(1, 0), a3, 0, g2);
            PG8_BAR; PG8_WAIT_L(0); PG8_MMA(1, 0, At, B0); PG8_BAR; PG8_SCHED;
            PG8_STAGE(PG8_SB(1, 1), b3 + hstepB, voffB);
            PG8_WAIT_V(6); PG8_BAR; PG8_MMA(1, 1, At, B1); PG8_BAR;
            }
        }
        if constexpr (ALIGN_EPI) { if (wr == 0) PG8_BAR; }
        const bool has_nn = has_next && S.next(ui + 2, nn);
        unsigned g3[4] = {0u, 0u, 0u, 0u};
        if constexpr (GATHER) { if (has_nn) {
#pragma unroll
            for (int h = 0; h < 2; ++h)
#pragma unroll
                for (int i = 0; i < 2; ++i) g3[2 * h + i] = (unsigned)S.row_src(nn, h * HALF + Rst[i]) * (unsigned)ROWB + (unsigned)(Cst[i] * 2); } }
        E(acc, cur, wr, wc, fr, fq);
        if constexpr (GATHER) asm volatile("" : "+v"(g3[0]), "+v"(g3[1]), "+v"(g3[2]), "+v"(g3[3]));
        if (!has_next) break;
#pragma unroll
        for (int a = 0; a < 2; ++a)
#pragma unroll
            for (int b = 0; b < 2; ++b)
#pragma unroll
                for (int m = 0; m < 4; ++m)
#pragma unroll
                    for (int n = 0; n < 2; ++n) acc[a][b][m][n] = (ACC){0, 0, 0, 0};
#pragma unroll
        for (int i = 0; i < 4; ++i) { gc[i] = gn[i]; gn[i] = g3[i]; }
        cur = nxt; cA = nA; cB = nB; ++ui; nxt = nn; has_next = has_nn;
        if constexpr (ALIGN_EPI) { if (wr == 1) PG8_BAR; }
    }
    PG8_WAIT_V(0);
    if constexpr (!ALIGN_EPI) { if (wr == 0) PG8_BAR; }
    PG8_BAR;
#undef PG8_SA
#undef PG8_SB
#undef PG8_STAGE
#undef PG8_STAGE4
#undef PG8_STAGEA
#undef PG8_LDA
#undef PG8_LDB
#undef PG8_MMA
#undef PG8_WAIT_V
#undef PG8_WAIT_L
#undef PG8_BAR
#undef PG8_SCHED
}
}

struct Args { const float* in[16]; float* out; unsigned char* ws; int ph_lo, ph_hi; int never, pad; };
struct Frame {
    LAS unsigned char* lds;
    gu32* ctl;
    int tid, lane, wave, G;
    const float *x, *norm_mix_g, *norm_ffn_g, *pool_w, *pool_scale, *w_qkv, *q_gain, *k_gain, *w_o, *rel_bias, *w_router, *b_router, *w_gu, *b_gu, *w_dn, *b_dn;
    float* out; unsigned char* ws;
};

__device__ __forceinline__ void transpose_item(const float* W, int K, int N, bf16* WT, LAS float* scr, int item, int lane) {
    const int nblk = N / 32, kb = item / nblk, nb = item % nblk, k0 = 64 * kb, n0 = 32 * nb;
#pragma unroll 8
    for (int i = 0; i < 32; ++i) { const int kk = 2 * i + (lane >> 5); scr[kk * 33 + (lane & 31)] = W[(size_t)(k0 + kk) * N + n0 + (lane & 31)]; }
    LDS_WAIT(); asm volatile("" ::: "memory");
    const int c = lane & 7;
#pragma unroll
    for (int j = 0; j < 4; ++j) { const int n = (lane >> 3) + 8 * j; const LAS float* s = scr + (8 * c) * 33 + n;
        u32x4 o; o.x = pk2(s[0 * 33], s[1 * 33]); o.y = pk2(s[2 * 33], s[3 * 33]); o.z = pk2(s[4 * 33], s[5 * 33]); o.w = pk2(s[6 * 33], s[7 * 33]);
        *(GAS u32x4*)(WT + (size_t)(n0 + n) * K + k0 + 8 * c) = o; }
    LDS_WAIT(); asm volatile("" ::: "memory");
}
__device__ __forceinline__ int slab_pos(int k, int n) { return k * 32 + ((n + (k >> 4) + (k & 3)) & 31); }
__device__ __forceinline__ void slab_load(const float* W, int N, int n0, int tid, f32x4 (&v)[16]) {
#pragma unroll
    for (int j = 0; j < 16; ++j) { const int i = tid + j * NTHREADS, k = i >> 3, c4 = i & 7; v[j] = __builtin_nontemporal_load((const GAS f32x4*)(W + (size_t)k * N + n0 + c4 * 4)); }
}
template <int FMT>
__device__ __forceinline__ void slab_store_lds(Frame& F, const f32x4 (&v)[16]) {
    LAS float* S = (LAS float*)F.lds;
#pragma unroll
    for (int j = 0; j < 16; ++j) { const int i = F.tid + j * NTHREADS, k = i >> 3, c4 = i & 7;
        S[slab_pos(k, c4 * 4 + 0)] = v[j].x; S[slab_pos(k, c4 * 4 + 1)] = v[j].y; S[slab_pos(k, c4 * 4 + 2)] = v[j].z; S[slab_pos(k, c4 * 4 + 3)] = v[j].w; }
}
template <int FMT>
__device__ __forceinline__ void slab_process(Frame& F, int n0, unsigned char* Q, float* SC) {
    LAS float* S = (LAS float*)F.lds;
    LAS float* red = (LAS float*)(F.lds + L_SLOTE);
    LAS float* scl = (LAS float*)(F.lds + L_HIST);
    const int tid = F.tid;
    { const int n = tid & 31, part = tid >> 5; float am = 0.f;
#pragma unroll 8
      for (int kk = 0; kk < 64; ++kk) am = fmaxf(am, fabsf(S[slab_pos(part * 64 + kk, n)]));
      am = fmaxf(am, __shfl_xor(am, 32));
      if (F.lane < 32) red[F.wave * 32 + n] = am; }
    __syncthreads();
    if (tid < 32) { float am = 0.f;
#pragma unroll
        for (int w = 0; w < 8; ++w) am = fmaxf(am, red[w * 32 + tid]);
        float qs, inv;
        if (FMT == 1) { qs = am > 0.f ? 127.f / am : 0.f; inv = am * (1.f / 127.f); }
        else { int ex = 0; (void)frexpf(am > 0.f ? am : 1.f, &ex); qs = ldexpf(1.f, 7 - ex); inv = ldexpf(1.f, ex - 7); }
        scl[tid] = qs; SC[n0 + tid] = inv; }
    __syncthreads();
#pragma unroll
    for (int it = 0; it < 4; ++it) {
        const int n = (tid >> 6) + 8 * it, c = tid & 63; const float qs = scl[n];
        float v[16];
#pragma unroll
        for (int i = 0; i < 16; ++i) v[i] = S[slab_pos(16 * c + i, n)] * qs;
        u32x4 o;
        if (FMT == 1) {
#pragma unroll
            for (int d = 0; d < 4; ++d) { const int q0 = (int)rintf(v[4 * d]), q1 = (int)rintf(v[4 * d + 1]), q2 = (int)rintf(v[4 * d + 2]), q3 = (int)rintf(v[4 * d + 3]);
                o[d] = (unsigned)(q0 & 255) | ((unsigned)(q1 & 255) << 8) | ((unsigned)(q2 & 255) << 16) | ((unsigned)q3 << 24); }
        } else {
#pragma unroll
            for (int d = 0; d < 4; ++d) { int w = __builtin_amdgcn_cvt_pk_fp8_f32(v[4 * d], v[4 * d + 1], 0, false); w = __builtin_amdgcn_cvt_pk_fp8_f32(v[4 * d + 2], v[4 * d + 3], w, true); o[d] = (unsigned)w; }
        }
        *(GAS u32x4*)(Q + (size_t)(n0 + n) * 1024 + 16 * c) = o;
    }
    __syncthreads();
}
struct SlabDesc { const float* W; int N, n0; unsigned char* Q; float* SC; };
__device__ __forceinline__ SlabDesc slab_desc(Frame& F, int sl) {
    constexpr int S_GU = 64 * 64;
    SlabDesc d;
    if (sl < S_GU) { const int mat = sl >> 6; d.W = F.w_gu + (size_t)mat * 1024 * 2048; d.N = 2048; d.n0 = (sl & 63) * 32; d.Q = F.ws + WS_WGU + (size_t)mat * 2048 * 1024; d.SC = (float*)(F.ws + WS_SC_GU) + mat * 2048; }
    else { d.W = F.w_qkv; d.N = NQKV; d.n0 = (sl - S_GU) * 32; d.Q = F.ws + WS_WQKV; d.SC = (float*)(F.ws + WS_SC_QKV); }
    return d;
}
__device__ __forceinline__ void phase_convert(Frame& F) {
    constexpr int NSLAB = 64 * 64 + 288;
    {
        f32x4 v[16];
        int sl = blockIdx.x;
        if (sl < NSLAB) { const SlabDesc d = slab_desc(F, sl); slab_load(d.W, d.N, d.n0, F.tid, v); }
        for (; sl < NSLAB; sl += F.G) {
            const SlabDesc d = slab_desc(F, sl);
            slab_store_lds<1>(F, v);
            __syncthreads();
            if (sl + F.G < NSLAB) { const SlabDesc dn = slab_desc(F, sl + F.G); slab_load(dn.W, dn.N, dn.n0, F.tid, v); }
            slab_process<1>(F, d.n0, d.Q, d.SC);
        }
    }
    LAS float* scr = (LAS float*)(F.lds + F.wave * 16384);
    const int gw = blockIdx.x * NWAVES + F.wave, NGW = F.G * NWAVES;
    constexpr int I_DN = 64 * 512, I_WO = 512, I_POOL = 4 * 32;
    constexpr int NITEMS = I_DN + I_WO + I_POOL;
    for (int it = gw; it < NITEMS; it += NGW) {
        int r = it;
        if (r < I_DN) { const int mat = r >> 9; transpose_item(F.w_dn + (size_t)mat * 1024 * 1024, 1024, 1024, (bf16*)(F.ws + WS_WDN) + (size_t)mat * 1024 * 1024, scr, r & 511, F.lane); continue; } r -= I_DN;
        if (r < I_WO) { transpose_item(F.w_o, 1024, 1024, (bf16*)(F.ws + WS_WO), scr, r, F.lane); continue; } r -= I_WO;
        { const int mat = r >> 5; transpose_item(F.pool_w + (size_t)mat * 65536, 256, 256, (bf16*)(F.ws + WS_WPOOL) + (size_t)mat * 65536, scr, r & 31, F.lane); }
    }
    float* wrt = (float*)(F.ws + WS_WRT);
    for (int i = blockIdx.x * NTHREADS + F.tid; i < 2 * 32 * 1024; i += F.G * NTHREADS) wrt[i] = F.w_router[i] * F.norm_ffn_g[i >> 5];
}

__device__ __forceinline__ void quant_row_i8(const f32x4 (&h)[4], unsigned (&w)[4], float& inv) {
    float am = 0.f;
#pragma unroll
    for (int j = 0; j < 4; ++j) am = fmaxf(fmaxf(am, fmaxf(fabsf(h[j].x), fabsf(h[j].y))), fmaxf(fabsf(h[j].z), fabsf(h[j].w)));
#pragma unroll
    for (int o = 1; o < 64; o <<= 1) am = fmaxf(am, __shfl_xor(am, o));
    const float qs = am > 0.f ? 127.f / am : 0.f; inv = am * (1.f / 127.f);
#pragma unroll
    for (int j = 0; j < 4; ++j) { const int q0 = (int)rintf(h[j].x * qs), q1 = (int)rintf(h[j].y * qs), q2 = (int)rintf(h[j].z * qs), q3 = (int)rintf(h[j].w * qs);
        w[j] = (unsigned)(q0 & 255) | ((unsigned)(q1 & 255) << 8) | ((unsigned)(q2 & 255) << 16) | ((unsigned)q3 << 24); }
}

__device__ __forceinline__ void router_tile(Frame& F, int layer, int tok0, bool dry) {
    LAS int* hist = (LAS int*)(F.lds + L_HIST); LAS int* base = (LAS int*)(F.lds + L_BASE);
    LAS int* slot_e = (LAS int*)(F.lds + L_SLOTE); LAS int* slot_p = (LAS int*)(F.lds + L_SLOTP); LAS float* slot_g = (LAS float*)(F.lds + L_SLOTG);
    LAS float* rstdL = (LAS float*)(F.lds + L_RSTD);
    LAS float* part = (LAS float*)F.lds;
    const int lane = F.lane, wave = F.wave;
    if (F.tid < 32) hist[F.tid] = 0;
    const float* g2 = F.norm_ffn_g + layer * 1024;
    unsigned char* H2 = F.ws + WS_H2; float* HS = (float*)(F.ws + WS_HS);
    {
        f32x4 gv[4];
#pragma unroll
        for (int j = 0; j < 4; ++j) gv[j] = *(const f32x4*)(g2 + lane * 4 + 256 * j);
#pragma unroll 1
        for (int half = 0; half < 2; ++half) {
            f32x4 h[4][4];
#pragma unroll
            for (int r = 0; r < 4; ++r) { const GAS f32x4* xr = (const GAS f32x4*)(F.out + (size_t)(tok0 + wave * 8 + half * 4 + r) * 1024) + lane;
#pragma unroll
                for (int j = 0; j < 4; ++j) h[r][j] = xr[64 * j]; }
#pragma unroll
            for (int r = 0; r < 4; ++r) {
                const int row = wave * 8 + half * 4 + r, tok = tok0 + row;
                float ss = 0.f;
#pragma unroll
                for (int j = 0; j < 4; ++j) ss += (h[r][j].x * h[r][j].x + h[r][j].y * h[r][j].y) + (h[r][j].z * h[r][j].z + h[r][j].w * h[r][j].w);
                const float rstd = rsqrtf(wave_sum(ss) * (1.f / 1024.f) + EPS);
#pragma unroll
                for (int j = 0; j < 4; ++j) h[r][j] = h[r][j] * rstd * gv[j];
                unsigned qw[4]; float inv; quant_row_i8(h[r], qw, inv);
                GAS unsigned* o4 = (GAS unsigned*)(H2 + (size_t)tok * 1024) + lane;
#pragma unroll
                for (int j = 0; j < 4; ++j) o4[64 * j] = qw[j];
                if (lane == 0) { HS[tok] = inv; rstdL[row] = rstd; }
            }
        }
    }
    {
        __syncthreads();
        const float* wrg = (const float*)(F.ws + WS_WRT) + (size_t)layer * 32 * 1024;
        LAS float* img = (LAS float*)(F.lds) + wave * (32 * 128);
        const int r = lane & 31, kh = lane >> 5;
        const GAS float* wb = (const GAS float*)(wrg + (size_t)(128 * wave + kh) * 32 + r);
        f32x16 acc0, acc1;
#pragma unroll
        for (int i = 0; i < 16; ++i) { acc0[i] = 0.f; acc1[i] = 0.f; }
#define ROUTER_HALF(half, ACC_) do { \
            f32x4 ld[16]; \
            _Pragma("unroll") for (int j = 0; j < 16; ++j) ld[j] = *((const GAS f32x4*)(F.out + (size_t)(tok0 + (half) * 32 + 2 * j + kh) * 1024 + 128 * wave) + r); \
            _Pragma("unroll") for (int j = 0; j < 16; ++j) *(LAS f32x4*)(img + (2 * j + kh) * 128 + 4 * ((r + 2 * j + kh) & 31)) = ld[j]; \
            _Pragma("unroll 8") for (int s4 = 0; s4 < 32; ++s4) { \
                const LAS float* ap = img + r * 128 + 4 * ((s4 + r) & 31); \
                const f32x2 a01 = *(const LAS f32x2*)(ap), a23 = *(const LAS f32x2*)(ap + 2); \
                const float b0 = wb[(2 * s4) * 64], b1 = wb[(2 * s4 + 1) * 64]; \
                ACC_ = __builtin_amdgcn_mfma_f32_32x32x2f32(kh ? a01.y : a01.x, b0, ACC_, 0, 0, 0); ACC_ = __builtin_amdgcn_mfma_f32_32x32x2f32(kh ? a23.y : a23.x, b1, ACC_, 0, 0, 0); } } while (0)
        ROUTER_HALF(0, acc0);
        ROUTER_HALF(1, acc1);
#undef ROUTER_HALF
        __syncthreads();
#pragma unroll
        for (int rg = 0; rg < 16; ++rg) { const int row = (rg & 3) + 8 * (rg >> 2) + 4 * kh;
            part[(wave * 64 + row) * 32 + r] = acc0[rg]; part[(wave * 64 + 32 + row) * 32 + r] = acc1[rg]; }
    }
    __syncthreads();
    {
        const int e = lane & 31, kh = lane >> 5;
        const float brl = F.b_router[layer * 32 + e];
#pragma unroll 1
        for (int rr = 0; rr < 4; ++rr) {
            const int row = wave * 8 + rr + 4 * kh;
            float v = 0.f;
#pragma unroll
            for (int w = 0; w < 8; ++w) v += part[(w * 64 + row) * 32 + e];
            v = v * rstdL[row] + brl;
            float tv[4]; int ti[4];
#pragma unroll
            for (int k = 0; k < 4; ++k) {
                float bv = v; int bi = e;
#pragma unroll
                for (int off = 16; off >= 1; off >>= 1) { const float ov = __shfl_xor(bv, off); const int oi = __shfl_xor(bi, off); if (ov > bv || (ov == bv && oi < bi)) { bv = ov; bi = oi; } }
                tv[k] = bv; ti[k] = bi; if (e == bi) v = -INFINITY;
            }
            const float e1 = __expf(tv[1] - tv[0]), e2 = __expf(tv[2] - tv[0]), e3 = __expf(tv[3] - tv[0]);
            const float inv = 1.f / (1.f + e1 + e2 + e3);
            if (e < 4) {
                const int ex = e == 0 ? ti[0] : e == 1 ? ti[1] : e == 2 ? ti[2] : ti[3];
                const float gt = (e == 0 ? 1.f : e == 1 ? e1 : e == 2 ? e2 : e3) * inv;
                const int lp = atomicAdd((int*)(hist + ex), 1);
                const int sl = row * 4 + e;
                slot_e[sl] = ex; slot_p[sl] = lp; slot_g[sl] = gt;
            }
        }
    }
    __syncthreads();
    if (dry) return;
    if (F.tid < 32) base[F.tid] = (int)__hip_atomic_fetch_add((unsigned*)(F.ctl + CW_CNT + layer * 32 + F.tid), (unsigned)hist[F.tid], RLX_AGENT);
    __syncthreads();
    if (F.tid < 256) {
        const int e = slot_e[F.tid]; const int pos = base[e] + slot_p[F.tid];
        ((int*)(F.ws + WS_ROWSLOT))[e * CAP + pos] = (tok0 + (F.tid >> 2)) * 4 + (F.tid & 3);
        ((float*)(F.ws + WS_ROWGATE))[e * CAP + pos] = slot_g[F.tid];
        ((float*)(F.ws + WS_ROWHS))[e * CAP + pos] = ((const float*)(F.ws + WS_HS))[tok0 + (F.tid >> 2)];
    }
    __syncthreads();
}

__device__ __forceinline__ int pswz(int r, int c) { return r * 2048 + ((((c >> 3) ^ (r & 7)) << 4) | ((c & 7) << 1)); }
template <int W>
__device__ __forceinline__ void pool_chunk(const f32x2 (&v)[8], int sc, int s0, const LAS float* rstd1, float gx, float gy, float (&rx)[W], float (&ry)[W], LAS unsigned char* P, int tid) {
#pragma unroll
    for (int j = 0; j < 8; ++j) {
        const int tl = sc * 8 + j; const float r = rstd1[16 + tl];
        const float hx = v[j].x * r * gx, hy = v[j].y * r * gy;
        constexpr int WM = W < 8 ? W : 8;
        if (W <= 8) { rx[j % WM] = hx; ry[j % WM] = hy; }
        else { if (sc & 1) { rx[(8 + j) % W] = hx; ry[(8 + j) % W] = hy; } else { rx[j % W] = hx; ry[j % W] = hy; } }
        float sx = 0.f, sy = 0.f;
#pragma unroll
        for (int q = 0; q < W; ++q) { sx += rx[q]; sy += ry[q]; }
        const int s = s0 + tl; const int cn = (s + 1 < W) ? (s + 1) : W; const float inv = 1.f / (float)cn;
        *(LAS unsigned*)(P + pswz(tl, 2 * tid)) = pk2(sx * inv - hx, sy * inv - hy);
    }
}
template <int W>
__device__ __forceinline__ void pool_window(const float* __restrict__ x, int tok0, int s0, const LAS float* rstd1, float gx, float gy, LAS unsigned char* P, int tid) {
    float rx[W], ry[W];
    const GAS f32x2* xp = (const GAS f32x2*)x + tid;
    const bool hist = s0 > 0;
    {
        const GAS f32x2* pw = xp + (size_t)(hist ? tok0 - W : tok0) * 512;
#pragma unroll
        for (int j = 0; j < W; ++j) { const f32x2 v = pw[(size_t)j * 512]; const float r = hist ? rstd1[16 - W + j] : 0.f; rx[j] = v.x * r * gx; ry[j] = v.y * r * gy; }
    }
    f32x2 va[8];
    { const GAS f32x2* p0 = xp + (size_t)tok0 * 512;
#pragma unroll
      for (int j = 0; j < 8; ++j) va[j] = p0[(size_t)j * 512]; }
#pragma unroll 2
    for (int sc = 0; sc < 8; ++sc) {
        f32x2 vb[8];
        const GAS f32x2* pn = xp + (size_t)(tok0 + 8 * (sc < 7 ? sc + 1 : 7)) * 512;
#pragma unroll
        for (int j = 0; j < 8; ++j) vb[j] = pn[(size_t)j * 512];
        pool_chunk<W>(va, sc, s0, rstd1, gx, gy, rx, ry, P, tid);
#pragma unroll
        for (int j = 0; j < 8; ++j) va[j] = vb[j];
    }
}
__device__ __forceinline__ void phase_pool(Frame& F, bool dry) {
    LAS unsigned char* P = F.lds;
    LAS float* rstd1 = (LAS float*)(F.lds + L_RSTD);
    const int lane = F.lane, wave = F.wave, tid = F.tid;
    const int fr = lane & 15, fq = lane >> 4;
    const float* __restrict__ xin = F.x; float* __restrict__ xo = F.out;
    for (int tile = blockIdx.x; tile < NTOK / 64; tile += F.G) {
        const int tok0 = tile * 64, s0 = tok0 & (SEQ - 1);
#pragma unroll 1
        for (int hb = 0; hb < 2; ++hb) {
            f32x4 v[5][4];
#pragma unroll
            for (int k = 0; k < 5; ++k) { const int rr = wave + 8 * (5 * hb + k); const bool ok = (s0 - 16 + rr) >= 0;
                const GAS f32x4* xr = (const GAS f32x4*)(xin + (size_t)(ok ? tok0 - 16 + rr : tok0) * 1024) + lane;
#pragma unroll
                for (int j = 0; j < 4; ++j) v[k][j] = xr[64 * j]; }
#pragma unroll
            for (int k = 0; k < 5; ++k) { const int rr = wave + 8 * (5 * hb + k); const bool ok = (s0 - 16 + rr) >= 0; float ss = 0.f;
#pragma unroll
                for (int j = 0; j < 4; ++j) ss += (v[k][j].x * v[k][j].x + v[k][j].y * v[k][j].y) + (v[k][j].z * v[k][j].z + v[k][j].w * v[k][j].w);
                const float r = rsqrtf(wave_sum(ss) * (1.f / 1024.f) + EPS);
                if (lane == 0) rstd1[rr] = ok ? r : 0.f; }
        }
        __syncthreads();
        { const float gx = F.norm_mix_g[2 * tid], gy = F.norm_mix_g[2 * tid + 1];
          const int grp = wave >> 1;
          if (grp == 0) pool_window<2>(xin, tok0, s0, rstd1, gx, gy, P, tid);
          else if (grp == 1) pool_window<4>(xin, tok0, s0, rstd1, gx, gy, P, tid);
          else if (grp == 2) pool_window<8>(xin, tok0, s0, rstd1, gx, gy, P, tid);
          else pool_window<16>(xin, tok0, s0, rstd1, gx, gy, P, tid); }
        __syncthreads();
        { const int gi = wave >> 1, nh = wave & 1;
#pragma unroll 1
          for (int np = 0; np < 2; ++np) {
              const bf16* Wt = (const bf16*)(F.ws + WS_WPOOL) + (size_t)gi * 65536 + (size_t)(nh * 128 + np * 64) * 256;
              f32x4 acc[4][4];
#pragma unroll
              for (int m = 0; m < 4; ++m)
#pragma unroll
                  for (int n = 0; n < 4; ++n) acc[m][n] = (f32x4){0.f, 0.f, 0.f, 0.f};
#pragma unroll 4
              for (int ks = 0; ks < 8; ++ks) {
                  bf16x8 a[4];
#pragma unroll
                  for (int m = 0; m < 4; ++m) a[m] = *(const LAS bf16x8*)(P + pswz(m * 16 + fr, gi * 256 + ks * 32 + fq * 8));
#pragma unroll
                  for (int n = 0; n < 4; ++n) {
                      const bf16x8 b = *(const GAS bf16x8*)(Wt + (size_t)(n * 16 + fr) * 256 + ks * 32 + fq * 8);
#pragma unroll
                      for (int m = 0; m < 4; ++m) acc[m][n] = __builtin_amdgcn_mfma_f32_16x16x32_bf16(b, a[m], acc[m][n], 0, 0, 0);
                  }
              }
              const int colb = gi * 256 + nh * 128 + np * 64 + fq * 4;
              f32x4 xv[4][4], sc[4];
#pragma unroll
              for (int n = 0; n < 4; ++n) { sc[n] = *(const f32x4*)(F.pool_scale + colb + n * 16);
#pragma unroll
                  for (int m = 0; m < 4; ++m) xv[n][m] = *(const GAS f32x4*)(xin + (size_t)(tok0 + m * 16 + fr) * 1024 + colb + n * 16); }
#pragma unroll
              for (int n = 0; n < 4; ++n)
#pragma unroll
                  for (int m = 0; m < 4; ++m) *(GAS f32x4*)(xo + (size_t)(tok0 + m * 16 + fr) * 1024 + colb + n * 16) = xv[n][m] + acc[m][n] * sc[n];
          }
        }
    }
    VM_WAIT();
    __syncthreads();
    for (int tile = blockIdx.x; tile < NTOK / 64; tile += F.G) router_tile(F, 0, tile * 64, dry);
}
__device__ __forceinline__ void phase_router(Frame& F, int layer, bool dry) {
    for (int tile = blockIdx.x; tile < NTOK / 64; tile += F.G) router_tile(F, layer, tile * 64, dry);
}

__device__ __forceinline__ void moe_tables(Frame& F, int layer) {
    LAS int* cntL = (LAS int*)(F.lds + L_CNT); LAS int* prow0 = (LAS int*)(F.lds + L_PROW0); LAS int* ntp = (LAS int*)(F.lds + L_NT);
    LAS int* tileE = (LAS int*)(F.lds + L_TILEE); LAS int* tileRow = (LAS int*)(F.lds + L_TILEROW);
    __syncthreads();
    if (F.tid < 64) {
        int c = 0;
        if (F.tid < 32) { c = (int)__hip_atomic_load((unsigned*)(F.ctl + CW_CNT + layer * 32 + F.tid), RLX_AGENT); if (c > CAP) c = CAP; }
        const int mt = (c + 255) >> 8;
        int incl = mt;
#pragma unroll
        for (int o = 1; o < 32; o <<= 1) { const int v = __shfl_up(incl, o); if ((F.tid & 63) >= o) incl += v; }
        const int excl = incl - mt;
        if (F.tid < 32) {
            cntL[F.tid] = c; prow0[F.tid] = excl * 256;
            for (int m = 0; m < mt; ++m) if (excl + m < MAXT) { tileE[excl + m] = F.tid; tileRow[excl + m] = (excl + m) * 256; }
            if (F.tid == 31) ntp[0] = incl < MAXT ? incl : MAXT;
        }
    }
    __syncthreads();
}

template <bool GATH>
struct MoeOrderT {
    static constexpr bool GATHER = GATH;
    int NT, nN, G, c; const LAS int* tileE; const LAS int* tileRow; const LAS int* cntL; const LAS int* prow0; const int* rowslot;
    const char* Abase; const char* Bbase; size_t bExp, bTile; int aPitch;
    __device__ __forceinline__ bool next(int i, pg8::Unit& u) const {
        int T, pn; if (!pg8::tile_order(i, G, c, NT, nN, T, pn)) return false;
        const int e = tileE[T], row0 = tileRow[T];
        u.a = GATH ? Abase : Abase + (size_t)row0 * aPitch; u.b = Bbase + (size_t)e * bExp + (size_t)pn * bTile; u.i0 = T; u.i1 = pn; u.i2 = e; u.i3 = row0; return true;
    }
    __device__ __forceinline__ int row_src(const pg8::Unit& u, int r) const {
        const int e = u.i2, cn = cntL[e]; int pos = u.i3 - prow0[e] + r; pos = pos < cn ? pos : cn - 1;
        return rowslot[e * CAP + pos] >> 2;
    }
};
struct EpiGU {
    typedef v4i ACC; static constexpr int MODE = 1;
    static __host__ __device__ __forceinline__ int brow(int R) { return (R & ~31) + pg8::perm32(R & 31); }
    bf16* ACT; const float* bgu; const float* wsc; const float* rowhs; const LAS int* prow0;
    __device__ __forceinline__ void operator()(const v4i (&acc)[2][2][4][2], const pg8::Unit& u, int wr, int wc, int fr, int fq) const {
        const int e = u.i2, f0 = u.i1 * 128 + wc * 32 + 8 * fq;
        const float* bg = bgu + (size_t)e * 2048 + f0; const float* sp = wsc + (size_t)e * 2048 + f0;
        const f32x4 bg0 = *(const f32x4*)(bg), bg1 = *(const f32x4*)(bg + 4), bu0 = *(const f32x4*)(bg + 1024), bu1 = *(const f32x4*)(bg + 1028);
        const f32x4 sg0 = *(const f32x4*)(sp), sg1 = *(const f32x4*)(sp + 4), su0 = *(const f32x4*)(sp + 1024), su1 = *(const f32x4*)(sp + 1028);
        const int pbase = u.i3 - prow0[e];
        float rsv[2][4];
#pragma unroll
        for (int ai = 0; ai < 2; ++ai)
#pragma unroll
            for (int m = 0; m < 4; ++m) rsv[ai][m] = rowhs[e * CAP + pbase + ai * 128 + wr * 64 + m * 16 + fr];
#pragma unroll
        for (int ai = 0; ai < 2; ++ai)
#pragma unroll
            for (int m = 0; m < 4; ++m) {
                const int prow = u.i3 + ai * 128 + wr * 64 + m * 16 + fr; const float rs = rsv[ai][m];
                const f32x4 ga[2] = {__builtin_convertvector(acc[ai][0][m][0], f32x4), __builtin_convertvector(acc[ai][0][m][1], f32x4)};
                const f32x4 ua[2] = {__builtin_convertvector(acc[ai][1][m][0], f32x4), __builtin_convertvector(acc[ai][1][m][1], f32x4)};
                const f32x4 sgr[2] = {sg0 * rs, sg1 * rs}, sur[2] = {su0 * rs, su1 * rs}, bgv[2] = {bg0, bg1}, buv[2] = {bu0 + 1.f, bu1 + 1.f};
                float o[8];
#pragma unroll
                for (int h = 0; h < 2; ++h)
#pragma unroll
                    for (int p = 0; p < 2; ++p) {
                        f32x2 g = (f32x2){ga[h][2 * p], ga[h][2 * p + 1]} * (f32x2){sgr[h][2 * p], sgr[h][2 * p + 1]} + (f32x2){bgv[h][2 * p], bgv[h][2 * p + 1]};
                        f32x2 u1 = (f32x2){ua[h][2 * p], ua[h][2 * p + 1]} * (f32x2){sur[h][2 * p], sur[h][2 * p + 1]} + (f32x2){buv[h][2 * p], buv[h][2 * p + 1]};
                        g.x = fminf(g.x, 7.f); g.y = fminf(g.y, 7.f);
                        u1.x = __builtin_amdgcn_fmed3f(u1.x, -6.f, 8.f); u1.y = __builtin_amdgcn_fmed3f(u1.y, -6.f, 8.f);
                        const f32x2 t = g * (-1.702f * 1.4426950408889634f);
                        f32x2 e; e.x = __builtin_amdgcn_exp2f(t.x); e.y = __builtin_amdgcn_exp2f(t.y);
                        const f32x2 d = e + 1.f;
                        f32x2 rcp; rcp.x = __builtin_amdgcn_rcpf(d.x); rcp.y = __builtin_amdgcn_rcpf(d.y);
                        const f32x2 r2 = (g * rcp) * u1;
                        o[4 * h + 2 * p] = r2.x; o[4 * h + 2 * p + 1] = r2.y;
                    }
                u32x4 w; w.x = cvt_pk_bf16(o[0], o[1]); w.y = cvt_pk_bf16(o[2], o[3]); w.z = cvt_pk_bf16(o[4], o[5]); w.w = cvt_pk_bf16(o[6], o[7]);
                *(GAS u32x4*)(ACT + (size_t)prow * 1024 + f0) = w;
            }
    }
};
struct EpiDN {
    typedef f32x4 ACC; static constexpr int MODE = 0;
    static __host__ __device__ __forceinline__ int brow(int R) { return (R & ~31) + pg8::perm32(R & 31); }
    bf16* Y; const float* bdn; const float* wsc; const int* rowslot; const float* rowgate; const LAS int* cntL; const LAS int* prow0;
    __device__ __forceinline__ void operator()(const f32x4 (&acc)[2][2][4][2], const pg8::Unit& u, int wr, int wc, int fr, int fq) const {
        const int e = u.i2, col0 = u.i1 * 256 + wc * 32 + 8 * fq;
        const float* bp = bdn + (size_t)e * 1024 + col0;
        f32x4 bv[2][2];
#pragma unroll
        for (int bj = 0; bj < 2; ++bj)
#pragma unroll
            for (int n = 0; n < 2; ++n) bv[bj][n] = *(const f32x4*)(bp + bj * 128 + 4 * n);
        const int pbase = u.i3 - prow0[e], cn = cntL[e];
        int slotv[2][4]; float gtv[2][4];
#pragma unroll
        for (int ai = 0; ai < 2; ++ai)
#pragma unroll
            for (int m = 0; m < 4; ++m) { const int pos = pbase + ai * 128 + wr * 64 + m * 16 + fr; const int pc = pos < cn ? pos : 0;
                slotv[ai][m] = rowslot[e * CAP + pc]; gtv[ai][m] = rowgate[e * CAP + pc]; }
#pragma unroll
        for (int ai = 0; ai < 2; ++ai)
#pragma unroll
            for (int m = 0; m < 4; ++m) {
                const int pos = pbase + ai * 128 + wr * 64 + m * 16 + fr;
                if (pos < cn) {
                    const float gt = gtv[ai][m];
                    bf16* rowp = Y + (size_t)slotv[ai][m] * 1024 + col0;
#pragma unroll
                    for (int bj = 0; bj < 2; ++bj) {
                        const f32x4 v0 = (acc[ai][bj][m][0] + bv[bj][0]) * gt, v1 = (acc[ai][bj][m][1] + bv[bj][1]) * gt;
                        u32x4 w; w.x = cvt_pk_bf16(v0[0], v0[1]); w.y = cvt_pk_bf16(v0[2], v0[3]); w.z = cvt_pk_bf16(v1[0], v1[1]); w.w = cvt_pk_bf16(v1[2], v1[3]);
                        *(GAS u32x4*)(rowp + bj * 128) = w;
                    }
                }
            }
    }
};
__device__ __forceinline__ void phase_moe_gu(Frame& F, int layer) {
    moe_tables(F, layer);
    typedef MoeOrderT<true> Ord;
    Ord S; S.NT = *(const LAS int*)(F.lds + L_NT); S.nN = 8; S.G = F.G; S.c = blockIdx.x; S.tileE = (const LAS int*)(F.lds + L_TILEE); S.tileRow = (const LAS int*)(F.lds + L_TILEROW);
    S.cntL = (const LAS int*)(F.lds + L_CNT); S.prow0 = (const LAS int*)(F.lds + L_PROW0); S.rowslot = (const int*)(F.ws + WS_ROWSLOT);
    S.Abase = (const char*)(F.ws + WS_H2); S.Bbase = (const char*)(F.ws + WS_WGU) + (size_t)layer * 32 * 2048 * 1024; S.bExp = (size_t)2048 * 1024; S.bTile = (size_t)128 * 1024; S.aPitch = 1024;
    EpiGU E; E.ACT = (bf16*)(F.ws + WS_ACT); E.bgu = F.b_gu + (size_t)layer * 32 * 2048; E.wsc = (const float*)(F.ws + WS_SC_GU) + (size_t)layer * 32 * 2048; E.rowhs = (const float*)(F.ws + WS_ROWHS);
    E.prow0 = (const LAS int*)(F.lds + L_PROW0);
    pg8::gemm_phase<EpiGU, Ord, true, true>(F.lds, (size_t)1024 * 1024, S, E);
}
__device__ __forceinline__ void phase_moe_dn(Frame& F, int layer) {
    moe_tables(F, layer);
    typedef MoeOrderT<false> Ord;
    Ord S; S.NT = *(const LAS int*)(F.lds + L_NT); S.nN = 4; S.G = F.G; S.c = blockIdx.x; S.tileE = (const LAS int*)(F.lds + L_TILEE); S.tileRow = (const LAS int*)(F.lds + L_TILEROW);
    S.cntL = (const LAS int*)(F.lds + L_CNT); S.prow0 = (const LAS int*)(F.lds + L_PROW0); S.rowslot = (const int*)(F.ws + WS_ROWSLOT);
    S.Abase = (const char*)(F.ws + WS_ACT); S.Bbase = (const char*)(F.ws + WS_WDN) + (size_t)layer * 32 * 1024 * 1024 * 2; S.bExp = (size_t)1024 * 1024 * 2; S.bTile = (size_t)256 * 1024 * 2; S.aPitch = 2048;
    EpiDN E; E.Y = (bf16*)(F.ws + WS_Y); E.bdn = F.b_dn + (size_t)layer * 32 * 1024; E.wsc = (const float*)(F.ws + WS_SC_DN) + (size_t)layer * 32 * 1024;
    E.rowslot = (const int*)(F.ws + WS_ROWSLOT); E.rowgate = (const float*)(F.ws + WS_ROWGATE);
    E.cntL = (const LAS int*)(F.lds + L_CNT); E.prow0 = (const LAS int*)(F.lds + L_PROW0);
    pg8::gemm_phase<EpiDN, Ord, true, true>(F.lds, (size_t)128 * 1024 * 2, S, E);
}

__device__ __forceinline__ void phase_combine(Frame& F, int layer, bool dry) {
    float* xout = dry ? (float*)(F.ws + WS_BIG + 144 * MiB) : F.out;
    const int gw = blockIdx.x * NWAVES + F.wave, NGW = F.G * NWAVES, lane = F.lane;
    const bf16* Y = (const bf16*)(F.ws + WS_Y); unsigned char* H2 = F.ws + WS_H2; float* HS = (float*)(F.ws + WS_HS);
    f32x4 gv[4];
#pragma unroll
    for (int j = 0; j < 4; ++j) gv[j] = *(const f32x4*)(F.norm_mix_g + 1024 + lane * 4 + 256 * j);
    for (int tok0 = 2 * gw; tok0 < NTOK; tok0 += 2 * NGW) {
        f32x4 v[2][4]; u32x2 yv[2][4][4];
#pragma unroll
        for (int tt = 0; tt < 2; ++tt) { const int tok = tok0 + tt;
            const GAS f32x4* xr = (const GAS f32x4*)(F.out + (size_t)tok * 1024) + lane;
#pragma unroll
            for (int j = 0; j < 4; ++j) v[tt][j] = xr[64 * j];
#pragma unroll
            for (int k = 0; k < 4; ++k) { const GAS u32x2* yr = (const GAS u32x2*)(Y + (size_t)(tok * 4 + k) * 1024) + lane;
#pragma unroll
                for (int j = 0; j < 4; ++j) yv[tt][k][j] = yr[64 * j]; } }
#pragma unroll
        for (int tt = 0; tt < 2; ++tt) { const int tok = tok0 + tt;
#pragma unroll
            for (int k = 0; k < 4; ++k)
#pragma unroll
                for (int j = 0; j < 4; ++j) { const u32x2 w = yv[tt][k][j]; v[tt][j].x += bflo(w.x); v[tt][j].y += bfhi(w.x); v[tt][j].z += bflo(w.y); v[tt][j].w += bfhi(w.y); }
            float ss = 0.f;
#pragma unroll
            for (int j = 0; j < 4; ++j) { ((GAS f32x4*)(xout + (size_t)tok * 1024) + lane)[64 * j] = v[tt][j]; ss += (v[tt][j].x * v[tt][j].x + v[tt][j].y * v[tt][j].y) + (v[tt][j].z * v[tt][j].z + v[tt][j].w * v[tt][j].w); }
            if (layer == 0 && !dry) {
                const float rstd = rsqrtf(wave_sum(ss) * (1.f / 1024.f) + EPS);
                f32x4 h[4];
#pragma unroll
                for (int j = 0; j < 4; ++j) h[j] = v[tt][j] * rstd * gv[j];
                unsigned qw[4]; float inv; quant_row_i8(h, qw, inv);
                GAS unsigned* o4 = (GAS unsigned*)(H2 + (size_t)tok * 1024) + lane;
#pragma unroll
                for (int j = 0; j < 4; ++j) o4[64 * j] = qw[j];
                if (lane == 0) HS[tok] = inv;
            }
        }
    }
}

struct DenseOrder {
    static constexpr bool GATHER = false;
    __device__ __forceinline__ int row_src(const pg8::Unit&, int) const { return 0; }
    int nM, nN, G, c; const char* Abase; const char* Bbase; int pitch;
    __device__ __forceinline__ bool next(int i, pg8::Unit& u) const {
        int pm, pn; if (!pg8::tile_order(i, G, c, nM, nN, pm, pn)) return false;
        u.a = Abase + (size_t)pm * 256 * pitch; u.b = Bbase + (size_t)pn * 256 * pitch; u.i0 = pm; u.i1 = pn; u.i2 = 0; u.i3 = 0; return true;
    }
};
struct EpiQKV {
    typedef v4i ACC; static constexpr int MODE = 1;
    static __host__ __device__ __forceinline__ int brow(int R) { return 2 * (R & ~31) + pg8::perm32(R & 31); }
    bf16* O; const float* qg; const float* kg; const float* wsc; const float* hs;
    __device__ __forceinline__ void operator()(const v4i (&acc)[2][2][4][2], const pg8::Unit& u, int wr, int wc, int fr, int fq) const {
        const int pn = u.i1, which = pn / 12;
        const int colh = pn * 256 + wc * 64;
        f32x4 gn[2][2], sc[2][2];
#pragma unroll
        for (int bj = 0; bj < 2; ++bj)
#pragma unroll
            for (int n = 0; n < 2; ++n) {
                const int hd = bj * 32 + 8 * fq + 4 * n;
                gn[bj][n] = which == 0 ? *(const f32x4*)(qg + hd) * (0.125f * 1.4426950408889634f * 64.f) : which == 1 ? *(const f32x4*)(kg + hd) * 16.f : (f32x4){1.f, 1.f, 1.f, 1.f};
                sc[bj][n] = *(const f32x4*)(wsc + colh + hd);
            }
#pragma unroll
        for (int ai = 0; ai < 2; ++ai)
#pragma unroll
            for (int m = 0; m < 4; ++m) {
                const int row = u.i0 * 256 + ai * 128 + wr * 64 + m * 16 + fr; const float rsc = hs[row];
                f32x4 v[2][2]; float ss = 0.f;
#pragma unroll
                for (int bj = 0; bj < 2; ++bj)
#pragma unroll
                    for (int n = 0; n < 2; ++n) { v[bj][n] = __builtin_convertvector(acc[ai][bj][m][n], f32x4) * (sc[bj][n] * rsc); const f32x4 t = v[bj][n]; ss += (t[0] * t[0] + t[1] * t[1]) + (t[2] * t[2] + t[3] * t[3]); }
                ss += __shfl_xor(ss, 16); ss += __shfl_xor(ss, 32);
                const float rs = which == 2 ? 1.f : rsqrtf(ss * (1.f / 64.f) + EPS);
                const int cwh = (pn % 12) * 256 + wc * 64;
                if (which < 2) {
                    unsigned h0[2], h1[2];
                    { const f32x4 a0 = v[0][0] * rs * gn[0][0], a1 = v[0][1] * rs * gn[0][1], b0 = v[1][0] * rs * gn[1][0], b1 = v[1][1] * rs * gn[1][1];
                      int w = __builtin_amdgcn_cvt_pk_fp8_f32(a0[0], a0[1], 0, false); h0[0] = (unsigned)__builtin_amdgcn_cvt_pk_fp8_f32(a0[2], a0[3], w, true);
                      w = __builtin_amdgcn_cvt_pk_fp8_f32(a1[0], a1[1], 0, false); h0[1] = (unsigned)__builtin_amdgcn_cvt_pk_fp8_f32(a1[2], a1[3], w, true);
                      w = __builtin_amdgcn_cvt_pk_fp8_f32(b0[0], b0[1], 0, false); h1[0] = (unsigned)__builtin_amdgcn_cvt_pk_fp8_f32(b0[2], b0[3], w, true);
                      w = __builtin_amdgcn_cvt_pk_fp8_f32(b1[0], b1[1], 0, false); h1[1] = (unsigned)__builtin_amdgcn_cvt_pk_fp8_f32(b1[2], b1[3], w, true); }
                    const auto r0 = __builtin_amdgcn_permlane16_swap(h0[0], h1[0], false, false), r1 = __builtin_amdgcn_permlane16_swap(h0[1], h1[1], false, false);
                    const int boff = (fq & 1) ? 32 + 8 * (fq - 1) : 8 * fq;
                    const u32x4 wv = (fq & 1) ? (u32x4){r0[0], r1[0], r0[1], r1[1]} : (u32x4){r0[0], r1[0], r0[1], r1[1]};
                    *(GAS u32x4*)((unsigned char*)O + (size_t)row * QKVB + which * 3072 + cwh + boff) = wv;
                } else {
                    u32x4 w0, w1;
                    { const f32x4 a0 = v[0][0], a1 = v[0][1], b0 = v[1][0], b1 = v[1][1];
                      w0.x = cvt_pk_bf16(a0[0], a0[1]); w0.y = cvt_pk_bf16(a0[2], a0[3]); w0.z = cvt_pk_bf16(a1[0], a1[1]); w0.w = cvt_pk_bf16(a1[2], a1[3]);
                      w1.x = cvt_pk_bf16(b0[0], b0[1]); w1.y = cvt_pk_bf16(b0[2], b0[3]); w1.z = cvt_pk_bf16(b1[0], b1[1]); w1.w = cvt_pk_bf16(b1[2], b1[3]); }
                    u32x4 t0, t1;
#pragma unroll
                    for (int d = 0; d < 4; ++d) { t0[d] = (unsigned)__builtin_amdgcn_update_dpp(0, (int)w0[d], 0x128, 0xf, 0xf, false); t1[d] = (unsigned)__builtin_amdgcn_update_dpp(0, (int)w1[d], 0x128, 0xf, 0xf, false); }
                    const bool lo = fr < 8;
                    const int rbase = u.i0 * 256 + ai * 128 + wr * 64 + m * 16 + (fr & 7);
                    const int bofs = 6144 + (cwh + 8 * fq) * 2 + (lo ? 0 : 64);
                    *(GAS u32x4*)((unsigned char*)O + (size_t)rbase * QKVB + bofs) = lo ? w0 : t1;
                    *(GAS u32x4*)((unsigned char*)O + (size_t)(rbase + 8) * QKVB + bofs) = lo ? t0 : w1;
                }
            }
    }
};
__device__ __forceinline__ void phase_qkv(Frame& F) {
    DenseOrder S; S.nM = NTOK / 256; S.nN = NQKV / 256; S.G = F.G; S.c = blockIdx.x; S.Abase = (const char*)(F.ws + WS_H2); S.Bbase = (const char*)(F.ws + WS_WQKV); S.pitch = 1024;
    EpiQKV E; E.O = (bf16*)(F.ws + WS_QKV); E.qg = F.q_gain; E.kg = F.k_gain; E.wsc = (const float*)(F.ws + WS_SC_QKV); E.hs = (const float*)(F.ws + WS_HS);
    pg8::gemm_phase<EpiQKV, DenseOrder, true, true>(F.lds, (size_t)32 * 1024, S, E);
}

struct EpiWo {
    typedef f32x4 ACC; static constexpr int MODE = 0;
    static __host__ __device__ __forceinline__ int brow(int R) { return R; }
    float* X; float* XO;
    __device__ __forceinline__ void operator()(const f32x4 (&acc)[2][2][4][2], const pg8::Unit& u, int wr, int wc, int fr, int fq) const {
        const int row0 = u.i0 * 256 + wr * 64 + fr, col0 = u.i1 * 256 + wc * 32 + 4 * fq; const size_t dlt = XO - X;
#pragma unroll
        for (int ai = 0; ai < 2; ++ai)
#pragma unroll
            for (int mp = 0; mp < 2; ++mp) {
                f32x4 xv[2][2][2];
#pragma unroll
                for (int mm = 0; mm < 2; ++mm)
#pragma unroll
                    for (int bj = 0; bj < 2; ++bj)
#pragma unroll
                        for (int n = 0; n < 2; ++n) xv[mm][bj][n] = *(const GAS f32x4*)(X + (size_t)(row0 + ai * 128 + (2 * mp + mm) * 16) * 1024 + col0 + bj * 128 + n * 16);
#pragma unroll
                for (int mm = 0; mm < 2; ++mm)
#pragma unroll
                    for (int bj = 0; bj < 2; ++bj)
#pragma unroll
                        for (int n = 0; n < 2; ++n) *(GAS f32x4*)(X + dlt + (size_t)(row0 + ai * 128 + (2 * mp + mm) * 16) * 1024 + col0 + bj * 128 + n * 16) = xv[mm][bj][n] + acc[ai][bj][2 * mp + mm][n];
            }
    }
};
__device__ __forceinline__ void phase_wo(Frame& F, bool dry) {
    DenseOrder S; S.nM = NTOK / 256; S.nN = 4; S.G = F.G; S.c = blockIdx.x; S.Abase = (const char*)(F.ws + WS_OB); S.Bbase = (const char*)(F.ws + WS_WO); S.pitch = 2048;
    EpiWo E; E.X = F.out; E.XO = dry ? (float*)(F.ws + WS_BIG + 144 * MiB) : F.out;
    pg8::gemm_phase<EpiWo, DenseOrder, false, true>(F.lds, (size_t)128 * 1024 * 2, S, E);
}

typedef short v4i16_t __attribute__((ext_vector_type(4)));
__device__ __forceinline__ s16x4 vtr(const LAS unsigned char* p) { return __builtin_bit_cast(s16x4, __builtin_amdgcn_ds_read_tr16_b64_v4i16((LAS v4i16_t*)p)); }
struct AttnItem { int g, dil, i, head, needprev; size_t rowbase; };
__device__ __forceinline__ AttnItem attn_item(int sup, int it, int hg) {
    AttnItem a; int z, hp;
    if (it < 4) { const int c0 = sup >> 2; a.g = 0; a.dil = 1; z = c0 >> 3; hp = c0 & 7; a.i = 4 * (sup & 3) + it; a.needprev = (it == 0 && a.i > 0); }
    else if (it < 8) { a.g = 1; a.dil = 4; z = sup >> 3; hp = sup & 7; a.i = it - 4; a.needprev = 0; }
    else { const int idx = 4 * sup + (it - 8); a.g = 2; a.dil = 16; z = idx >> 3; hp = idx & 7; a.i = 0; a.needprev = 0; }
    a.head = hp * 2 + hg;
    a.rowbase = (size_t)(z / a.dil) * SEQ + (z % a.dil);
    return a;
}
__device__ __forceinline__ void attn_issue(const unsigned char* QKV, const AttnItem& a, int blk, int t2, u32x4 (&kv)[2], u32x4 (&vv)[4]) {
#pragma unroll
    for (int it = 0; it < 4; ++it) {
        const int cidx = t2 + 256 * it, row = cidx >> 3, ch = cidx & 7;
        const unsigned char* src = QKV + (a.rowbase + (size_t)a.dil * ((size_t)blk * 128 + row)) * QKVB + 6144 + (a.g * 1024 + a.head * 64 + ch * 8) * 2;
        vv[it] = *(const GAS u32x4*)src;
    }
#pragma unroll
    for (int it = 0; it < 2; ++it) {
        const int cidx = t2 + 256 * it, row = cidx >> 2, ch = cidx & 3;
        const unsigned char* src = QKV + (a.rowbase + (size_t)a.dil * ((size_t)blk * 128 + row)) * QKVB + 3072 + a.g * 1024 + a.head * 64 + ch * 16;
        kv[it] = *(const GAS u32x4*)src;
    }
}
__device__ __forceinline__ void attn_commit(LAS unsigned char* Kb, LAS unsigned char* Vb, int slot, int t2, const u32x4 (&kv)[2], const u32x4 (&vv)[4]) {
#pragma unroll
    for (int it = 0; it < 4; ++it) {
        const int cidx = t2 + 256 * it, row = cidx >> 3, ch = cidx & 7;
        *(LAS u32x4*)(Vb + slot * 16384 + row * 128 + ((ch ^ (row & 7)) << 4)) = vv[it];
    }
#pragma unroll
    for (int it = 0; it < 2; ++it) {
        const int cidx = t2 + 256 * it, row = cidx >> 2, ch = cidx & 3, x = (row >> 2) & 7;
        LAS unsigned char* rp = Kb + slot * 8192 + row * 64;
        *(LAS u32x2*)(rp + (((2 * ch) ^ x) << 3)) = (u32x2){kv[it].x, kv[it].y};
        *(LAS u32x2*)(rp + (((2 * ch + 1) ^ x) << 3)) = (u32x2){kv[it].z, kv[it].w};
    }
}
__device__ __forceinline__ void attn_loadq(const unsigned char* QKV, const AttnItem& a, int w, int q, int hh, long (&qf)[4]) {
    const size_t qrow = a.rowbase + (size_t)a.dil * ((size_t)a.i * 128 + 32 * w + q);
    const unsigned char* qp = QKV + qrow * QKVB + a.g * 1024 + a.head * 64 + 8 * hh;
#pragma unroll
    for (int ks = 0; ks < 4; ++ks) qf[ks] = *(const GAS long*)(qp + 16 * ks);
}
__device__ __forceinline__ void phase_attn(Frame& F) {
    LAS unsigned char* lds = F.lds;
    LAS float* btab = (LAS float*)(lds + L_BTAB); LAS int* bucketL = (LAS int*)(lds + L_BUCKET);
    const int tid = F.tid, lane = F.lane, wave = F.wave;
    for (int i = tid; i < 3 * 129; i += NTHREADS) {
        const int g = i / 129, d = i % 129; const int n = d * (g == 0 ? 1 : g == 1 ? 4 : 16);
        int bk;
        if (n < 16) bk = n;
        else { const float nf = (float)n; int lg = 16 + (int)(logf(nf / 16.f) / 4.852030263919617f * 16.f); bk = lg < 31 ? lg : 31; }
        bucketL[g * 132 + d] = bk;
    }
    __syncthreads();
    const int hg = wave >> 2, w = wave & 3, t2 = tid & 255;
    const int q = lane & 31, hh = lane >> 5;
    const unsigned char* QKV = F.ws + WS_QKV;
    LAS unsigned char* Kb = lds + hg * 16384;
    LAS unsigned char* Vb = lds + 65536 + hg * 32768;
    const int g16 = lane >> 4, i16 = lane & 15, qsel = i16 >> 2, psel = i16 & 3;
    int kcon[4];
#pragma unroll
    for (int ks = 0; ks < 4; ++ks) kcon[ks] = q * 64 + (((2 * ks + hh) ^ ((q >> 2) & 7)) << 3);
    const int c7 = (4 * hh + qsel) & 7, cb = 2 * (g16 & 1) + (psel >> 1);
    const int vcon0 = (4 * hh + qsel) * 128 + ((cb ^ c7) << 4) + (psel & 1) * 8;
    const int vcon1 = (4 * hh + qsel) * 128 + (((cb + 4) ^ c7) << 4) + (psel & 1) * 8;
    const LAS float* bt = btab + hg * 192 + 32 + 4 * hh - q;
    const int bj_ = t2 - 32; const bool bval = (t2 < 192) && bj_ >= 0 && bj_ <= 128; const int bdel = bval ? 128 - bj_ : 0;
    for (int sup = blockIdx.x; sup < 256; sup += F.G) {
        AttnItem cur = attn_item(sup, 0, hg);
        u32x4 kv[2], vv[4]; long qf[4], qn[4]; float bnx;
        if (cur.needprev) { attn_issue(QKV, cur, cur.i - 1, t2, kv, vv); attn_commit(Kb, Vb, (cur.i - 1) & 1, t2, kv, vv); }
        attn_issue(QKV, cur, cur.i, t2, kv, vv); attn_loadq(QKV, cur, w, q, hh, qf);
        bnx = F.rel_bias[bucketL[cur.g * 132 + bdel] * 48 + cur.g * 16 + cur.head];
        attn_commit(Kb, Vb, cur.i & 1, t2, kv, vv);
        if (t2 < 192) btab[hg * 192 + t2] = bval ? bnx * (1.4426950408889634f * 1024.f) : -1e30f;
        asm volatile("" : "+v"(qf[0]), "+v"(qf[1]), "+v"(qf[2]), "+v"(qf[3]) :: "memory");
        __syncthreads();
#pragma unroll 1
        for (int it = 0; it < 12; ++it) {
            const bool hn = it + 1 < 12;
            AttnItem nxt = cur;
            if (hn) { nxt = attn_item(sup, it + 1, hg); attn_issue(QKV, nxt, nxt.i, t2, kv, vv); attn_loadq(QKV, nxt, w, q, hh, qn);
                      bnx = F.rel_bias[bucketL[nxt.g * 132 + bdel] * 48 + nxt.g * 16 + nxt.head]; }
            const int i = cur.i;
            const int kt_lo = (i == 0) ? 4 : w;
            f32x16 S[5];
            float mx = -1e30f;
#pragma unroll
            for (int t = 0; t < 5; ++t) {
                const int kt = w + t;
                if (kt >= kt_lo) {
                    const LAS unsigned char* kp = Kb + (((kt < 4 ? i - 1 : i) & 1) * 8192 + (kt & 3) * 2048);
                    long kf[4];
#pragma unroll
                    for (int ks = 0; ks < 4; ++ks) kf[ks] = *(const LAS long*)(kp + kcon[ks]);
                    f32x16 acc;
#pragma unroll
                    for (int rg = 0; rg < 16; ++rg) acc[rg] = bt[32 * t + 8 * (rg >> 2) + (rg & 3)];
#pragma unroll
                    for (int ks = 0; ks < 4; ++ks) acc = __builtin_amdgcn_mfma_f32_32x32x16_fp8_fp8(kf[ks], qf[ks], acc, 0, 0, 0);
                    S[t] = acc;
#pragma unroll
                    for (int rg = 0; rg < 16; ++rg) mx = fmaxf(mx, acc[rg]);
                } else {
#pragma unroll
                    for (int rg = 0; rg < 16; ++rg) S[t][rg] = -1e30f;
                }
            }
            mx = fmaxf(mx, __shfl_xor(mx, 32)) * (1.f / 1024.f);
            float lsum = 0.f;
#pragma unroll
            for (int t = 0; t < 5; ++t)
#pragma unroll
                for (int rg = 0; rg < 16; ++rg) { const float p = __builtin_amdgcn_exp2f(__builtin_fmaf(S[t][rg], 1.f / 1024.f, -mx)); S[t][rg] = p; lsum += p; }
            lsum += __shfl_xor(lsum, 32);
            f32x16 O[2];
#pragma unroll
            for (int dt = 0; dt < 2; ++dt)
#pragma unroll
                for (int rg = 0; rg < 16; ++rg) O[dt][rg] = 0.f;
#pragma unroll
            for (int t = 0; t < 5; ++t) {
                const int kt = w + t;
                if (kt >= kt_lo) {
                    const LAS unsigned char* vp = Vb + (((kt < 4 ? i - 1 : i) & 1) * 16384 + (kt & 3) * 4096);
#pragma unroll
                    for (int s2 = 0; s2 < 2; ++s2) {
                        bf16x8 pf;
                        { const unsigned w0 = cvt_pk_bf16(S[t][8 * s2 + 0], S[t][8 * s2 + 1]), w1 = cvt_pk_bf16(S[t][8 * s2 + 2], S[t][8 * s2 + 3]),
                                         w2 = cvt_pk_bf16(S[t][8 * s2 + 4], S[t][8 * s2 + 5]), w3 = cvt_pk_bf16(S[t][8 * s2 + 6], S[t][8 * s2 + 7]);
                          const u32x4 pw = (u32x4){w0, w1, w2, w3}; pf = __builtin_bit_cast(bf16x8, pw); }
                        const s16x4 lo0 = vtr(vp + s2 * 2048 + vcon0), hi0 = vtr(vp + s2 * 2048 + 1024 + vcon0);
                        const s16x4 lo1 = vtr(vp + s2 * 2048 + vcon1), hi1 = vtr(vp + s2 * 2048 + 1024 + vcon1);
                        const bf16x8 vf0 = (bf16x8){lo0[0], lo0[1], lo0[2], lo0[3], hi0[0], hi0[1], hi0[2], hi0[3]};
                        const bf16x8 vf1 = (bf16x8){lo1[0], lo1[1], lo1[2], lo1[3], hi1[0], hi1[1], hi1[2], hi1[3]};
                        O[0] = __builtin_amdgcn_mfma_f32_32x32x16_bf16(vf0, pf, O[0], 0, 0, 0);
                        O[1] = __builtin_amdgcn_mfma_f32_32x32x16_bf16(vf1, pf, O[1], 0, 0, 0);
                    }
                }
            }
            {
                const size_t qrow = cur.rowbase + (size_t)cur.dil * ((size_t)i * 128 + 32 * w + q);
                const float inv = 1.f / lsum;
                bf16* op = (bf16*)(F.ws + WS_OG) + ((size_t)cur.g * NTOK + qrow) * 1024 + cur.head * 64;
#pragma unroll
                for (int dt = 0; dt < 2; ++dt)
#pragma unroll
                    for (int r4 = 0; r4 < 4; ++r4) {
                        u32x2 wv; wv.x = cvt_pk_bf16(O[dt][4 * r4 + 0] * inv, O[dt][4 * r4 + 1] * inv); wv.y = cvt_pk_bf16(O[dt][4 * r4 + 2] * inv, O[dt][4 * r4 + 3] * inv);
                        *(GAS u32x2*)(op + dt * 32 + 8 * r4 + 4 * hh) = wv;
                    }
                if (hh == 0) ((float*)(F.ws + WS_LSE))[((size_t)cur.g * NTOK + qrow) * 16 + cur.head] = (mx + __builtin_amdgcn_logf(lsum)) * 0.6931471805599453f;
            }
            __syncthreads();
            if (hn) {
                asm volatile("" : "+v"(qn[0]), "+v"(qn[1]), "+v"(qn[2]), "+v"(qn[3]), "+v"(bnx) :: "memory");
                attn_commit(Kb, Vb, nxt.i & 1, t2, kv, vv);
                if (t2 < 192) btab[hg * 192 + t2] = bval ? bnx * (1.4426950408889634f * 1024.f) : -1e30f;
#pragma unroll
                for (int ks = 0; ks < 4; ++ks) qf[ks] = qn[ks];
                cur = nxt;
            }
            __syncthreads();
        }
    }
}
__device__ __forceinline__ void phase_attn_combine(Frame& F) {
    const int gw = blockIdx.x * NWAVES + F.wave, NGW = F.G * NWAVES, lane = F.lane;
    const float* LSE = (const float*)(F.ws + WS_LSE); const bf16* OG = (const bf16*)(F.ws + WS_OG); bf16* OB = (bf16*)(F.ws + WS_OB);
    for (int tok = gw; tok < NTOK; tok += NGW) {
        const int head = lane >> 2;
        const float l0 = LSE[((size_t)0 * NTOK + tok) * 16 + head], l1 = LSE[((size_t)1 * NTOK + tok) * 16 + head], l2 = LSE[((size_t)2 * NTOK + tok) * 16 + head];
        const float m = fmaxf(l0, fmaxf(l1, l2));
        float a0 = __expf(l0 - m), a1 = __expf(l1 - m), a2 = __expf(l2 - m); const float inv = 1.f / (a0 + a1 + a2); a0 *= inv; a1 *= inv; a2 *= inv;
        const GAS u32x4* p0 = (const GAS u32x4*)(OG + ((size_t)0 * NTOK + tok) * 1024) + 2 * lane;
        const GAS u32x4* p1 = (const GAS u32x4*)(OG + ((size_t)1 * NTOK + tok) * 1024) + 2 * lane;
        const GAS u32x4* p2 = (const GAS u32x4*)(OG + ((size_t)2 * NTOK + tok) * 1024) + 2 * lane;
        GAS u32x4* po = (GAS u32x4*)(OB + (size_t)tok * 1024) + 2 * lane;
#pragma unroll
        for (int c = 0; c < 2; ++c) {
            const u32x4 v0 = p0[c], v1 = p1[c], v2 = p2[c]; u32x4 o;
#pragma unroll
            for (int k = 0; k < 4; ++k) {
                const float lo = a0 * bflo(v0[k]) + a1 * bflo(v1[k]) + a2 * bflo(v2[k]);
                const float hi = a0 * bfhi(v0[k]) + a1 * bfhi(v1[k]) + a2 * bfhi(v2[k]);
                o[k] = pk2(lo, hi);
            }
            po[c] = o;
        }
    }
}

constexpr int NPHASE = 13;
__global__ void __launch_bounds__(NTHREADS, 2) fwd_kernel(Args args) {
    extern __shared__ __attribute__((aligned(16))) unsigned char lds_raw[];
    Frame F;
    F.lds = (LAS unsigned char*)lds_raw;
    F.tid = threadIdx.x; F.lane = F.tid & 63; F.wave = __builtin_amdgcn_readfirstlane(F.tid >> 6); F.G = gridDim.x;
    F.ws = args.ws; F.out = args.out; F.ctl = (gu32*)(args.ws + WS_CTL);
    F.x = args.in[0]; F.norm_mix_g = args.in[1]; F.norm_ffn_g = args.in[2]; F.pool_w = args.in[3]; F.pool_scale = args.in[4]; F.w_qkv = args.in[5];
    F.q_gain = args.in[6]; F.k_gain = args.in[7]; F.w_o = args.in[8]; F.rel_bias = args.in[9]; F.w_router = args.in[10]; F.b_router = args.in[11];
    F.w_gu = args.in[12]; F.b_gu = args.in[13]; F.w_dn = args.in[14]; F.b_dn = args.in[15];
    if (F.tid < 16) ((LAS unsigned*)(F.lds + L_BARST))[F.tid] = 0u;
    __syncthreads();
    if (args.never) cg::this_grid().sync();
#if MK_MULTI
#define GRID_BAR() do { } while (0)
#else
    XcdBarrier bar = xcd_barrier_post((unsigned*)(F.ctl + CW_BAR), (volatile LAS unsigned*)(F.lds + L_BARST));
#define GRID_BAR() xcd_barrier(bar)
#endif
    const int lo = args.ph_lo, hi = args.ph_hi;
#define IN(k) (lo <= (k) && (k) < hi)
#define SEAM(k) do { if (IN(k) && IN((k) + 1)) GRID_BAR(); } while (0)
#define RUN(k, call) do { if (IN(k)) { if ((DUP_MASK >> (k)) & 1) { call; GRID_BAR(); } call; } } while (0)
#define DRY(k) (((DUP_MASK >> (k)) & 1) != 0)
    RUN(0, phase_convert(F));          SEAM(0);
    if (IN(1)) { if (DRY(1)) { phase_pool(F, true); GRID_BAR(); } phase_pool(F, false); }  SEAM(1);
    RUN(2, phase_moe_gu(F, 0));        SEAM(2);
    RUN(3, phase_moe_dn(F, 0));        SEAM(3);
    if (IN(4)) { if (DRY(4)) { phase_combine(F, 0, true); GRID_BAR(); } phase_combine(F, 0, false); }  SEAM(4);
    RUN(5, phase_qkv(F));              SEAM(5);
    RUN(6, phase_attn(F));             SEAM(6);
    RUN(7, phase_attn_combine(F));     SEAM(7);
    if (IN(8)) { if (DRY(8)) { phase_wo(F, true); GRID_BAR(); } phase_wo(F, false); }  SEAM(8);
    if (IN(9)) { if (DRY(9)) { phase_router(F, 1, true); GRID_BAR(); } phase_router(F, 1, false); }  SEAM(9);
    RUN(10, phase_moe_gu(F, 1));       SEAM(10);
    RUN(11, phase_moe_dn(F, 1));       SEAM(11);
    if (IN(12)) { if (DRY(12)) { phase_combine(F, 1, true); GRID_BAR(); } phase_combine(F, 1, false); }
#undef RUN
#undef DRY
#undef IN
#undef SEAM
}

extern "C" void kernel_launch(void* const* d_in, const int* in_sizes, int n_in, void* d_out, int out_size, void* d_ws, size_t ws_size, hipStream_t stream) {
    static int grid = 0;
    if (grid == 0) {
        if (n_in != 16 || in_sizes[0] != NTOK * DM || out_size != NTOK * DM || ws_size < WS_END) {
            fprintf(stderr, "kernel_launch: unexpected shapes (n_in %d, in0 %d, out %d, ws %zu < %zu); nothing launched\n", n_in, n_in > 0 ? in_sizes[0] : -1, out_size, ws_size, (size_t)WS_END); grid = -1; return; }
        int dev = 0, cus = 0, per_cu = 0;
        if (hipGetDevice(&dev) != hipSuccess || hipDeviceGetAttribute(&cus, hipDeviceAttributeMultiprocessorCount, dev) != hipSuccess) { grid = -1; return; }
        if (hipFuncSetAttribute((const void*)fwd_kernel, hipFuncAttributeMaxDynamicSharedMemorySize, LDS_BYTES) != hipSuccess) { fprintf(stderr, "kernel_launch: hipFuncSetAttribute failed\n"); grid = -1; return; }
        if (hipOccupancyMaxActiveBlocksPerMultiprocessor(&per_cu, (const void*)fwd_kernel, NTHREADS, LDS_BYTES) != hipSuccess || per_cu < 1) { fprintf(stderr, "kernel_launch: occupancy query says %d blocks/CU\n", per_cu); (void)hipGetLastError(); grid = -1; return; }
        grid = cus;
    }
    if (grid < 0) return;
    if (hipMemsetAsync((char*)d_ws + WS_CTL, 0, CTL_BYTES, stream) != hipSuccess) { fprintf(stderr, "kernel_launch: memset failed\n"); return; }
    Args a{};
    for (int i = 0; i < 16; ++i) a.in[i] = (const float*)d_in[i];
    a.out = (float*)d_out; a.ws = (unsigned char*)d_ws; a.never = 0; a.pad = 0;
#if MK_MULTI
    for (int p = 0; p < NPHASE; ++p) { a.ph_lo = p; a.ph_hi = p + 1; hipLaunchKernelGGL(fwd_kernel, dim3(grid), dim3(NTHREADS), LDS_BYTES, stream, a); }
#else
    a.ph_lo = 0; a.ph_hi = NPHASE;
    void* kargs[] = {&a};
    hipError_t e = hipLaunchCooperativeKernel((const void*)fwd_kernel, dim3(grid), dim3(NTHREADS), kargs, LDS_BYTES, stream);
    if (e != hipSuccess) fprintf(stderr, "kernel_launch: cooperative launch failed: %s (grid %d)\n", hipGetErrorString(e), grid);
#endif
}
```

```cpp
#include <hip/hip_runtime.h>
#include <hip/hip_cooperative_groups.h>
#include <cstdio>
#include <cstdint>
namespace cg = cooperative_groups;

#ifndef DUP_MASK
#define DUP_MASK 0
#endif
#ifndef MK_MULTI
#define MK_MULTI 0
#endif

#define LAS __attribute__((address_space(3)))
#define GAS __attribute__((address_space(1)))
typedef unsigned short bf16;
typedef short bf16x8 __attribute__((ext_vector_type(8)));
typedef short s16x4 __attribute__((ext_vector_type(4)));
typedef float f32x2 __attribute__((ext_vector_type(2)));
typedef float f32x4 __attribute__((ext_vector_type(4)));
typedef float f32x16 __attribute__((ext_vector_type(16)));
typedef int v4i __attribute__((ext_vector_type(4)));
typedef long v2l __attribute__((ext_vector_type(2)));
typedef int v8i __attribute__((ext_vector_type(8)));
typedef unsigned u32x4 __attribute__((ext_vector_type(4)));
typedef unsigned u32x2 __attribute__((ext_vector_type(2)));
typedef GAS unsigned gu32;

constexpr int NTOK = 16384, DM = 1024, SEQ = 2048, NEXP = 32, TOPK = 4, FF = 1024, NQKV = 9216;
constexpr int QKVB = 9216;
constexpr int CAP = 16384;
constexpr int MAXT = 288;
constexpr int PMAX = MAXT * 256;
constexpr float EPS = 1e-6f;
constexpr int NWAVES = 8, NTHREADS = 512;

constexpr size_t MiB = 1u << 20;
constexpr size_t WS_CTL = 0, CTL_BYTES = 32 * 1024;
constexpr size_t WS_WRT = 1 * MiB;
constexpr size_t WS_WPOOL = WS_WRT + 512 * 1024;
constexpr size_t WS_WO = 2 * MiB;
constexpr size_t WS_SC_GU = 4 * MiB;
constexpr size_t WS_SC_QKV = 4 * MiB + 512 * 1024;
constexpr size_t WS_SC_DN = 5 * MiB;
constexpr size_t WS_SC_WO = 5 * MiB + 512 * 1024;
constexpr size_t WS_HS = 6 * MiB;
constexpr size_t WS_WQKV = 8 * MiB;
constexpr size_t WS_WGU = 18 * MiB;
constexpr size_t WS_WDN = WS_WGU + 128 * MiB;
constexpr size_t WS_ROWSLOT = WS_WDN + 128 * MiB;
constexpr size_t WS_ROWGATE = WS_ROWSLOT + 2 * MiB;
constexpr size_t WS_ROWHS = WS_ROWGATE + 2 * MiB;
constexpr size_t WS_LSE = WS_ROWHS + 2 * MiB;
constexpr size_t WS_H2 = WS_LSE + 3 * MiB;
constexpr size_t WS_BIG = WS_H2 + 16 * MiB;
constexpr size_t WS_ACT = WS_BIG, WS_QKV = WS_BIG;
constexpr size_t WS_Y = WS_BIG + 288 * MiB;
constexpr size_t WS_OG = WS_Y, WS_OB = WS_Y + 96 * MiB;
constexpr size_t WS_XB = WS_Y + 128 * MiB;
constexpr size_t WS_END = WS_XB + 32 * MiB;
static_assert(WS_END <= 874 * MiB, "workspace map must fit the guaranteed d_ws size");
constexpr int CW_CNT = 64;
constexpr int CW_BAR = 4096;
constexpr int CW_TICKET = 160;
constexpr int NDEFER = 448;

constexpr int RING_BYTES = 131072;
constexpr int MISC_OFF = RING_BYTES;
constexpr int L_BARST = MISC_OFF + 0;
constexpr int L_CNT = MISC_OFF + 64;
constexpr int L_PROW0 = MISC_OFF + 192;
constexpr int L_NT = MISC_OFF + 320;
constexpr int L_TICKET = MISC_OFF + 324;
constexpr int L_TILEE = MISC_OFF + 336;
constexpr int L_TILEROW = MISC_OFF + 1488;
constexpr int L_HIST = MISC_OFF + 2640;
constexpr int L_BASE = MISC_OFF + 2768;
constexpr int L_SLOTE = MISC_OFF + 2896;
constexpr int L_SLOTP = MISC_OFF + 3920;
constexpr int L_SLOTG = MISC_OFF + 4944;
constexpr int L_RSTD = MISC_OFF + 5968;
constexpr int L_BIAS = MISC_OFF + 6288;
constexpr int L_BUCKET = MISC_OFF + 7344;
constexpr int L_BTAB = MISC_OFF + 8960;
constexpr int LDS_BYTES = 147456;
static_assert(L_BTAB + 2 * 192 * 4 <= LDS_BYTES, "LDS map");

#define RLX_AGENT __ATOMIC_RELAXED, __HIP_MEMORY_SCOPE_AGENT
#define LDS_WAIT() asm volatile("s_waitcnt lgkmcnt(0)" ::: "memory")
#define VM_WAIT() asm volatile("s_waitcnt vmcnt(0)" ::: "memory")
__device__ __forceinline__ unsigned f2bf(float f) { unsigned u = __builtin_bit_cast(unsigned, f); return (u + 0x7fffu + ((u >> 16) & 1u)) >> 16; }
__device__ __forceinline__ unsigned pk2(float lo, float hi) { return f2bf(lo) | (f2bf(hi) << 16); }
__device__ __forceinline__ float bf2f(unsigned short b) { return __builtin_bit_cast(float, ((unsigned)b) << 16); }
__device__ __forceinline__ float bflo(unsigned w) { return __builtin_bit_cast(float, w << 16); }
__device__ __forceinline__ float bfhi(unsigned w) { return __builtin_bit_cast(float, w & 0xffff0000u); }
typedef __bf16 bf16x2_t __attribute__((ext_vector_type(2)));
__device__ __forceinline__ unsigned cvt_pk_bf16(float lo, float hi) { const f32x2 v = {lo, hi}; const bf16x2_t b = __builtin_convertvector(v, bf16x2_t); return __builtin_bit_cast(unsigned, b); }
__device__ __forceinline__ f32x4 bf4(u32x2 w) { return (f32x4){bflo(w.x), bfhi(w.x), bflo(w.y), bfhi(w.y)}; }
__device__ __forceinline__ float wave_sum(float v) {
#pragma unroll
    for (int o = 1; o < 64; o <<= 1) v += __shfl_xor(v, o);
    return v;
}

#define XB_TMO      128
#define XB_XCNT(j)  (256  + 64 * (j))
#define XB_XSUB(j)  (1280 + 64 * (j))
#define XB_XGEN(j)  (2304 + 64 * (j))
#define XB_TOP      3328
#define XB_TOPGEN   3392
#define XCD_BAR_WORDS 3456
#define XB_SPIN_CAP (1u << 20)
__device__ __forceinline__ unsigned xb_ld(unsigned* p)              { return __hip_atomic_load(p, __ATOMIC_RELAXED, __HIP_MEMORY_SCOPE_AGENT); }
__device__ __forceinline__ unsigned xb_add(unsigned* p, unsigned v) { return __hip_atomic_fetch_add(p, v, __ATOMIC_RELAXED, __HIP_MEMORY_SCOPE_AGENT); }
__device__ __forceinline__ unsigned xb_xcc_id() { return (unsigned)__builtin_amdgcn_s_getreg((3 << 11) | 20) & 0xFu; }
#define XB_SPIN(cond, bar) do { unsigned _sp = 0; while (cond) { __builtin_amdgcn_s_sleep(1); \
    if ((++_sp & 255u) == 0u) { if (xb_ld(&(bar)[XB_TMO])) break; if (_sp > XB_SPIN_CAP) { atomicAdd(&(bar)[XB_TMO], 1u); break; } } } } while (0)
struct XcdBarrier { unsigned* bar; unsigned x; volatile LAS unsigned* st; };
__device__ __forceinline__ XcdBarrier xcd_barrier_post(unsigned* bar, volatile LAS unsigned* st) {
    XcdBarrier b; b.bar = bar; b.x = xb_xcc_id(); b.st = st;
    if (threadIdx.x == 0) (void)xb_add(&bar[XB_XCNT(b.x)], 1u);
    return b;
}
__device__ __forceinline__ void xcd_barrier_complete(unsigned* bar, unsigned x, unsigned& nloc, unsigned& nx) {
    const unsigned G = gridDim.x * gridDim.y * gridDim.z;
    unsigned sum, cnt, mine, sp = 0u;
    for (;;) {
        sum = 0u; cnt = 0u; mine = 0u;
#pragma unroll
        for (unsigned j = 0; j < 16; ++j) { const unsigned c = xb_ld(&bar[XB_XCNT(j)]); sum += c; cnt += (c > 0u) ? 1u : 0u; mine = (j == x) ? c : mine; }
        if (sum == G) break;
        __builtin_amdgcn_s_sleep(1);
        if ((++sp & 255u) == 0u) { if (xb_ld(&bar[XB_TMO])) break; if (sp > XB_SPIN_CAP) { atomicAdd(&bar[XB_TMO], 1u); break; } }
    }
    nloc = mine > 0u ? mine : 1u; nx = cnt > 0u ? cnt : 1u;
}
__device__ __forceinline__ void xcd_barrier(const XcdBarrier& b) {
    asm volatile("s_waitcnt vmcnt(0)" ::: "memory");
    __syncthreads();
    if (threadIdx.x == 0) {
        unsigned* bar = b.bar;
        __builtin_amdgcn_s_waitcnt(0);
        unsigned nloc = b.st[0], nx = b.st[1];
        if (nloc == 0u) { xcd_barrier_complete(bar, b.x, nloc, nx); b.st[0] = nloc; b.st[1] = nx; }
        const unsigned old = xb_add(&bar[XB_XSUB(b.x)], 1u);
        const unsigned gen = old / nloc;
        if (old + 1u == (gen + 1u) * nloc) {
            __builtin_amdgcn_fence(__ATOMIC_RELEASE, "agent");
            asm volatile("s_waitcnt vmcnt(0)" ::: "memory");
            const unsigned og = xb_add(&bar[XB_TOP], 1u);
            const unsigned tg = og / nx;
            if (og + 1u == (tg + 1u) * nx) xb_add(&bar[XB_TOPGEN], 1u);
            else XB_SPIN(xb_ld(&bar[XB_TOPGEN]) == tg, bar);
            __builtin_amdgcn_fence(__ATOMIC_ACQUIRE, "agent");
            asm volatile("s_waitcnt vmcnt(0)" ::: "memory");
        } else {
            XB_SPIN(xb_ld(&bar[XB_TOPGEN]) == gen, bar);
            __builtin_amdgcn_fence(__ATOMIC_ACQUIRE, "agent");
            asm volatile("s_waitcnt vmcnt(0)" ::: "memory");
        }
    }
    __syncthreads();
}

namespace pg8 {
constexpr int BM = 256, BK = 64, HALF = 128, HTB = HALF * BK * 2, STAGE_BYTES = 8 * HTB, NXCD = 8, WGM = 2, KD = 1024;
__host__ __device__ __forceinline__ int lds_byte(int r, int c) { const int st = (r >> 4) * 2 + (c >> 5), rr = r & 15, cc = c & 31, ob = rr * 64 + cc * 2; return st * 1024 + (ob ^ (((ob >> 9) & 1) << 5)); }
__host__ __device__ __forceinline__ void stage_rc(int b, int& R, int& C) { const int st = b / 1024, sb = b % 1024, swz = sb ^ (((sb >> 9) & 1) << 5); R = (st >> 1) * 16 + swz / 64; C = (st & 1) * 32 + (swz % 64) / 2; }
__host__ __device__ __forceinline__ int perm32(int rho) { const int n = rho >> 4, i = rho & 15; return 8 * (i >> 2) + 4 * n + (i & 3); }

struct Unit { const char* a; const char* b; int i0, i1, i2, i3; };
template <int M> struct Frag { bf16x8 v[2]; };
template <> struct Frag<2> { v8i w; };

__device__ __forceinline__ bool tile_order(int i, int G, int c, int nM, int nN, int& pm, int& pn, int WGM = 2) {
    const int nwg = nM * nN; const long L = (long)i * G + c; if (L >= nwg) return false;
    int wgid = (int)L; { const int q = nwg / NXCD, r = nwg % NXCD, xcd = wgid % NXCD, off = wgid / NXCD; wgid = (xcd < r ? xcd * (q + 1) : r * (q + 1) + (xcd - r) * q) + off; }
    const int nig = WGM * nN, gid = wgid / nig, fm = gid * WGM, gsz = (nM - fm) < WGM ? (nM - fm) : WGM;
    pm = fm + ((wgid % nig) % gsz); pn = (wgid % nig) / gsz; return true;
}

template <class Epi, class Sched, bool ALIGN_EPI, bool SP2>
__device__ __forceinline__ void gemm_phase(LAS unsigned char* lds, const size_t hstepB_, const Sched& S, const Epi& E) {
    typedef typename Epi::ACC ACC; constexpr int MODE = Epi::MODE;
    const int tid = threadIdx.x, wid = __builtin_amdgcn_readfirstlane(tid >> 6), lane = tid & 63, wr = wid >> 2, wc = wid & 3, fr = lane & 15, fq = lane >> 4;
    constexpr int ROWB = (MODE == 0) ? KD * 2 : KD;
    constexpr int nt = ROWB / 128;
    constexpr bool GATHER = Sched::GATHER;
    unsigned voffA[2], voffB[2]; int Rst[2], Cst[2];
#pragma unroll
    for (int i = 0; i < 2; ++i) { int R, C; stage_rc(tid * 16 + i * 8192, R, C); const int Rb = Epi::brow(R); Rst[i] = R; Cst[i] = C;
        voffA[i] = (unsigned)(R * ROWB + C * 2); voffB[i] = (unsigned)(Rb * ROWB + C * 2); }
    unsigned gc[4] = {0u, 0u, 0u, 0u}, gn[4] = {0u, 0u, 0u, 0u};
    const unsigned kstep = (unsigned)(BK * 2);
    const unsigned hstepA = (unsigned)(HALF * ROWB);
    const unsigned hstepB = (unsigned)hstepB_;
    const __amdgpu_buffer_rsrc_t rsA = __builtin_amdgcn_make_buffer_rsrc((void*)S.abase(), 0, 0x7fffffff, 0x00020000);
    const __amdgpu_buffer_rsrc_t rsB = __builtin_amdgcn_make_buffer_rsrc((void*)S.bbase(), 0, 0x7fffffff, 0x00020000);
    const unsigned ldsw = (unsigned)wid * 1024u;
    const int aoff = lds_byte(wr * 64 + fr, fq * 8), boff = lds_byte(wc * 32 + fr, fq * 8);
#define PG8_SA(b, h) (((b) * 2 + (h)) * HTB)
#define PG8_SB(b, h) ((4 + (b) * 2 + (h)) * HTB)
#define PG8_STAGE(bufoff, soff, voff) do { _Pragma("unroll") for (int _i = 0; _i < 2; ++_i) \
        __builtin_amdgcn_raw_ptr_buffer_load_lds(rsB, (LAS unsigned*)(lds + (bufoff) + ldsw + _i * 8192), 16, (int)(voff)[_i], (int)(soff), 0, 0); } while (0)
#define PG8_STAGE4(bufoff, soff, o0, o1) do { \
        __builtin_amdgcn_raw_ptr_buffer_load_lds(rsA, (LAS unsigned*)(lds + (bufoff) + ldsw), 16, (int)(o0), (int)(soff), 0, 0); \
        __builtin_amdgcn_raw_ptr_buffer_load_lds(rsA, (LAS unsigned*)(lds + (bufoff) + ldsw + 8192), 16, (int)(o1), (int)(soff), 0, 0); } while (0)
#define PG8_STAGEA(bufoff, p, h, g) do { if constexpr (GATHER) PG8_STAGE4(bufoff, p, (g)[2 * (h)], (g)[2 * (h) + 1]); else PG8_STAGE4(bufoff, (p) + (h) * hstepA, voffA[0], voffA[1]); } while (0)
#define PG8_LDA(dst, b, h) do { _Pragma("unroll") for (int m = 0; m < 4; ++m) { if constexpr (MODE == 2) { dst[m].w.lo = *(const LAS v4i*)(lds + PG8_SA(b, h) + aoff + m * 2048); dst[m].w.hi = *(const LAS v4i*)(lds + PG8_SA(b, h) + aoff + m * 2048 + 1024); } \
        else { dst[m].v[0] = *(const LAS bf16x8*)(lds + PG8_SA(b, h) + aoff + m * 2048); dst[m].v[1] = *(const LAS bf16x8*)(lds + PG8_SA(b, h) + aoff + m * 2048 + 1024); } } } while (0)
#define PG8_LDB(dst, b, h) do { _Pragma("unroll") for (int n = 0; n < 2; ++n) { if constexpr (MODE == 2) { dst[n].w.lo = *(const LAS v4i*)(lds + PG8_SB(b, h) + boff + n * 2048); dst[n].w.hi = *(const LAS v4i*)(lds + PG8_SB(b, h) + boff + n * 2048 + 1024); } \
        else { dst[n].v[0] = *(const LAS bf16x8*)(lds + PG8_SB(b, h) + boff + n * 2048); dst[n].v[1] = *(const LAS bf16x8*)(lds + PG8_SB(b, h) + boff + n * 2048 + 1024); } } } while (0)
#define PG8_MMA(ai, bj, At, Bt) do { __builtin_amdgcn_s_setprio(1); _Pragma("unroll") for (int m = 0; m < 4; ++m) _Pragma("unroll") for (int n = 0; n < 2; ++n) { \
        if constexpr (MODE == 0) { _Pragma("unroll") for (int k = 0; k < 2; ++k) acc[ai][bj][m][n] = __builtin_amdgcn_mfma_f32_16x16x32_bf16(Bt[n].v[k], At[m].v[k], acc[ai][bj][m][n], 0, 0, 0); } \
        else if constexpr (MODE == 1) { _Pragma("unroll") for (int k = 0; k < 2; ++k) acc[ai][bj][m][n] = __builtin_amdgcn_mfma_i32_16x16x64_i8(__builtin_bit_cast(v4i, Bt[n].v[k]), __builtin_bit_cast(v4i, At[m].v[k]), acc[ai][bj][m][n], 0, 0, 0); } \
        else if constexpr (MODE == 3) { _Pragma("unroll") for (int k = 0; k < 2; ++k) { const v2l bb_ = __builtin_bit_cast(v2l, Bt[n].v[k]), aa_ = __builtin_bit_cast(v2l, At[m].v[k]); \
            acc[ai][bj][m][n] = __builtin_amdgcn_mfma_f32_16x16x32_fp8_fp8(bb_[0], aa_[0], acc[ai][bj][m][n], 0, 0, 0); acc[ai][bj][m][n] = __builtin_amdgcn_mfma_f32_16x16x32_fp8_fp8(bb_[1], aa_[1], acc[ai][bj][m][n], 0, 0, 0); } } \
        else { acc[ai][bj][m][n] = __builtin_amdgcn_mfma_scale_f32_16x16x128_f8f6f4(Bt[n].w, At[m].w, acc[ai][bj][m][n], 0, 0, 0, 0x7f7f7f7f, 0, 0x7f7f7f7f); } \
        } __builtin_amdgcn_s_setprio(0); } while (0)
#define PG8_WAIT_V(n) asm volatile("s_waitcnt vmcnt(" #n ")" ::: "memory")
#define PG8_WAIT_L(n) asm volatile("s_waitcnt lgkmcnt(" #n ")" ::: "memory")
#define PG8_BAR __builtin_amdgcn_s_barrier()
#define PG8_SCHED __builtin_amdgcn_sched_barrier(0)
    Unit cur, nxt, nn; int ui = 0;
    if (!S.next(0, cur)) return;
    bool has_next = S.next(1, nxt);
    if constexpr (GATHER) {
#pragma unroll
        for (int h = 0; h < 2; ++h)
#pragma unroll
            for (int i = 0; i < 2; ++i) { gc[2 * h + i] = (unsigned)S.row_src(cur, h * HALF + Rst[i]) * (unsigned)ROWB + (unsigned)(Cst[i] * 2);
                                          gn[2 * h + i] = has_next ? (unsigned)S.row_src(nxt, h * HALF + Rst[i]) * (unsigned)ROWB + (unsigned)(Cst[i] * 2) : 0u; }
    }
    ACC acc[2][2][4][2];
#pragma unroll
    for (int a = 0; a < 2; ++a)
#pragma unroll
        for (int b = 0; b < 2; ++b)
#pragma unroll
            for (int m = 0; m < 4; ++m)
#pragma unroll
                for (int n = 0; n < 2; ++n) acc[a][b][m][n] = (ACC){0, 0, 0, 0};
    Frag<MODE> At[4], B0[2], B1[2];
    unsigned cA = (unsigned)(cur.a - S.abase()), cB = (unsigned)(cur.b - S.bbase());
    if constexpr (SP2) {
        PG8_STAGE(PG8_SB(0, 0), cB, voffB); PG8_STAGE(PG8_SB(0, 1), cB + hstepB, voffB); PG8_STAGEA(PG8_SA(0, 0), cA, 0, gc); PG8_STAGEA(PG8_SA(0, 1), cA, 1, gc);
        if (wr == 1) PG8_BAR;
        PG8_WAIT_V(2); PG8_BAR;
        PG8_STAGE(PG8_SB(1, 0), cB + kstep, voffB); PG8_STAGEA(PG8_SA(1, 0), cA + kstep, 0, gc); PG8_STAGE(PG8_SB(1, 1), cB + hstepB + kstep, voffB);
        PG8_WAIT_V(6); PG8_BAR;
    } else {
        PG8_STAGE(PG8_SB(0, 0), cB, voffB); PG8_STAGEA(PG8_SA(0, 0), cA, 0, gc); PG8_STAGE(PG8_SB(0, 1), cB + hstepB, voffB); PG8_STAGEA(PG8_SA(0, 1), cA, 1, gc);
        if (wr == 1) PG8_BAR;
        PG8_WAIT_V(4); PG8_BAR;
        PG8_STAGE(PG8_SB(1, 0), cB + kstep, voffB); PG8_STAGEA(PG8_SA(1, 0), cA + kstep, 0, gc); PG8_STAGE(PG8_SB(1, 1), cB + hstepB + kstep, voffB);
        PG8_WAIT_V(6); PG8_BAR;
    }
    for (;;) {
        const unsigned nA = has_next ? (unsigned)(nxt.a - S.abase()) : cA, nB = has_next ? (unsigned)(nxt.b - S.bbase()) : cB;
        for (int t = 0; t < nt; t += 2) {
            const bool last = (t == nt - 2);
            const unsigned a1 = cA + (unsigned)(t + 1) * kstep;
            const unsigned a2 = last ? nA : cA + (unsigned)(t + 2) * kstep, b2 = last ? nB : cB + (unsigned)(t + 2) * kstep;
            const unsigned a3 = a2 + kstep, b3 = b2 + kstep;
            unsigned g2[4];
#pragma unroll
            for (int i = 0; i < 4; ++i) g2[i] = (last && has_next) ? gn[i] : gc[i];
            if constexpr (SP2) {
            PG8_LDB(B0, 0, 0); PG8_LDB(B1, 0, 1); PG8_SCHED; PG8_LDA(At, 0, 0); PG8_STAGEA(PG8_SA(1, 1), a1, 1, gc);
            PG8_WAIT_V(8); PG8_WAIT_L(0); PG8_BAR; PG8_MMA(0, 0, At, B0); PG8_MMA(0, 1, At, B1); PG8_BAR; PG8_SCHED;
            PG8_LDA(At, 0, 1); PG8_STAGE(PG8_SB(0, 0), b2, voffB); PG8_STAGE(PG8_SB(0, 1), b2 + hstepB, voffB); PG8_STAGEA(PG8_SA(0, 0), a2, 0, g2);
            PG8_WAIT_V(8); PG8_WAIT_L(0); PG8_BAR; PG8_MMA(1, 0, At, B0); PG8_MMA(1, 1, At, B1); PG8_BAR; PG8_SCHED;
            PG8_LDB(B0, 1, 0); PG8_LDB(B1, 1, 1); PG8_SCHED; PG8_LDA(At, 1, 0); PG8_STAGEA(PG8_SA(0, 1), a2, 1, g2);
            PG8_WAIT_V(8); PG8_WAIT_L(0); PG8_BAR; PG8_MMA(0, 0, At, B0); PG8_MMA(0, 1, At, B1); PG8_BAR; PG8_SCHED;
            PG8_LDA(At, 1, 1); PG8_STAGE(PG8_SB(1, 0), b3, voffB); PG8_STAGE(PG8_SB(1, 1), b3 + hstepB, voffB); PG8_STAGEA(PG8_SA(1, 0), a3, 0, g2);
            PG8_WAIT_V(8); PG8_WAIT_L(0); PG8_BAR; PG8_MMA(1, 0, At, B0); PG8_MMA(1, 1, At, B1); PG8_BAR; PG8_SCHED;
            } else {
            PG8_LDB(B0, 0, 0); PG8_SCHED; PG8_LDA(At, 0, 0); PG8_STAGEA(PG8_SA(1, 1), a1, 1, gc);
            PG8_WAIT_L(8); PG8_BAR; PG8_WAIT_L(0); PG8_MMA(0, 0, At, B0); PG8_BAR; PG8_SCHED;
            PG8_LDB(B1, 0, 1); PG8_STAGE(PG8_SB(0, 0), b2, voffB);
            PG8_BAR; PG8_WAIT_L(0); PG8_MMA(0, 1, At, B1); PG8_BAR;
            PG8_LDA(At, 0, 1); PG8_STAGEA(PG8_SA(0, 0), a2, 0, g2);
            PG8_BAR; PG8_WAIT_L(0); PG8_MMA(1, 0, At, B0); PG8_BAR; PG8_SCHED;
            PG8_STAGE(PG8_SB(0, 1), b2 + hstepB, voffB);
            PG8_WAIT_V(6); PG8_BAR; PG8_MMA(1, 1, At, B1); PG8_BAR;
            PG8_LDB(B0, 1, 0); PG8_SCHED; PG8_LDA(At, 1, 0); PG8_STAGEA(PG8_SA(0, 1), a2, 1, g2);
            PG8_WAIT_L(8); PG8_BAR; PG8_WAIT_L(0); PG8_MMA(0, 0, At, B0); PG8_BAR; PG8_SCHED;
            PG8_LDB(B1, 1, 1); PG8_STAGE(PG8_SB(1, 0), b3, voffB);
            PG8_BAR; PG8_WAIT_L(0); PG8_MMA(0, 1, At, B1); PG8_BAR;
            PG8_LDA(At, 1, 1); PG8_STAGEA(PG8_SA(1, 0), a3, 0, g2);
            PG8_BAR; PG8_WAIT_L(0); PG8_MMA(1, 0, At, B0); PG8_BAR; PG8_SCHED;
            PG8_STAGE(PG8_SB(1, 1), b3 + hstepB, voffB);
            PG8_WAIT_V(6); PG8_BAR; PG8_MMA(1, 1, At, B1); PG8_BAR;
            }
        }
        if constexpr (ALIGN_EPI) { if (wr == 0) PG8_BAR; }
        const bool has_nn = has_next && S.next(ui + 2, nn);
        unsigned g3[4] = {0u, 0u, 0u, 0u};
        if constexpr (GATHER) { if (has_nn) {
#pragma unroll
            for (int h = 0; h < 2; ++h)
#pragma unroll
                for (int i = 0; i < 2; ++i) g3[2 * h + i] = (unsigned)S.row_src(nn, h * HALF + Rst[i]) * (unsigned)ROWB + (unsigned)(Cst[i] * 2); } }
        E(acc, cur, wr, wc, fr, fq);
        if constexpr (GATHER) asm volatile("" : "+v"(g3[0]), "+v"(g3[1]), "+v"(g3[2]), "+v"(g3[3]));
        if (!has_next) break;
#pragma unroll
        for (int a = 0; a < 2; ++a)
#pragma unroll
            for (int b = 0; b < 2; ++b)
#pragma unroll
                for (int m = 0; m < 4; ++m)
#pragma unroll
                    for (int n = 0; n < 2; ++n) acc[a][b][m][n] = (ACC){0, 0, 0, 0};
#pragma unroll
        for (int i = 0; i < 4; ++i) { gc[i] = gn[i]; gn[i] = g3[i]; }
        cur = nxt; cA = nA; cB = nB; ++ui; nxt = nn; has_next = has_nn;
        if constexpr (ALIGN_EPI) { if (wr == 1) PG8_BAR; }
    }
    PG8_WAIT_V(0);
    if constexpr (!ALIGN_EPI) { if (wr == 0) PG8_BAR; }
    PG8_BAR;
#undef PG8_SA
#undef PG8_SB
#undef PG8_STAGE
#undef PG8_STAGE4
#undef PG8_STAGEA
#undef PG8_LDA
#undef PG8_LDB
#undef PG8_MMA
#undef PG8_WAIT_V
#undef PG8_WAIT_L
#undef PG8_BAR
#undef PG8_SCHED
}
}

struct Args { const float* in[16]; float* out; unsigned char* ws; int ph_lo, ph_hi; int never, pad; };
struct Frame {
    LAS unsigned char* lds;
    gu32* ctl;
    int tid, lane, wave, G;
    const float *x, *norm_mix_g, *norm_ffn_g, *pool_w, *pool_scale, *w_qkv, *q_gain, *k_gain, *w_o, *rel_bias, *w_router, *b_router, *w_gu, *b_gu, *w_dn, *b_dn;
    float* out; unsigned char* ws;
};

__device__ __forceinline__ void transpose_item(const float* W, int K, int N, bf16* WT, LAS float* scr, int item, int lane) {
    const int nblk = N / 32, kb = item / nblk, nb = item % nblk, k0 = 64 * kb, n0 = 32 * nb;
#pragma unroll 8
    for (int i = 0; i < 32; ++i) { const int kk = 2 * i + (lane >> 5); scr[kk * 33 + (lane & 31)] = W[(size_t)(k0 + kk) * N + n0 + (lane & 31)]; }
    LDS_WAIT(); asm volatile("" ::: "memory");
    const int c = lane & 7;
#pragma unroll
    for (int j = 0; j < 4; ++j) { const int n = (lane >> 3) + 8 * j; const LAS float* s = scr + (8 * c) * 33 + n;
        u32x4 o; o.x = pk2(s[0 * 33], s[1 * 33]); o.y = pk2(s[2 * 33], s[3 * 33]); o.z = pk2(s[4 * 33], s[5 * 33]); o.w = pk2(s[6 * 33], s[7 * 33]);
        *(GAS u32x4*)(WT + (size_t)(n0 + n) * K + k0 + 8 * c) = o; }
    LDS_WAIT(); asm volatile("" ::: "memory");
}
struct SlabDesc { const float* W; int N, n0, fmt; unsigned char* Q; float* SC; };
constexpr int S_GU = 64 * 64, S_QKV = 288, S_DN = 64 * 32, S_WO = 32, NSLAB = S_GU + S_QKV + S_DN + S_WO;
__device__ __forceinline__ SlabDesc slab_desc(Frame& F, int sl) {
    SlabDesc d;
    if (sl < S_GU) { const int mat = sl >> 6; d.W = F.w_gu + (size_t)mat * 1024 * 2048; d.N = 2048; d.n0 = (sl & 63) * 32; d.fmt = 1; d.Q = F.ws + WS_WGU + (size_t)mat * 2048 * 1024; d.SC = (float*)(F.ws + WS_SC_GU) + mat * 2048; return d; }
    sl -= S_GU;
    if (sl < S_QKV) { d.W = F.w_qkv; d.N = NQKV; d.n0 = sl * 32; d.fmt = 1; d.Q = F.ws + WS_WQKV; d.SC = (float*)(F.ws + WS_SC_QKV); return d; }
    sl -= S_QKV;
    if (sl < S_DN / 2) { const int mat = sl >> 5; d.W = F.w_dn + (size_t)mat * 1024 * 1024; d.N = 1024; d.n0 = (sl & 31) * 32; d.fmt = 2; d.Q = F.ws + WS_WDN + (size_t)mat * 1024 * 1024; d.SC = (float*)(F.ws + WS_SC_DN) + mat * 1024; return d; }
    sl -= S_DN / 2;
    if (sl < S_WO) { d.W = F.w_o; d.N = 1024; d.n0 = sl * 32; d.fmt = 2; d.Q = F.ws + WS_WO; d.SC = (float*)(F.ws + WS_SC_WO); return d; }
    sl -= S_WO;
    { const int mat = 32 + (sl >> 5); d.W = F.w_dn + (size_t)mat * 1024 * 1024; d.N = 1024; d.n0 = (sl & 31) * 32; d.fmt = 2; d.Q = F.ws + WS_WDN + (size_t)mat * 1024 * 1024; d.SC = (float*)(F.ws + WS_SC_DN) + mat * 1024; return d; }
}
__device__ __forceinline__ void slab_load(const SlabDesc& d, int tid, f32x4 (&v)[16]) {
    const GAS f32x4* p = (const GAS f32x4*)(d.W + (size_t)(16 * (tid >> 3)) * d.N + d.n0 + 4 * (tid & 7));
    const int rs = d.N >> 2;
#pragma unroll
    for (int j = 0; j < 16; ++j) v[j] = __builtin_nontemporal_load(p + (size_t)j * rs);
}
__device__ __forceinline__ void slab_process(Frame& F, const SlabDesc& d, const f32x4 (&v)[16], int& par) {
    const int tid = F.tid, c4 = tid & 7, kq = tid >> 3;
    if (d.fmt == 0) {
        bf16* WT = (bf16*)d.Q;
#pragma unroll
        for (int c = 0; c < 4; ++c) {
            u32x4 o0, o1;
            o0.x = cvt_pk_bf16(v[0][c], v[1][c]); o0.y = cvt_pk_bf16(v[2][c], v[3][c]); o0.z = cvt_pk_bf16(v[4][c], v[5][c]); o0.w = cvt_pk_bf16(v[6][c], v[7][c]);
            o1.x = cvt_pk_bf16(v[8][c], v[9][c]); o1.y = cvt_pk_bf16(v[10][c], v[11][c]); o1.z = cvt_pk_bf16(v[12][c], v[13][c]); o1.w = cvt_pk_bf16(v[14][c], v[15][c]);
            GAS u32x4* q = (GAS u32x4*)(WT + (size_t)(d.n0 + 4 * c4 + c) * 1024 + 16 * kq);
            q[0] = o0; q[1] = o1;
        }
        return;
    }
    f32x4 am;
#pragma unroll
    for (int c = 0; c < 4; ++c) { float m = fabsf(v[0][c]);
#pragma unroll
        for (int j = 1; j < 16; ++j) m = fmaxf(m, fabsf(v[j][c]));
        unsigned u = __builtin_bit_cast(unsigned, m);
        { const unsigned o = (unsigned)__builtin_amdgcn_update_dpp(0, (int)u, 0x128, 0xf, 0xf, false); u = u > o ? u : o; }
        { const auto s1 = __builtin_amdgcn_permlane16_swap(u, u, false, false); u = s1[0] > s1[1] ? s1[0] : s1[1]; }
        { const auto s2 = __builtin_amdgcn_permlane32_swap(u, u, false, false); u = s2[0] > s2[1] ? s2[0] : s2[1]; }
        am[c] = __builtin_bit_cast(float, u); }
    LAS f32x4* red = (LAS f32x4*)(F.lds + L_SLOTE) + par * 64;
    par ^= 1;
    if (F.lane < 8) red[F.wave * 8 + F.lane] = am;
    __syncthreads();
    f32x4 m = red[c4];
#pragma unroll
    for (int w = 1; w < 8; ++w) { const f32x4 r = red[w * 8 + c4]; m.x = fmaxf(m.x, r.x); m.y = fmaxf(m.y, r.y); m.z = fmaxf(m.z, r.z); m.w = fmaxf(m.w, r.w); }
    const float qmax = d.fmt == 2 ? 448.f : 127.f;
    if (tid < 8) *(f32x4*)(d.SC + d.n0 + 4 * tid) = m * (1.f / qmax);
    if (d.fmt == 2) {
#pragma unroll
        for (int c = 0; c < 4; ++c) {
            const float qs = m[c] > 0.f ? qmax / m[c] : 0.f;
            u32x4 o;
#pragma unroll
            for (int dd = 0; dd < 4; ++dd) { const int w0 = __builtin_amdgcn_cvt_pk_fp8_f32(v[4 * dd][c] * qs, v[4 * dd + 1][c] * qs, 0, false);
                o[dd] = (unsigned)__builtin_amdgcn_cvt_pk_fp8_f32(v[4 * dd + 2][c] * qs, v[4 * dd + 3][c] * qs, w0, true); }
            __builtin_nontemporal_store(o, (GAS u32x4*)(d.Q + (size_t)(d.n0 + 4 * c4 + c) * 1024 + 16 * kq));
        }
        return;
    }
#pragma unroll
    for (int c = 0; c < 4; ++c) {
        const float qs = m[c] > 0.f ? 127.f / m[c] : 0.f;
        u32x4 o;
#pragma unroll
        for (int dd = 0; dd < 4; ++dd) { const int q0 = (int)rintf(v[4 * dd][c] * qs), q1 = (int)rintf(v[4 * dd + 1][c] * qs), q2 = (int)rintf(v[4 * dd + 2][c] * qs), q3 = (int)rintf(v[4 * dd + 3][c] * qs);
            o[dd] = (unsigned)(q0 & 255) | ((unsigned)(q1 & 255) << 8) | ((unsigned)(q2 & 255) << 16) | ((unsigned)q3 << 24); }
        __builtin_nontemporal_store(o, (GAS u32x4*)(d.Q + (size_t)(d.n0 + 4 * c4 + c) * 1024 + 16 * kq));
    }
}
constexpr int SLAB_D0 = S_GU - NDEFER, NSLAB0 = NSLAB - NDEFER;
__device__ __forceinline__ int slab_id(int n) { return n < SLAB_D0 ? n : n + NDEFER; }
template <bool REMAP>
__device__ __forceinline__ void convert_slabs(Frame& F, int base, int count) {
    f32x4 a[16], b[16];
    int par = 0;
    int n = blockIdx.x;
    if (n < count) { const SlabDesc d = slab_desc(F, REMAP ? slab_id(n) : base + n); slab_load(d, F.tid, a); }
    for (; n < count; n += F.G) {
        const SlabDesc d = slab_desc(F, REMAP ? slab_id(n) : base + n);
        const bool hn = n + F.G < count;
        if (hn) { const SlabDesc dn = slab_desc(F, REMAP ? slab_id(n + F.G) : base + n + F.G); slab_load(dn, F.tid, b); }
        slab_process(F, d, a, par);
        if (hn) {
#pragma unroll
            for (int j = 0; j < 16; ++j) a[j] = b[j]; }
    }
    __syncthreads();
}
constexpr int NLATE = S_DN / 2;
template <int PART>
__device__ __forceinline__ void phase_convert(Frame& F) {
    if constexpr (PART == 1) {
        convert_slabs<true>(F, 0, NSLAB0 - NLATE - 1536);
    } else {
        LAS float* scr = (LAS float*)(F.lds + F.wave * 16384);
        const int gw = blockIdx.x * NWAVES + F.wave, NGW = F.G * NWAVES;
        for (int r = gw; r < 4 * 32; r += NGW) { const int mat = r >> 5; transpose_item(F.pool_w + (size_t)mat * 65536, 256, 256, (bf16*)(F.ws + WS_WPOOL) + (size_t)mat * 65536, scr, r & 31, F.lane); }
        unsigned short* wh = (unsigned short*)(F.ws + WS_WRT); unsigned short* wl = wh + 2 * 32 * 1024;
        for (int i = blockIdx.x * NTHREADS + F.tid; i < 2 * 32 * 1024; i += F.G * NTHREADS) {
            const int l = i >> 15, e = (i >> 10) & 31, c = i & 1023;
            const float w = F.w_router[(size_t)(l * 1024 + c) * 32 + e] * F.norm_ffn_g[l * 1024 + c];
            const unsigned hi = f2bf(w); const float r = w - bf2f((unsigned short)hi);
            wh[i] = (unsigned short)hi; wl[i] = (unsigned short)f2bf(r); }
    }
}

constexpr int NMAIN = NSLAB0 - NLATE, NTAIL = 1536, CW_TAIL = 176;
template <int POOL>
__device__ __forceinline__ int defer_ticket(Frame& F) {
    LAS int* tk = (LAS int*)(F.lds + L_TICKET);
    __syncthreads();
    if (F.tid == 0) tk[0] = (int)__hip_atomic_fetch_add((unsigned*)(F.ctl + (POOL == 0 ? CW_TICKET : CW_TAIL)), 1u, RLX_AGENT);
    __syncthreads();
    return tk[0];
}
template <int POOL>
__device__ __forceinline__ void defer_run(Frame& F, int quota) {
    constexpr int COUNT = POOL == 0 ? NDEFER : NTAIL;
    int t = defer_ticket<POOL>(F);
    if (t >= COUNT) return;
    f32x4 a[16], b[16];
    int par = 0;
    { const SlabDesc d = slab_desc(F, POOL == 0 ? SLAB_D0 + t : slab_id(NMAIN - NTAIL + t)); slab_load(d, F.tid, a); }
    for (int q = 0; q < quota; ++q) {
        const SlabDesc d = slab_desc(F, POOL == 0 ? SLAB_D0 + t : slab_id(NMAIN - NTAIL + t));
        int tn = COUNT;
        if (q + 1 < quota) tn = defer_ticket<POOL>(F);
        if (tn < COUNT) { const SlabDesc dn = slab_desc(F, POOL == 0 ? SLAB_D0 + tn : slab_id(NMAIN - NTAIL + tn)); slab_load(dn, F.tid, b); }
        slab_process(F, d, a, par);
        t = tn; if (t >= COUNT) break;
#pragma unroll
        for (int j = 0; j < 16; ++j) a[j] = b[j];
    }
    __syncthreads();
}

__device__ __forceinline__ void quant_row_i8(const f32x4 (&h)[4], unsigned (&w)[4], float& inv) {
    float am = 0.f;
#pragma unroll
    for (int j = 0; j < 4; ++j) am = fmaxf(fmaxf(am, fmaxf(fabsf(h[j].x), fabsf(h[j].y))), fmaxf(fabsf(h[j].z), fabsf(h[j].w)));
#pragma unroll
    for (int o = 1; o < 64; o <<= 1) am = fmaxf(am, __shfl_xor(am, o));
    const float qs = am > 0.f ? 127.f / am : 0.f; inv = am * (1.f / 127.f);
#pragma unroll
    for (int j = 0; j < 4; ++j) { const int q0 = (int)rintf(h[j].x * qs), q1 = (int)rintf(h[j].y * qs), q2 = (int)rintf(h[j].z * qs), q3 = (int)rintf(h[j].w * qs);
        w[j] = (unsigned)(q0 & 255) | ((unsigned)(q1 & 255) << 8) | ((unsigned)(q2 & 255) << 16) | ((unsigned)q3 << 24); }
}

__device__ __forceinline__ void argmax32(float& bv, int& bi) {
#define AM_STEP(ctrl) do { const float ov = __builtin_bit_cast(float, __builtin_amdgcn_update_dpp(0, __builtin_bit_cast(int, bv), (ctrl), 0xf, 0xf, false)); \
        const int oi = __builtin_amdgcn_update_dpp(0, bi, (ctrl), 0xf, 0xf, false); if (ov > bv || (ov == bv && oi < bi)) { bv = ov; bi = oi; } } while (0)
    AM_STEP(0xB1);
    AM_STEP(0x4E);
    AM_STEP(0x141);
    AM_STEP(0x140);
#undef AM_STEP
    { const auto sv = __builtin_amdgcn_permlane16_swap(__builtin_bit_cast(unsigned, bv), __builtin_bit_cast(unsigned, bv), false, false);
      const auto si = __builtin_amdgcn_permlane16_swap((unsigned)bi, (unsigned)bi, false, false);
      const float v0 = __builtin_bit_cast(float, (unsigned)sv[0]), v1 = __builtin_bit_cast(float, (unsigned)sv[1]); const int i0 = (int)si[0], i1 = (int)si[1];
      if (v1 > v0 || (v1 == v0 && i1 < i0)) { bv = v1; bi = i1; } else { bv = v0; bi = i0; } }
}
template <bool XBF>
__device__ __forceinline__ void router_tile(Frame& F, int layer, int tok0, bool dry) {
    const bf16* XB = (const bf16*)(F.ws + WS_XB);
    LAS int* hist = (LAS int*)(F.lds + L_HIST); LAS int* base = (LAS int*)(F.lds + L_BASE);
    LAS int* slot_e = (LAS int*)(F.lds + L_SLOTE); LAS int* slot_p = (LAS int*)(F.lds + L_SLOTP); LAS float* slot_g = (LAS float*)(F.lds + L_SLOTG);
    LAS float* rstdL = (LAS float*)(F.lds + L_RSTD);
    LAS float* part = (LAS float*)F.lds;
    const int lane = F.lane, wave = F.wave;
    if (F.tid < 32) hist[F.tid] = 0;
    const float* g2 = F.norm_ffn_g + layer * 1024;
    unsigned char* H2 = F.ws + WS_H2; float* HS = (float*)(F.ws + WS_HS);
    {
        f32x4 gv[4];
#pragma unroll
        for (int j = 0; j < 4; ++j) gv[j] = *(const f32x4*)(g2 + lane * 4 + 256 * j);
#pragma unroll 1
        for (int half = 0; half < 2; ++half) {
            f32x4 h[4][4];
#pragma unroll
            for (int r = 0; r < 4; ++r) {
                if constexpr (XBF) { const GAS u32x2* xr = (const GAS u32x2*)(XB + (size_t)(tok0 + wave * 8 + half * 4 + r) * 1024) + lane;
#pragma unroll
                    for (int j = 0; j < 4; ++j) h[r][j] = bf4(xr[64 * j]); }
                else { const GAS f32x4* xr = (const GAS f32x4*)(F.out + (size_t)(tok0 + wave * 8 + half * 4 + r) * 1024) + lane;
#pragma unroll
                    for (int j = 0; j < 4; ++j) h[r][j] = xr[64 * j]; } }
#pragma unroll
            for (int r = 0; r < 4; ++r) {
                const int row = wave * 8 + half * 4 + r, tok = tok0 + row;
                float ss = 0.f;
#pragma unroll
                for (int j = 0; j < 4; ++j) ss += (h[r][j].x * h[r][j].x + h[r][j].y * h[r][j].y) + (h[r][j].z * h[r][j].z + h[r][j].w * h[r][j].w);
                const float rstd = rsqrtf(wave_sum(ss) * (1.f / 1024.f) + EPS);
#pragma unroll
                for (int j = 0; j < 4; ++j) h[r][j] = h[r][j] * rstd * gv[j];
                unsigned qw[4]; float inv; quant_row_i8(h[r], qw, inv);
                GAS unsigned* o4 = (GAS unsigned*)(H2 + (size_t)tok * 1024) + lane;
#pragma unroll
                for (int j = 0; j < 4; ++j) o4[64 * j] = qw[j];
                if (lane == 0) { HS[tok] = inv; rstdL[row] = rstd; }
            }
        }
    }
    {
        const unsigned short* wh = (const unsigned short*)(F.ws + WS_WRT) + (size_t)layer * 32 * 1024; const unsigned short* wl = wh + 2 * 32 * 1024;
        const int r = lane & 31, kh = lane >> 5;
        bf16x8 bh[8], bl[8];
#pragma unroll
        for (int st = 0; st < 8; ++st) { bh[st] = *(const GAS bf16x8*)(wh + (size_t)r * 1024 + 128 * wave + 16 * st + 8 * kh); bl[st] = *(const GAS bf16x8*)(wl + (size_t)r * 1024 + 128 * wave + 16 * st + 8 * kh); }
        f32x16 acc0, acc1;
#pragma unroll
        for (int i = 0; i < 16; ++i) { acc0[i] = 0.f; acc1[i] = 0.f; }
        bf16x8 a0[8], a1[8];
#pragma unroll
        for (int st = 0; st < 8; ++st) { a0[st] = *(const GAS bf16x8*)(XB + (size_t)(tok0 + r) * 1024 + 128 * wave + 16 * st + 8 * kh);
                                         a1[st] = *(const GAS bf16x8*)(XB + (size_t)(tok0 + 32 + r) * 1024 + 128 * wave + 16 * st + 8 * kh); }
#pragma unroll
        for (int st = 0; st < 8; ++st) {
            acc0 = __builtin_amdgcn_mfma_f32_32x32x16_bf16(a0[st], bh[st], acc0, 0, 0, 0); acc0 = __builtin_amdgcn_mfma_f32_32x32x16_bf16(a0[st], bl[st], acc0, 0, 0, 0);
            acc1 = __builtin_amdgcn_mfma_f32_32x32x16_bf16(a1[st], bh[st], acc1, 0, 0, 0); acc1 = __builtin_amdgcn_mfma_f32_32x32x16_bf16(a1[st], bl[st], acc1, 0, 0, 0);
        }
        __syncthreads();
#pragma unroll
        for (int rg = 0; rg < 16; ++rg) { const int row = (rg & 3) + 8 * (rg >> 2) + 4 * kh;
            part[(wave * 64 + row) * 32 + r] = acc0[rg]; part[(wave * 64 + 32 + row) * 32 + r] = acc1[rg]; }
    }
    __syncthreads();
    {
        const int e = lane & 31, kh = lane >> 5;
        const float brl = F.b_router[layer * 32 + e];
#pragma unroll
        for (int rr = 0; rr < 4; ++rr) {
            const int row = wave * 8 + rr + 4 * kh;
            float v = 0.f;
#pragma unroll
            for (int w = 0; w < 8; ++w) v += part[(w * 64 + row) * 32 + e];
            v = v * rstdL[row] + brl;
            float tv[4]; int ti[4];
#pragma unroll
            for (int k = 0; k < 4; ++k) {
                float bv = v; int bi = e;
                argmax32(bv, bi);
                tv[k] = bv; ti[k] = bi; if (e == bi) v = -INFINITY;
            }
            const float e1 = __expf(tv[1] - tv[0]), e2 = __expf(tv[2] - tv[0]), e3 = __expf(tv[3] - tv[0]);
            const float inv = 1.f / (1.f + e1 + e2 + e3);
            if (e < 4) {
                const int ex = e == 0 ? ti[0] : e == 1 ? ti[1] : e == 2 ? ti[2] : ti[3];
                const float gt = (e == 0 ? 1.f : e == 1 ? e1 : e == 2 ? e2 : e3) * inv;
                const int lp = atomicAdd((int*)(hist + ex), 1);
                const int sl = row * 4 + e;
                slot_e[sl] = ex; slot_p[sl] = lp; slot_g[sl] = gt;
            }
        }
    }
    __syncthreads();
    if (dry) return;
    if (F.tid < 32) base[F.tid] = (int)__hip_atomic_fetch_add((unsigned*)(F.ctl + CW_CNT + layer * 32 + F.tid), (unsigned)hist[F.tid], RLX_AGENT);
    __syncthreads();
    if (F.tid < 256) {
        const int e = slot_e[F.tid]; const int pos = base[e] + slot_p[F.tid];
        ((int*)(F.ws + WS_ROWSLOT))[e * CAP + pos] = (tok0 + (F.tid >> 2)) * 4 + (F.tid & 3);
        ((float*)(F.ws + WS_ROWGATE))[e * CAP + pos] = slot_g[F.tid];
        ((float*)(F.ws + WS_ROWHS))[e * CAP + pos] = ((const float*)(F.ws + WS_HS))[tok0 + (F.tid >> 2)];
    }
    __syncthreads();
}

__device__ __forceinline__ int pswz(int r, int c) { return r * 2048 + ((((c >> 3) ^ (r & 7)) << 4) | ((c & 7) << 1)); }
template <int W>
__device__ __forceinline__ void pool_chunk(const f32x2 (&v)[8], int sc, int s0, const LAS float* rstd1, float gx, float gy, float (&rx)[W], float (&ry)[W], LAS unsigned char* P, int tid) {
#pragma unroll
    for (int j = 0; j < 8; ++j) {
        const int tl = sc * 8 + j; const float r = rstd1[16 + tl];
        const float hx = v[j].x * r * gx, hy = v[j].y * r * gy;
        constexpr int WM = W < 8 ? W : 8;
        if (W <= 8) { rx[j % WM] = hx; ry[j % WM] = hy; }
        else { if (sc & 1) { rx[(8 + j) % W] = hx; ry[(8 + j) % W] = hy; } else { rx[j % W] = hx; ry[j % W] = hy; } }
        float sx = 0.f, sy = 0.f;
#pragma unroll
        for (int q = 0; q < W; ++q) { sx += rx[q]; sy += ry[q]; }
        const int s = s0 + tl; const int cn = (s + 1 < W) ? (s + 1) : W; const float inv = 1.f / (float)cn;
        *(LAS unsigned*)(P + pswz(tl, 2 * tid)) = pk2(sx * inv - hx, sy * inv - hy);
    }
}
template <int W>
__device__ __forceinline__ void pool_window(const float* __restrict__ x, int tok0, int s0, const LAS float* rstd1, float gx, float gy, LAS unsigned char* P, int tid) {
    float rx[W], ry[W];
    const GAS f32x2* xp = (const GAS f32x2*)x + tid;
    const bool hist = s0 > 0;
    {
        const GAS f32x2* pw = xp + (size_t)(hist ? tok0 - W : tok0) * 512;
#pragma unroll
        for (int j = 0; j < W; ++j) { const f32x2 v = pw[(size_t)j * 512]; const float r = hist ? rstd1[16 - W + j] : 0.f; rx[j] = v.x * r * gx; ry[j] = v.y * r * gy; }
    }
    f32x2 va[8];
    { const GAS f32x2* p0 = xp + (size_t)tok0 * 512;
#pragma unroll
      for (int j = 0; j < 8; ++j) va[j] = p0[(size_t)j * 512]; }
#pragma unroll 2
    for (int sc = 0; sc < 8; ++sc) {
        f32x2 vb[8];
        const GAS f32x2* pn = xp + (size_t)(tok0 + 8 * (sc < 7 ? sc + 1 : 7)) * 512;
#pragma unroll
        for (int j = 0; j < 8; ++j) vb[j] = pn[(size_t)j * 512];
        pool_chunk<W>(va, sc, s0, rstd1, gx, gy, rx, ry, P, tid);
#pragma unroll
        for (int j = 0; j < 8; ++j) va[j] = vb[j];
    }
}
__device__ __forceinline__ void phase_pool(Frame& F, bool dry) {
    LAS unsigned char* P = F.lds;
    LAS float* rstd1 = (LAS float*)(F.lds + L_RSTD);
    const int lane = F.lane, wave = F.wave, tid = F.tid;
    const int fr = lane & 15, fq = lane >> 4;
    const float* __restrict__ xin = F.x; bf16* __restrict__ xb = (bf16*)(F.ws + WS_XB);
    for (int tile = blockIdx.x; tile < NTOK / 64; tile += F.G) {
        const int tok0 = tile * 64, s0 = tok0 & (SEQ - 1);
#pragma unroll 1
        for (int hb = 0; hb < 2; ++hb) {
            f32x4 v[5][4];
#pragma unroll
            for (int k = 0; k < 5; ++k) { const int rr = wave + 8 * (5 * hb + k); const bool ok = (s0 - 16 + rr) >= 0;
                const GAS f32x4* xr = (const GAS f32x4*)(xin + (size_t)(ok ? tok0 - 16 + rr : tok0) * 1024) + lane;
#pragma unroll
                for (int j = 0; j < 4; ++j) v[k][j] = xr[64 * j]; }
#pragma unroll
            for (int k = 0; k < 5; ++k) { const int rr = wave + 8 * (5 * hb + k); const bool ok = (s0 - 16 + rr) >= 0; float ss = 0.f;
#pragma unroll
                for (int j = 0; j < 4; ++j) ss += (v[k][j].x * v[k][j].x + v[k][j].y * v[k][j].y) + (v[k][j].z * v[k][j].z + v[k][j].w * v[k][j].w);
                const float r = rsqrtf(wave_sum(ss) * (1.f / 1024.f) + EPS);
                if (lane == 0) rstd1[rr] = ok ? r : 0.f; }
        }
        __syncthreads();
        { const float gx = F.norm_mix_g[2 * tid], gy = F.norm_mix_g[2 * tid + 1];
          const int grp = wave >> 1;
          if (grp == 0) pool_window<2>(xin, tok0, s0, rstd1, gx, gy, P, tid);
          else if (grp == 1) pool_window<4>(xin, tok0, s0, rstd1, gx, gy, P, tid);
          else if (grp == 2) pool_window<8>(xin, tok0, s0, rstd1, gx, gy, P, tid);
          else pool_window<16>(xin, tok0, s0, rstd1, gx, gy, P, tid); }
        __syncthreads();
        { const int gi = wave >> 1, nh = wave & 1;
#pragma unroll 1
          for (int np = 0; np < 2; ++np) {
              const bf16* Wt = (const bf16*)(F.ws + WS_WPOOL) + (size_t)gi * 65536 + (size_t)(nh * 128 + np * 64) * 256;
              f32x4 acc[4][4];
#pragma unroll
              for (int m = 0; m < 4; ++m)
#pragma unroll
                  for (int n = 0; n < 4; ++n) acc[m][n] = (f32x4){0.f, 0.f, 0.f, 0.f};
#pragma unroll 4
              for (int ks = 0; ks < 8; ++ks) {
                  bf16x8 a[4];
#pragma unroll
                  for (int m = 0; m < 4; ++m) a[m] = *(const LAS bf16x8*)(P + pswz(m * 16 + fr, gi * 256 + ks * 32 + fq * 8));
#pragma unroll
                  for (int n = 0; n < 4; ++n) {
                      const bf16x8 b = *(const GAS bf16x8*)(Wt + (size_t)(n * 16 + fr) * 256 + ks * 32 + fq * 8);
#pragma unroll
                      for (int m = 0; m < 4; ++m) acc[m][n] = __builtin_amdgcn_mfma_f32_16x16x32_bf16(b, a[m], acc[m][n], 0, 0, 0);
                  }
              }
              const int colb = gi * 256 + nh * 128 + np * 64 + fq * 4;
              f32x4 xv[4][4], sc[4];
#pragma unroll
              for (int n = 0; n < 4; ++n) { sc[n] = *(const f32x4*)(F.pool_scale + colb + n * 16);
#pragma unroll
                  for (int m = 0; m < 4; ++m) xv[n][m] = *(const GAS f32x4*)(xin + (size_t)(tok0 + m * 16 + fr) * 1024 + colb + n * 16); }
#pragma unroll
              for (int n = 0; n < 4; ++n)
#pragma unroll
                  for (int m = 0; m < 4; ++m) { const f32x4 r = xv[n][m] + acc[m][n] * sc[n];
                      *(GAS u32x2*)(xb + (size_t)(tok0 + m * 16 + fr) * 1024 + colb + n * 16) = (u32x2){cvt_pk_bf16(r[0], r[1]), cvt_pk_bf16(r[2], r[3])}; }
          }
        }
    }
    VM_WAIT();
    __syncthreads();
    for (int tile = blockIdx.x; tile < NTOK / 64; tile += F.G) router_tile<true>(F, 0, tile * 64, dry);
}
__device__ __forceinline__ void phase_router(Frame& F, int layer, bool dry) {
    const bool conv_first = ((blockIdx.x >> 3) & 1) != 0;
    unsigned tkpre = 0u;
    if (!dry && F.tid == 0) tkpre = __hip_atomic_load((unsigned*)(F.ctl + CW_TICKET), RLX_AGENT);
    if (!dry && conv_first) convert_slabs<false>(F, NSLAB - NLATE, NLATE);
    for (int tile = blockIdx.x; tile < NTOK / 64; tile += F.G) router_tile<true>(F, layer, tile * 64, dry);
    if (!dry) {
        LAS int* tk = (LAS int*)(F.lds + L_TICKET);
        if (F.tid == 0) tk[0] = (int)tkpre;
        __syncthreads();
        const int seen = tk[0];
        __syncthreads();
        if (seen < NDEFER) defer_run<0>(F, 1 << 30);
        if (!conv_first) convert_slabs<false>(F, NSLAB - NLATE, NLATE);
    }
}

__device__ __forceinline__ void moe_tables(Frame& F, int layer) {
    LAS int* cntL = (LAS int*)(F.lds + L_CNT); LAS int* prow0 = (LAS int*)(F.lds + L_PROW0); LAS int* ntp = (LAS int*)(F.lds + L_NT);
    LAS int* tileE = (LAS int*)(F.lds + L_TILEE); LAS int* tileRow = (LAS int*)(F.lds + L_TILEROW);
    __syncthreads();
    if (F.tid < 64) {
        int c = 0;
        if (F.tid < 32) { c = (int)__hip_atomic_load((unsigned*)(F.ctl + CW_CNT + layer * 32 + F.tid), RLX_AGENT); if (c > CAP) c = CAP; }
        const int mt = (c + 255) >> 8;
        int incl = mt;
#pragma unroll
        for (int o = 1; o < 32; o <<= 1) { const int v = __shfl_up(incl, o); if ((F.tid & 63) >= o) incl += v; }
        const int excl = incl - mt;
        if (F.tid < 32) {
            cntL[F.tid] = c; prow0[F.tid] = excl * 256;
            for (int m = 0; m < mt; ++m) if (excl + m < MAXT) { tileE[excl + m] = F.tid; tileRow[excl + m] = (excl + m) * 256; }
            if (F.tid == 31) ntp[0] = incl < MAXT ? incl : MAXT;
        }
    }
    __syncthreads();
}

template <bool GATH>
struct MoeOrderT {
    static constexpr bool GATHER = GATH;
    int NT, nN, G, c, wgm = 2; const LAS int* tileE; const LAS int* tileRow; const LAS int* cntL; const LAS int* prow0; const int* rowslot;
    const char* Abase; const char* Bbase; size_t bExp, bTile; int aPitch;
    __device__ __forceinline__ bool next(int i, pg8::Unit& u) const {
        int T, pn; if (!pg8::tile_order(i, G, c, NT, nN, T, pn, wgm)) return false;
        const int e = tileE[T], row0 = tileRow[T];
        u.a = GATH ? Abase : Abase + (size_t)row0 * aPitch; u.b = Bbase + (size_t)e * bExp + (size_t)pn * bTile; u.i0 = T; u.i1 = pn; u.i2 = e; u.i3 = row0; return true;
    }
    __device__ __forceinline__ const char* abase() const { return Abase; }
    __device__ __forceinline__ const char* bbase() const { return Bbase; }
    __device__ __forceinline__ int row_src(const pg8::Unit& u, int r) const {
        const int e = u.i2, cn = cntL[e]; int pos = u.i3 - prow0[e] + r; pos = pos < cn ? pos : cn - 1;
        return rowslot[e * CAP + pos] >> 2;
    }
};
constexpr int WGM_GU = 1, WGM_DN = 2, WGM_QKV = 2, WGM_WO = 2;
constexpr float ACT_SCALE = 4.f;
struct EpiGU {
    typedef v4i ACC; static constexpr int MODE = 1;
    static __host__ __device__ __forceinline__ int brow(int R) { return (R & ~31) + pg8::perm32(R & 31); }
    unsigned char* ACT; const float* bgu; const float* wsc; const float* rowhs; const LAS int* prow0;
    __device__ __forceinline__ void operator()(const v4i (&acc)[2][2][4][2], const pg8::Unit& u, int wr, int wc, int fr, int fq) const {
        const int e = u.i2, f0 = u.i1 * 128 + wc * 32 + 8 * fq;
        const float* bg = bgu + (size_t)e * 2048 + f0; const float* sp = wsc + (size_t)e * 2048 + f0;
        const f32x4 bg0 = *(const f32x4*)(bg), bg1 = *(const f32x4*)(bg + 4), bu0 = *(const f32x4*)(bg + 1024), bu1 = *(const f32x4*)(bg + 1028);
        const f32x4 sg0 = *(const f32x4*)(sp), sg1 = *(const f32x4*)(sp + 4), su0 = *(const f32x4*)(sp + 1024), su1 = *(const f32x4*)(sp + 1028);
        const int pbase = u.i3 - prow0[e];
        float rsv[2][4];
#pragma unroll
        for (int ai = 0; ai < 2; ++ai)
#pragma unroll
            for (int m = 0; m < 4; ++m) rsv[ai][m] = rowhs[e * CAP + pbase + ai * 128 + wr * 64 + m * 16 + fr];
        const int bcol = u.i1 * 128 + wc * 32 + 8 * (fq & ~1);
#pragma unroll
        for (int ai = 0; ai < 2; ++ai)
#pragma unroll
            for (int mp = 0; mp < 2; ++mp) {
                unsigned pc[2][2];
#pragma unroll
                for (int mi = 0; mi < 2; ++mi) {
                    const int m = 2 * mp + mi; const float rs = rsv[ai][m];
                    const f32x4 ga[2] = {__builtin_convertvector(acc[ai][0][m][0], f32x4), __builtin_convertvector(acc[ai][0][m][1], f32x4)};
                    const f32x4 ua[2] = {__builtin_convertvector(acc[ai][1][m][0], f32x4), __builtin_convertvector(acc[ai][1][m][1], f32x4)};
                    const float rs4 = rs * ACT_SCALE;
                    const f32x4 sgr[2] = {sg0 * rs, sg1 * rs}, sur[2] = {su0 * rs4, su1 * rs4}, bgv[2] = {bg0, bg1}, buv[2] = {(bu0 + 1.f) * ACT_SCALE, (bu1 + 1.f) * ACT_SCALE};
                    float o[8];
#pragma unroll
                    for (int h = 0; h < 2; ++h)
#pragma unroll
                        for (int p = 0; p < 2; ++p) {
                            f32x2 g = (f32x2){ga[h][2 * p], ga[h][2 * p + 1]} * (f32x2){sgr[h][2 * p], sgr[h][2 * p + 1]} + (f32x2){bgv[h][2 * p], bgv[h][2 * p + 1]};
                            f32x2 u1 = (f32x2){ua[h][2 * p], ua[h][2 * p + 1]} * (f32x2){sur[h][2 * p], sur[h][2 * p + 1]} + (f32x2){buv[h][2 * p], buv[h][2 * p + 1]};
                            g.x = fminf(g.x, 7.f); g.y = fminf(g.y, 7.f);
                            u1.x = __builtin_amdgcn_fmed3f(u1.x, -6.f * ACT_SCALE, 8.f * ACT_SCALE); u1.y = __builtin_amdgcn_fmed3f(u1.y, -6.f * ACT_SCALE, 8.f * ACT_SCALE);
                            const f32x2 t = g * (-1.702f * 1.4426950408889634f);
                            f32x2 ex; ex.x = __builtin_amdgcn_exp2f(t.x); ex.y = __builtin_amdgcn_exp2f(t.y);
                            const f32x2 dn = ex + 1.f;
                            f32x2 rcp; rcp.x = __builtin_amdgcn_rcpf(dn.x); rcp.y = __builtin_amdgcn_rcpf(dn.y);
                            const f32x2 r2 = (g * rcp) * u1;
                            o[4 * h + 2 * p] = r2.x; o[4 * h + 2 * p + 1] = r2.y;
                        }
                    int w = __builtin_amdgcn_cvt_pk_fp8_f32(o[0], o[1], 0, false); pc[mi][0] = (unsigned)__builtin_amdgcn_cvt_pk_fp8_f32(o[2], o[3], w, true);
                    w = __builtin_amdgcn_cvt_pk_fp8_f32(o[4], o[5], 0, false); pc[mi][1] = (unsigned)__builtin_amdgcn_cvt_pk_fp8_f32(o[6], o[7], w, true);
                }
                const auto r0 = __builtin_amdgcn_permlane16_swap(pc[0][0], pc[1][0], false, false), r1 = __builtin_amdgcn_permlane16_swap(pc[0][1], pc[1][1], false, false);
                const int prow = u.i3 + ai * 128 + wr * 64 + (2 * mp + (fq & 1)) * 16 + fr;
                *(GAS u32x4*)(ACT + (size_t)prow * 1024 + bcol) = (u32x4){r0[0], r1[0], r0[1], r1[1]};
            }
    }
};
struct EpiDN {
    typedef f32x4 ACC; static constexpr int MODE = 3;
    static __host__ __device__ __forceinline__ int brow(int R) { return (R & ~31) + pg8::perm32(R & 31); }
    unsigned char* Y; const float* bdn; const float* wsc; const int* rowslot; const float* rowgate; const LAS int* cntL; const LAS int* prow0;
    __device__ __forceinline__ void operator()(const f32x4 (&acc)[2][2][4][2], const pg8::Unit& u, int wr, int wc, int fr, int fq) const {
        const int e = u.i2, col0 = u.i1 * 256 + wc * 32 + 8 * fq;
        const float* bp = bdn + (size_t)e * 1024 + col0;
        const float* sp = wsc + (size_t)e * 1024 + col0;
        f32x4 bv[2][2], sv[2][2];
#pragma unroll
        for (int bj = 0; bj < 2; ++bj)
#pragma unroll
            for (int n = 0; n < 2; ++n) { bv[bj][n] = *(const f32x4*)(bp + bj * 128 + 4 * n); sv[bj][n] = *(const f32x4*)(sp + bj * 128 + 4 * n) * (1.f / ACT_SCALE); }
        const int pbase = u.i3 - prow0[e], cn = cntL[e];
        int slotv[2][4]; float gtv[2][4];
#pragma unroll
        for (int ai = 0; ai < 2; ++ai)
#pragma unroll
            for (int m = 0; m < 4; ++m) { const int pos = pbase + ai * 128 + wr * 64 + m * 16 + fr; const int pc = pos < cn ? pos : 0;
                slotv[ai][m] = rowslot[e * CAP + pc]; gtv[ai][m] = rowgate[e * CAP + pc]; }
        const int boff = u.i1 * 256 + wc * 32 + ((fq & 1) ? 128 + 8 * (fq - 1) : 8 * fq);
#pragma unroll
        for (int ai = 0; ai < 2; ++ai)
#pragma unroll
            for (int m = 0; m < 4; ++m) {
                const int pos = pbase + ai * 128 + wr * 64 + m * 16 + fr;
                const float gt = gtv[ai][m];
                unsigned h[2][2];
#pragma unroll
                for (int bj = 0; bj < 2; ++bj) {
                    const f32x4 v0 = (acc[ai][bj][m][0] * sv[bj][0] + bv[bj][0]) * gt, v1 = (acc[ai][bj][m][1] * sv[bj][1] + bv[bj][1]) * gt;
                    int w = __builtin_amdgcn_cvt_pk_fp8_f32(v0[0], v0[1], 0, false); h[bj][0] = (unsigned)__builtin_amdgcn_cvt_pk_fp8_f32(v0[2], v0[3], w, true);
                    w = __builtin_amdgcn_cvt_pk_fp8_f32(v1[0], v1[1], 0, false); h[bj][1] = (unsigned)__builtin_amdgcn_cvt_pk_fp8_f32(v1[2], v1[3], w, true);
                }
                const auto r0 = __builtin_amdgcn_permlane16_swap(h[0][0], h[1][0], false, false), r1 = __builtin_amdgcn_permlane16_swap(h[0][1], h[1][1], false, false);
                const u32x4 wv = {r0[0], r1[0], r0[1], r1[1]};
                if (pos < cn) *(GAS u32x4*)(Y + (size_t)slotv[ai][m] * 1024 + boff) = wv;
            }
    }
};
__device__ __forceinline__ void phase_moe_gu(Frame& F, int layer) {
    moe_tables(F, layer);
    typedef MoeOrderT<true> Ord;
    Ord S; S.NT = *(const LAS int*)(F.lds + L_NT); S.nN = 8; S.wgm = WGM_GU; S.G = F.G; S.c = blockIdx.x; S.tileE = (const LAS int*)(F.lds + L_TILEE); S.tileRow = (const LAS int*)(F.lds + L_TILEROW);
    S.cntL = (const LAS int*)(F.lds + L_CNT); S.prow0 = (const LAS int*)(F.lds + L_PROW0); S.rowslot = (const int*)(F.ws + WS_ROWSLOT);
    S.Abase = (const char*)(F.ws + WS_H2); S.Bbase = (const char*)(F.ws + WS_WGU) + (size_t)layer * 32 * 2048 * 1024; S.bExp = (size_t)2048 * 1024; S.bTile = (size_t)128 * 1024; S.aPitch = 1024;
    EpiGU E; E.ACT = F.ws + WS_ACT; E.bgu = F.b_gu + (size_t)layer * 32 * 2048; E.wsc = (const float*)(F.ws + WS_SC_GU) + (size_t)layer * 32 * 2048; E.rowhs = (const float*)(F.ws + WS_ROWHS);
    E.prow0 = (const LAS int*)(F.lds + L_PROW0);
    pg8::gemm_phase<EpiGU, Ord, true, true>(F.lds, (size_t)1024 * 1024, S, E);
    if (layer == 0) { const int nwg = S.NT * S.nN, mx = (nwg + S.G - 1) / S.G, mine = S.c < nwg ? (nwg - S.c + S.G - 1) / S.G : 0; if (mine < mx) defer_run<0>(F, 1); }
}
__device__ __forceinline__ void phase_moe_dn(Frame& F, int layer) {
#if MK_MULTI
    moe_tables(F, layer);
#endif
    typedef MoeOrderT<false> Ord;
    Ord S; S.NT = *(const LAS int*)(F.lds + L_NT); S.nN = 4; S.wgm = WGM_DN; S.G = F.G; S.c = blockIdx.x; S.tileE = (const LAS int*)(F.lds + L_TILEE); S.tileRow = (const LAS int*)(F.lds + L_TILEROW);
    S.cntL = (const LAS int*)(F.lds + L_CNT); S.prow0 = (const LAS int*)(F.lds + L_PROW0); S.rowslot = (const int*)(F.ws + WS_ROWSLOT);
    S.Abase = (const char*)(F.ws + WS_ACT); S.Bbase = (const char*)(F.ws + WS_WDN) + (size_t)layer * 32 * 1024 * 1024; S.bExp = (size_t)1024 * 1024; S.bTile = (size_t)256 * 1024; S.aPitch = 1024;
    EpiDN E; E.Y = F.ws + WS_Y; E.bdn = F.b_dn + (size_t)layer * 32 * 1024; E.wsc = (const float*)(F.ws + WS_SC_DN) + (size_t)layer * 32 * 1024;
    E.rowslot = (const int*)(F.ws + WS_ROWSLOT); E.rowgate = (const float*)(F.ws + WS_ROWGATE);
    E.cntL = (const LAS int*)(F.lds + L_CNT); E.prow0 = (const LAS int*)(F.lds + L_PROW0);
    pg8::gemm_phase<EpiDN, Ord, true, true>(F.lds, (size_t)128 * 1024, S, E);
    if (layer == 0) { const int nwg = S.NT * S.nN, mx = (nwg + S.G - 1) / S.G, mine = S.c < nwg ? (nwg - S.c + S.G - 1) / S.G : 0; if (mine < mx) defer_run<0>(F, 2); }
}

__device__ __forceinline__ void phase_combine(Frame& F, int layer, bool dry) {
    const int gw = blockIdx.x * NWAVES + F.wave, NGW = F.G * NWAVES, lane = F.lane;
    const unsigned char* Y = F.ws + WS_Y; unsigned char* H2 = F.ws + WS_H2; float* HS = (float*)(F.ws + WS_HS);
    bf16* XB = (bf16*)(F.ws + WS_XB);
    bf16* xb_out = dry ? (bf16*)(F.ws + WS_BIG + 144 * MiB) : XB; float* xf_out = dry ? (float*)(F.ws + WS_BIG + 144 * MiB) : F.out;
    f32x4 gv[4];
#pragma unroll
    for (int j = 0; j < 4; ++j) gv[j] = *(const f32x4*)(F.norm_mix_g + 1024 + lane * 16 + 4 * j);
    for (int tok0 = 2 * gw; tok0 < NTOK; tok0 += 2 * NGW) {
        f32x4 v[2][4]; u32x4 yv[2][4];
#pragma unroll
        for (int tt = 0; tt < 2; ++tt) { const int tok = tok0 + tt;
            { const GAS u32x4* xr = (const GAS u32x4*)(XB + (size_t)tok * 1024) + 2 * lane; const u32x4 q0 = xr[0], q1 = xr[1];
                v[tt][0] = bf4((u32x2){q0.x, q0.y}); v[tt][1] = bf4((u32x2){q0.z, q0.w}); v[tt][2] = bf4((u32x2){q1.x, q1.y}); v[tt][3] = bf4((u32x2){q1.z, q1.w}); }
#pragma unroll
            for (int k = 0; k < 4; ++k) yv[tt][k] = *((const GAS u32x4*)(Y + (size_t)(tok * 4 + k) * 1024) + lane); }
#pragma unroll
        for (int tt = 0; tt < 2; ++tt) { const int tok = tok0 + tt;
#pragma unroll
            for (int k = 0; k < 4; ++k)
#pragma unroll
                for (int j = 0; j < 4; ++j) { const int w = (int)yv[tt][k][j];
                    const f32x2 lo = __builtin_amdgcn_cvt_pk_f32_fp8(w, false), hi = __builtin_amdgcn_cvt_pk_f32_fp8(w, true);
                    v[tt][j].x += lo.x; v[tt][j].y += lo.y; v[tt][j].z += hi.x; v[tt][j].w += hi.y; }
            if (layer == 0) {
                float ss = 0.f;
#pragma unroll
                for (int j = 0; j < 4; ++j) ss += (v[tt][j].x * v[tt][j].x + v[tt][j].y * v[tt][j].y) + (v[tt][j].z * v[tt][j].z + v[tt][j].w * v[tt][j].w);
                GAS u32x4* xo = (GAS u32x4*)(xb_out + (size_t)tok * 1024) + 2 * lane;
                xo[0] = (u32x4){cvt_pk_bf16(v[tt][0].x, v[tt][0].y), cvt_pk_bf16(v[tt][0].z, v[tt][0].w), cvt_pk_bf16(v[tt][1].x, v[tt][1].y), cvt_pk_bf16(v[tt][1].z, v[tt][1].w)};
                xo[1] = (u32x4){cvt_pk_bf16(v[tt][2].x, v[tt][2].y), cvt_pk_bf16(v[tt][2].z, v[tt][2].w), cvt_pk_bf16(v[tt][3].x, v[tt][3].y), cvt_pk_bf16(v[tt][3].z, v[tt][3].w)};
                if (!dry) {
                    const float rstd = rsqrtf(wave_sum(ss) * (1.f / 1024.f) + EPS);
                    f32x4 h[4];
#pragma unroll
                    for (int j = 0; j < 4; ++j) h[j] = v[tt][j] * rstd * gv[j];
                    unsigned qw[4]; float inv; quant_row_i8(h, qw, inv);
                    *((GAS u32x4*)(H2 + (size_t)tok * 1024) + lane) = (u32x4){qw[0], qw[1], qw[2], qw[3]};
                    if (lane == 0) HS[tok] = inv;
                }
            } else {
#pragma unroll
                for (int j = 0; j < 4; ++j) ((GAS f32x4*)(xf_out + (size_t)tok * 1024) + 4 * lane)[j] = v[tt][j];
            }
        }
    }
}

struct DenseOrder {
    static constexpr bool GATHER = false;
    __device__ __forceinline__ int row_src(const pg8::Unit&, int) const { return 0; }
    __device__ __forceinline__ const char* abase() const { return Abase; }
    __device__ __forceinline__ const char* bbase() const { return Bbase; }
    int nM, nN, G, c, wgm = 2; const char* Abase; const char* Bbase; int pitch;
    __device__ __forceinline__ bool next(int i, pg8::Unit& u) const {
        int pm, pn; if (!pg8::tile_order(i, G, c, nM, nN, pm, pn, wgm)) return false;
        u.a = Abase + (size_t)pm * 256 * pitch; u.b = Bbase + (size_t)pn * 256 * pitch; u.i0 = pm; u.i1 = pn; u.i2 = 0; u.i3 = 0; return true;
    }
};
struct EpiQKV {
    typedef v4i ACC; static constexpr int MODE = 1;
    static __host__ __device__ __forceinline__ int brow(int R) { return 2 * (R & ~31) + pg8::perm32(R & 31); }
    bf16* O; const float* qg; const float* kg; const float* wsc; const float* hs;
    __device__ __forceinline__ void operator()(const v4i (&acc)[2][2][4][2], const pg8::Unit& u, int wr, int wc, int fr, int fq) const {
        const int pn = u.i1, which = pn / 12;
        const int colh = pn * 256 + wc * 64;
        f32x4 gn[2][2], sc[2][2];
#pragma unroll
        for (int bj = 0; bj < 2; ++bj)
#pragma unroll
            for (int n = 0; n < 2; ++n) {
                const int hd = bj * 32 + 8 * fq + 4 * n;
                gn[bj][n] = which == 0 ? *(const f32x4*)(qg + hd) * (0.125f * 1.4426950408889634f * 64.f) : which == 1 ? *(const f32x4*)(kg + hd) * 16.f : (f32x4){1.f, 1.f, 1.f, 1.f};
                sc[bj][n] = *(const f32x4*)(wsc + colh + hd);
            }
        float rscv[2][4];
#pragma unroll
        for (int ai = 0; ai < 2; ++ai)
#pragma unroll
            for (int m = 0; m < 4; ++m) rscv[ai][m] = hs[u.i0 * 256 + ai * 128 + wr * 64 + m * 16 + fr];
#pragma unroll
        for (int ai = 0; ai < 2; ++ai)
#pragma unroll
            for (int m = 0; m < 4; ++m) {
                const int row = u.i0 * 256 + ai * 128 + wr * 64 + m * 16 + fr; const float rsc = rscv[ai][m];
                f32x4 v[2][2]; float ss = 0.f;
#pragma unroll
                for (int bj = 0; bj < 2; ++bj)
#pragma unroll
                    for (int n = 0; n < 2; ++n) { v[bj][n] = __builtin_convertvector(acc[ai][bj][m][n], f32x4) * (sc[bj][n] * rsc); const f32x4 t = v[bj][n]; ss += (t[0] * t[0] + t[1] * t[1]) + (t[2] * t[2] + t[3] * t[3]); }
                { const unsigned su = __builtin_bit_cast(unsigned, ss); const auto s1 = __builtin_amdgcn_permlane16_swap(su, su, false, false);
                  const float p1 = __builtin_bit_cast(float, (unsigned)s1[0]) + __builtin_bit_cast(float, (unsigned)s1[1]);
                  const unsigned pu = __builtin_bit_cast(unsigned, p1); const auto s2 = __builtin_amdgcn_permlane32_swap(pu, pu, false, false);
                  ss = __builtin_bit_cast(float, (unsigned)s2[0]) + __builtin_bit_cast(float, (unsigned)s2[1]); }
                const float rs = which == 2 ? 1.f : rsqrtf(ss * (1.f / 64.f) + EPS);
                const int cwh = (pn % 12) * 256 + wc * 64;
                {
                    unsigned h0[2], h1[2];
                    { const f32x4 a0 = v[0][0] * rs * gn[0][0], a1 = v[0][1] * rs * gn[0][1], b0 = v[1][0] * rs * gn[1][0], b1 = v[1][1] * rs * gn[1][1];
                      int w = __builtin_amdgcn_cvt_pk_fp8_f32(a0[0], a0[1], 0, false); h0[0] = (unsigned)__builtin_amdgcn_cvt_pk_fp8_f32(a0[2], a0[3], w, true);
                      w = __builtin_amdgcn_cvt_pk_fp8_f32(a1[0], a1[1], 0, false); h0[1] = (unsigned)__builtin_amdgcn_cvt_pk_fp8_f32(a1[2], a1[3], w, true);
                      w = __builtin_amdgcn_cvt_pk_fp8_f32(b0[0], b0[1], 0, false); h1[0] = (unsigned)__builtin_amdgcn_cvt_pk_fp8_f32(b0[2], b0[3], w, true);
                      w = __builtin_amdgcn_cvt_pk_fp8_f32(b1[0], b1[1], 0, false); h1[1] = (unsigned)__builtin_amdgcn_cvt_pk_fp8_f32(b1[2], b1[3], w, true); }
                    const auto r0 = __builtin_amdgcn_permlane16_swap(h0[0], h1[0], false, false), r1 = __builtin_amdgcn_permlane16_swap(h0[1], h1[1], false, false);
                    const int boff = (fq & 1) ? 32 + 8 * (fq - 1) : 8 * fq;
                    const u32x4 wv = (fq & 1) ? (u32x4){r0[0], r1[0], r0[1], r1[1]} : (u32x4){r0[0], r1[0], r0[1], r1[1]};
                    *(GAS u32x4*)((unsigned char*)O + (size_t)row * QKVB + which * 3072 + cwh + boff) = wv;
                }
            }
    }
};
__device__ __forceinline__ void phase_qkv(Frame& F) {
    DenseOrder S; S.nM = NTOK / 256; S.nN = NQKV / 256; S.wgm = WGM_QKV; S.G = F.G; S.c = blockIdx.x; S.Abase = (const char*)(F.ws + WS_H2); S.Bbase = (const char*)(F.ws + WS_WQKV); S.pitch = 1024;
    EpiQKV E; E.O = (bf16*)(F.ws + WS_QKV); E.qg = F.q_gain; E.kg = F.k_gain; E.wsc = (const float*)(F.ws + WS_SC_QKV); E.hs = (const float*)(F.ws + WS_HS);
    pg8::gemm_phase<EpiQKV, DenseOrder, true, true>(F.lds, (size_t)32 * 1024, S, E);
}

struct EpiWo {
    typedef f32x4 ACC; static constexpr int MODE = 3;
    static __host__ __device__ __forceinline__ int brow(int R) { return R; }
    bf16* X; bf16* XO; const float* wsc;
    __device__ __forceinline__ void operator()(const f32x4 (&acc)[2][2][4][2], const pg8::Unit& u, int wr, int wc, int fr, int fq) const {
        const int row0 = u.i0 * 256 + wr * 64 + fr, col0 = u.i1 * 256 + wc * 32 + 4 * fq; const size_t dlt = XO - X;
        f32x4 sv[2][2];
#pragma unroll
        for (int bj = 0; bj < 2; ++bj)
#pragma unroll
            for (int n = 0; n < 2; ++n) sv[bj][n] = *(const f32x4*)(wsc + col0 + bj * 128 + n * 16);
#pragma unroll
        for (int ai = 0; ai < 2; ++ai) {
            u32x2 xv[4][2][2];
#pragma unroll
            for (int m = 0; m < 4; ++m)
#pragma unroll
                for (int bj = 0; bj < 2; ++bj)
#pragma unroll
                    for (int n = 0; n < 2; ++n) xv[m][bj][n] = *(const GAS u32x2*)(X + (size_t)(row0 + ai * 128 + m * 16) * 1024 + col0 + bj * 128 + n * 16);
#pragma unroll
            for (int m = 0; m < 4; ++m)
#pragma unroll
                for (int bj = 0; bj < 2; ++bj)
#pragma unroll
                    for (int n = 0; n < 2; ++n) { const f32x4 r = bf4(xv[m][bj][n]) + acc[ai][bj][m][n] * sv[bj][n];
                        *(GAS u32x2*)(X + dlt + (size_t)(row0 + ai * 128 + m * 16) * 1024 + col0 + bj * 128 + n * 16) = (u32x2){cvt_pk_bf16(r[0], r[1]), cvt_pk_bf16(r[2], r[3])}; }
        }
    }
};
__device__ __forceinline__ void phase_wo(Frame& F, bool dry) {
    DenseOrder S; S.nM = NTOK / 256; S.nN = 4; S.wgm = WGM_WO; S.G = F.G; S.c = blockIdx.x; S.Abase = (const char*)(F.ws + WS_OB); S.Bbase = (const char*)(F.ws + WS_WO); S.pitch = 1024;
    EpiWo E; E.X = (bf16*)(F.ws + WS_XB); E.XO = dry ? (bf16*)(F.ws + WS_BIG + 144 * MiB) : E.X; E.wsc = (const float*)(F.ws + WS_SC_WO);
    pg8::gemm_phase<EpiWo, DenseOrder, false, true>(F.lds, (size_t)128 * 1024, S, E);
}

typedef short v4i16_t __attribute__((ext_vector_type(4)));
__device__ __forceinline__ s16x4 vtr(const LAS unsigned char* p) { return __builtin_bit_cast(s16x4, __builtin_amdgcn_ds_read_tr16_b64_v4i16((LAS v4i16_t*)p)); }
struct AttnItem { int g, dil, i, head, needprev; size_t rowbase; };
__device__ __forceinline__ AttnItem attn_item(int sup, int it, int hg) {
    AttnItem a; int z, hp;
    if (it < 4) { const int c0 = sup >> 2; a.g = 0; a.dil = 1; z = c0 >> 3; hp = c0 & 7; a.i = 4 * (sup & 3) + it; a.needprev = (it == 0 && a.i > 0); }
    else if (it < 8) { a.g = 1; a.dil = 4; z = sup >> 3; hp = sup & 7; a.i = it - 4; a.needprev = 0; }
    else { const int idx = 4 * sup + (it - 8); a.g = 2; a.dil = 16; z = idx >> 3; hp = idx & 7; a.i = 0; a.needprev = 0; }
    a.head = hp * 2 + hg;
    a.rowbase = (size_t)(z / a.dil) * SEQ + (z % a.dil);
    return a;
}
__device__ __forceinline__ void attn_issue(const unsigned char* QKV, const AttnItem& a, int blk, int t2, u32x4 (&kv)[2], u32x4 (&vv)[2]) {
#pragma unroll
    for (int it = 0; it < 2; ++it) {
        const int cidx = t2 + 256 * it, row = cidx >> 2, ch = cidx & 3;
        const unsigned char* src = QKV + (a.rowbase + (size_t)a.dil * ((size_t)blk * 128 + row)) * QKVB + 3072 + a.g * 1024 + a.head * 64 + ch * 16;
        kv[it] = *(const GAS u32x4*)src;
        vv[it] = *(const GAS u32x4*)(src + 3072);
    }
}
__device__ __forceinline__ void attn_commit(LAS unsigned char* Kb, LAS unsigned char* Vb, int slot, int t2, const u32x4 (&kv)[2], const u32x4 (&vv)[2]) {
#pragma unroll
    for (int it = 0; it < 2; ++it) {
        const int cidx = t2 + 256 * it, row = cidx >> 2, ch = cidx & 3;
        unsigned o[8];
#pragma unroll
        for (int d = 0; d < 4; ++d) { const f32x2 lo = __builtin_amdgcn_cvt_pk_f32_fp8((int)vv[it][d], false), hi = __builtin_amdgcn_cvt_pk_f32_fp8((int)vv[it][d], true);
            o[2 * d] = cvt_pk_bf16(lo.x, lo.y); o[2 * d + 1] = cvt_pk_bf16(hi.x, hi.y); }
        LAS unsigned char* rp = Vb + slot * 16384 + row * 128;
        *(LAS u32x4*)(rp + (((2 * ch) ^ (row & 7)) << 4)) = (u32x4){o[0], o[1], o[2], o[3]};
        *(LAS u32x4*)(rp + (((2 * ch + 1) ^ (row & 7)) << 4)) = (u32x4){o[4], o[5], o[6], o[7]};
    }
#pragma unroll
    for (int it = 0; it < 2; ++it) {
        const int cidx = t2 + 256 * it, row = cidx >> 2, ch = cidx & 3, x = (row >> 2) & 7;
        LAS unsigned char* rp = Kb + slot * 8192 + row * 64;
        *(LAS u32x2*)(rp + (((2 * ch) ^ x) << 3)) = (u32x2){kv[it].x, kv[it].y};
        *(LAS u32x2*)(rp + (((2 * ch + 1) ^ x) << 3)) = (u32x2){kv[it].z, kv[it].w};
    }
}
__device__ __forceinline__ void attn_loadq(const unsigned char* QKV, const AttnItem& a, int w, int q, int hh, long (&qf)[4]) {
    const size_t qrow = a.rowbase + (size_t)a.dil * ((size_t)a.i * 128 + 32 * w + q);
    const unsigned char* qp = QKV + qrow * QKVB + a.g * 1024 + a.head * 64 + 8 * hh;
#pragma unroll
    for (int ks = 0; ks < 4; ++ks) qf[ks] = *(const GAS long*)(qp + 16 * ks);
}
__device__ __forceinline__ void phase_attn(Frame& F) {
    LAS unsigned char* lds = F.lds;
    LAS float* btab = (LAS float*)(lds + L_BTAB); LAS int* bucketL = (LAS int*)(lds + L_BUCKET);
    const int tid = F.tid, lane = F.lane, wave = F.wave;
    for (int i = tid; i < 3 * 129; i += NTHREADS) {
        const int g = i / 129, d = i % 129; const int n = d * (g == 0 ? 1 : g == 1 ? 4 : 16);
        int bk;
        if (n < 16) bk = n;
        else { const float nf = (float)n; int lg = 16 + (int)(logf(nf / 16.f) / 4.852030263919617f * 16.f); bk = lg < 31 ? lg : 31; }
        bucketL[g * 132 + d] = bk;
    }
    __syncthreads();
    const int hg = wave >> 2, w = wave & 3, t2 = tid & 255;
    const int q = lane & 31, hh = lane >> 5;
    const unsigned char* QKV = F.ws + WS_QKV;
    LAS unsigned char* Kb = lds + hg * 16384;
    LAS unsigned char* Vb = lds + 65536 + hg * 32768;
    const int g16 = lane >> 4, i16 = lane & 15, qsel = i16 >> 2, psel = i16 & 3;
    int kcon[4];
#pragma unroll
    for (int ks = 0; ks < 4; ++ks) kcon[ks] = q * 64 + (((2 * ks + hh) ^ ((q >> 2) & 7)) << 3);
    const int c7 = (4 * hh + qsel) & 7, cb = 2 * (g16 & 1) + (psel >> 1);
    const int vcon0 = (4 * hh + qsel) * 128 + ((cb ^ c7) << 4) + (psel & 1) * 8;
    const int vcon1 = (4 * hh + qsel) * 128 + (((cb + 4) ^ c7) << 4) + (psel & 1) * 8;
    const LAS float* bt = btab + hg * 192 + 32 + 4 * hh - q;
    const int bj_ = t2 - 32; const bool bval = (t2 < 192) && bj_ >= 0 && bj_ <= 128; const int bdel = bval ? 128 - bj_ : 0;
    for (int sup = blockIdx.x; sup < 256; sup += F.G) {
        AttnItem cur = attn_item(sup, 0, hg);
        u32x4 kv[2], vv[2]; long qf[4], qn[4]; float bnx;
        if (cur.needprev) { attn_issue(QKV, cur, cur.i - 1, t2, kv, vv); attn_commit(Kb, Vb, (cur.i - 1) & 1, t2, kv, vv); }
        attn_issue(QKV, cur, cur.i, t2, kv, vv); attn_loadq(QKV, cur, w, q, hh, qf);
        bnx = F.rel_bias[bucketL[cur.g * 132 + bdel] * 48 + cur.g * 16 + cur.head];
        attn_commit(Kb, Vb, cur.i & 1, t2, kv, vv);
        if (t2 < 192) btab[hg * 192 + t2] = bval ? bnx * (1.4426950408889634f * 1024.f) : -1e30f;
        asm volatile("" : "+v"(qf[0]), "+v"(qf[1]), "+v"(qf[2]), "+v"(qf[3]) :: "memory");
        __syncthreads();
#pragma unroll 1
        for (int it = 0; it < 12; ++it) {
            const bool hn = it + 1 < 12;
            AttnItem nxt = cur;
            if (hn) { nxt = attn_item(sup, it + 1, hg); attn_issue(QKV, nxt, nxt.i, t2, kv, vv); attn_loadq(QKV, nxt, w, q, hh, qn);
                      bnx = F.rel_bias[bucketL[nxt.g * 132 + bdel] * 48 + nxt.g * 16 + nxt.head]; }
            const int i = cur.i;
            const int kt_lo = (i == 0) ? 4 : w;
            f32x16 S[5];
            float mx = -1e30f;
#pragma unroll
            for (int t = 0; t < 5; ++t) {
                const int kt = w + t;
                if (kt >= kt_lo) {
                    const LAS unsigned char* kp = Kb + (((kt < 4 ? i - 1 : i) & 1) * 8192 + (kt & 3) * 2048);
                    long kf[4];
#pragma unroll
                    for (int ks = 0; ks < 4; ++ks) kf[ks] = *(const LAS long*)(kp + kcon[ks]);
                    f32x16 acc;
#pragma unroll
                    for (int rg = 0; rg < 16; ++rg) acc[rg] = bt[32 * t + 8 * (rg >> 2) + (rg & 3)];
#pragma unroll
                    for (int ks = 0; ks < 4; ++ks) acc = __builtin_amdgcn_mfma_f32_32x32x16_fp8_fp8(kf[ks], qf[ks], acc, 0, 0, 0);
                    S[t] = acc;
#pragma unroll
                    for (int rg = 0; rg < 16; ++rg) mx = fmaxf(mx, acc[rg]);
                } else {
#pragma unroll
                    for (int rg = 0; rg < 16; ++rg) S[t][rg] = -1e30f;
                }
            }
            mx = fmaxf(mx, __shfl_xor(mx, 32)) * (1.f / 1024.f);
            float lsum = 0.f;
#pragma unroll
            for (int t = 0; t < 5; ++t)
#pragma unroll
                for (int rg = 0; rg < 16; ++rg) { const float p = __builtin_amdgcn_exp2f(__builtin_fmaf(S[t][rg], 1.f / 1024.f, -mx)); S[t][rg] = p; lsum += p; }
            lsum += __shfl_xor(lsum, 32);
            f32x16 O[2];
#pragma unroll
            for (int dt = 0; dt < 2; ++dt)
#pragma unroll
                for (int rg = 0; rg < 16; ++rg) O[dt][rg] = 0.f;
#pragma unroll
            for (int t = 0; t < 5; ++t) {
                const int kt = w + t;
                if (kt >= kt_lo) {
                    const LAS unsigned char* vp = Vb + (((kt < 4 ? i - 1 : i) & 1) * 16384 + (kt & 3) * 4096);
#pragma unroll
                    for (int s2 = 0; s2 < 2; ++s2) {
                        bf16x8 pf;
                        { const unsigned w0 = cvt_pk_bf16(S[t][8 * s2 + 0], S[t][8 * s2 + 1]), w1 = cvt_pk_bf16(S[t][8 * s2 + 2], S[t][8 * s2 + 3]),
                                         w2 = cvt_pk_bf16(S[t][8 * s2 + 4], S[t][8 * s2 + 5]), w3 = cvt_pk_bf16(S[t][8 * s2 + 6], S[t][8 * s2 + 7]);
                          const u32x4 pw = (u32x4){w0, w1, w2, w3}; pf = __builtin_bit_cast(bf16x8, pw); }
                        const s16x4 lo0 = vtr(vp + s2 * 2048 + vcon0), hi0 = vtr(vp + s2 * 2048 + 1024 + vcon0);
                        const s16x4 lo1 = vtr(vp + s2 * 2048 + vcon1), hi1 = vtr(vp + s2 * 2048 + 1024 + vcon1);
                        const bf16x8 vf0 = (bf16x8){lo0[0], lo0[1], lo0[2], lo0[3], hi0[0], hi0[1], hi0[2], hi0[3]};
                        const bf16x8 vf1 = (bf16x8){lo1[0], lo1[1], lo1[2], lo1[3], hi1[0], hi1[1], hi1[2], hi1[3]};
                        O[0] = __builtin_amdgcn_mfma_f32_32x32x16_bf16(vf0, pf, O[0], 0, 0, 0);
                        O[1] = __builtin_amdgcn_mfma_f32_32x32x16_bf16(vf1, pf, O[1], 0, 0, 0);
                    }
                }
            }
            {
                const size_t qrow = cur.rowbase + (size_t)cur.dil * ((size_t)i * 128 + 32 * w + q);
                const float inv = 1.f / lsum;
                unsigned char* op = F.ws + WS_OG + ((size_t)cur.g * NTOK + qrow) * 1024 + cur.head * 64;
#pragma unroll
                for (int dt = 0; dt < 2; ++dt) {
                    unsigned P[4];
#pragma unroll
                    for (int r4 = 0; r4 < 4; ++r4) { const int w0 = __builtin_amdgcn_cvt_pk_fp8_f32(O[dt][4 * r4 + 0] * inv, O[dt][4 * r4 + 1] * inv, 0, false);
                        P[r4] = (unsigned)__builtin_amdgcn_cvt_pk_fp8_f32(O[dt][4 * r4 + 2] * inv, O[dt][4 * r4 + 3] * inv, w0, true); }
                    const auto s01 = __builtin_amdgcn_permlane32_swap(P[0], P[1], false, false), s23 = __builtin_amdgcn_permlane32_swap(P[2], P[3], false, false);
                    *(GAS u32x2*)(op + dt * 32 + 8 * hh) = (u32x2){s01[0], s01[1]};
                    *(GAS u32x2*)(op + dt * 32 + 16 + 8 * hh) = (u32x2){s23[0], s23[1]};
                }
                if (hh == 0) ((float*)(F.ws + WS_LSE))[((size_t)cur.g * NTOK + qrow) * 16 + cur.head] = (mx + __builtin_amdgcn_logf(lsum)) * 0.6931471805599453f;
            }
            __syncthreads();
            if (hn) {
                asm volatile("" : "+v"(qn[0]), "+v"(qn[1]), "+v"(qn[2]), "+v"(qn[3]), "+v"(bnx) :: "memory");
                attn_commit(Kb, Vb, nxt.i & 1, t2, kv, vv);
                if (t2 < 192) btab[hg * 192 + t2] = bval ? bnx * (1.4426950408889634f * 1024.f) : -1e30f;
#pragma unroll
                for (int ks = 0; ks < 4; ++ks) qf[ks] = qn[ks];
                cur = nxt;
            }
            __syncthreads();
        }
    }
}
__device__ __forceinline__ void phase_attn_combine(Frame& F) {
    const int gw = blockIdx.x * NWAVES + F.wave, NGW = F.G * NWAVES, lane = F.lane;
    const float* LSE = (const float*)(F.ws + WS_LSE); const unsigned char* OG = F.ws + WS_OG; unsigned char* OB = F.ws + WS_OB;
    for (int tok = gw; tok < NTOK; tok += NGW) {
        const int head = lane >> 2;
        const float l0 = LSE[((size_t)0 * NTOK + tok) * 16 + head], l1 = LSE[((size_t)1 * NTOK + tok) * 16 + head], l2 = LSE[((size_t)2 * NTOK + tok) * 16 + head];
        const u32x4 v0 = *((const GAS u32x4*)(OG + ((size_t)0 * NTOK + tok) * 1024) + lane);
        const u32x4 v1 = *((const GAS u32x4*)(OG + ((size_t)1 * NTOK + tok) * 1024) + lane);
        const u32x4 v2 = *((const GAS u32x4*)(OG + ((size_t)2 * NTOK + tok) * 1024) + lane);
        const float m = fmaxf(l0, fmaxf(l1, l2));
        float a0 = __expf(l0 - m), a1 = __expf(l1 - m), a2 = __expf(l2 - m); const float inv = 1.f / (a0 + a1 + a2); a0 *= inv; a1 *= inv; a2 *= inv;
        u32x4 o;
#pragma unroll
        for (int k = 0; k < 4; ++k) {
            const f32x2 x0 = __builtin_amdgcn_cvt_pk_f32_fp8((int)v0[k], false), y0 = __builtin_amdgcn_cvt_pk_f32_fp8((int)v0[k], true);
            const f32x2 x1 = __builtin_amdgcn_cvt_pk_f32_fp8((int)v1[k], false), y1 = __builtin_amdgcn_cvt_pk_f32_fp8((int)v1[k], true);
            const f32x2 x2 = __builtin_amdgcn_cvt_pk_f32_fp8((int)v2[k], false), y2 = __builtin_amdgcn_cvt_pk_f32_fp8((int)v2[k], true);
            const int w = __builtin_amdgcn_cvt_pk_fp8_f32(a0 * x0.x + a1 * x1.x + a2 * x2.x, a0 * x0.y + a1 * x1.y + a2 * x2.y, 0, false);
            o[k] = (unsigned)__builtin_amdgcn_cvt_pk_fp8_f32(a0 * y0.x + a1 * y1.x + a2 * y2.x, a0 * y0.y + a1 * y1.y + a2 * y2.y, w, true);
        }
        *((GAS u32x4*)(OB + (size_t)tok * 1024) + lane) = o;
    }
}

constexpr int NPHASE = 13;
__global__ void __launch_bounds__(NTHREADS, 2) fwd_kernel(Args args) {
    extern __shared__ __attribute__((aligned(16))) unsigned char lds_raw[];
    Frame F;
    F.lds = (LAS unsigned char*)lds_raw;
    F.tid = threadIdx.x; F.lane = F.tid & 63; F.wave = __builtin_amdgcn_readfirstlane(F.tid >> 6); F.G = gridDim.x;
    F.ws = args.ws; F.out = args.out; F.ctl = (gu32*)(args.ws + WS_CTL);
    F.x = args.in[0]; F.norm_mix_g = args.in[1]; F.norm_ffn_g = args.in[2]; F.pool_w = args.in[3]; F.pool_scale = args.in[4]; F.w_qkv = args.in[5];
    F.q_gain = args.in[6]; F.k_gain = args.in[7]; F.w_o = args.in[8]; F.rel_bias = args.in[9]; F.w_router = args.in[10]; F.b_router = args.in[11];
    F.w_gu = args.in[12]; F.b_gu = args.in[13]; F.w_dn = args.in[14]; F.b_dn = args.in[15];
    if (F.tid < 16) ((LAS unsigned*)(F.lds + L_BARST))[F.tid] = 0u;
    __syncthreads();
    if (args.never) cg::this_grid().sync();
#if MK_MULTI
#define GRID_BAR() do { } while (0)
#else
    XcdBarrier bar = xcd_barrier_post((unsigned*)(F.ctl + CW_BAR), (volatile LAS unsigned*)(F.lds + L_BARST));
#define GRID_BAR() xcd_barrier(bar)
#endif
    const int lo = args.ph_lo, hi = args.ph_hi;
#define IN(k) (lo <= (k) && (k) < hi)
#define SEAM(k) do { if (IN(k) && IN((k) + 1)) GRID_BAR(); } while (0)
#define RUN(k, call) do { if (IN(k)) { if ((DUP_MASK >> (k)) & 1) { call; GRID_BAR(); } call; } } while (0)
#define DRY(k) (((DUP_MASK >> (k)) & 1) != 0)
    RUN(0, phase_convert<0>(F));       SEAM(0);
    if (IN(1)) { if (DRY(1)) { phase_pool(F, true); GRID_BAR(); }
        const bool conv_first = ((blockIdx.x >> 3) & 1) != 0;
        if (conv_first) phase_convert<1>(F);
        phase_pool(F, false);
        if (!conv_first) phase_convert<1>(F);
        defer_run<1>(F, 1 << 30); }  SEAM(1);
    RUN(2, phase_moe_gu(F, 0));        SEAM(2);
    RUN(3, phase_moe_dn(F, 0));        SEAM(3);
    if (IN(4)) { if (DRY(4)) { phase_combine(F, 0, true); GRID_BAR(); } phase_combine(F, 0, false); }  SEAM(4);
    RUN(5, phase_qkv(F));              SEAM(5);
    RUN(6, phase_attn(F));             SEAM(6);
    RUN(7, phase_attn_combine(F));     SEAM(7);
    if (IN(8)) { if (DRY(8)) { phase_wo(F, true); GRID_BAR(); } phase_wo(F, false); }  SEAM(8);
    if (IN(9)) { if (DRY(9)) { phase_router(F, 1, true); GRID_BAR(); } phase_router(F, 1, false); }  SEAM(9);
    RUN(10, phase_moe_gu(F, 1));       SEAM(10);
    RUN(11, phase_moe_dn(F, 1));       SEAM(11);
    if (IN(12)) { if (DRY(12)) { phase_combine(F, 1, true); GRID_BAR(); } phase_combine(F, 1, false); }
#undef RUN
#undef DRY
#undef IN
#undef SEAM
}

extern "C" void kernel_launch(void* const* d_in, const int* in_sizes, int n_in, void* d_out, int out_size, void* d_ws, size_t ws_size, hipStream_t stream) {
    static int grid = 0;
    if (grid == 0) {
        if (n_in != 16 || in_sizes[0] != NTOK * DM || out_size != NTOK * DM || ws_size < WS_END) {
            fprintf(stderr, "kernel_launch: unexpected shapes (n_in %d, in0 %d, out %d, ws %zu < %zu); nothing launched\n", n_in, n_in > 0 ? in_sizes[0] : -1, out_size, ws_size, (size_t)WS_END); grid = -1; return; }
        int dev = 0, cus = 0, per_cu = 0;
        if (hipGetDevice(&dev) != hipSuccess || hipDeviceGetAttribute(&cus, hipDeviceAttributeMultiprocessorCount, dev) != hipSuccess) { grid = -1; return; }
        if (hipFuncSetAttribute((const void*)fwd_kernel, hipFuncAttributeMaxDynamicSharedMemorySize, LDS_BYTES) != hipSuccess) { fprintf(stderr, "kernel_launch: hipFuncSetAttribute failed\n"); grid = -1; return; }
        if (hipOccupancyMaxActiveBlocksPerMultiprocessor(&per_cu, (const void*)fwd_kernel, NTHREADS, LDS_BYTES) != hipSuccess || per_cu < 1) { fprintf(stderr, "kernel_launch: occupancy query says %d blocks/CU\n", per_cu); (void)hipGetLastError(); grid = -1; return; }
        grid = cus;
    }
    if (grid < 0) return;
    if (hipMemsetAsync((char*)d_ws + WS_CTL, 0, CTL_BYTES, stream) != hipSuccess) { fprintf(stderr, "kernel_launch: memset failed\n"); return; }
    Args a{};
    for (int i = 0; i < 16; ++i) a.in[i] = (const float*)d_in[i];
    a.out = (float*)d_out; a.ws = (unsigned char*)d_ws; a.never = 0; a.pad = 0;
#if MK_MULTI
    for (int p = 0; p < NPHASE; ++p) { a.ph_lo = p; a.ph_hi = p + 1; hipLaunchKernelGGL(fwd_kernel, dim3(grid), dim3(NTHREADS), LDS_BYTES, stream, a); }
#else
    a.ph_lo = 0; a.ph_hi = NPHASE;
    void* kargs[] = {&a};
    hipError_t e = hipLaunchCooperativeKernel((const void*)fwd_kernel, dim3(grid), dim3(NTHREADS), kargs, LDS_BYTES, stream);
    if (e != hipSuccess) fprintf(stderr, "kernel_launch: cooperative launch failed: %s (grid %d)\n", hipGetErrorString(e), grid);
#endif
}
```
